# Optimizing an MI355X kernel written in HIP

```python
import jax, jax.numpy as jnp
from jax import lax
import numpy as np

D_MODEL = 1024
BATCH = 16
SEQ = 2048
DEPTH = 2

CHUNK = 64
D_FF = 2816
CONV_W = D_MODEL
CONV_K = 3
CONV_GROUPS = 16
POOL_W = D_MODEL
POOL_WINDOWS = (2, 4, 8, 16)
POOL_GROUPS = len(POOL_WINDOWS)
POOL_GC = POOL_W // POOL_GROUPS
N_BRANCH = 2
IN_COLS = 3 * CONV_W + POOL_W + N_BRANCH * D_MODEL
EPS = 1e-6

kernel_name = "hybrid_conv_pool_gated_macaron"


def rms_norm(x, g):
    xf = x.astype(jnp.float32)
    y = xf * lax.rsqrt(jnp.mean(xf * xf, axis=-1, keepdims=True) + EPS)
    return (y * g.astype(jnp.float32)).astype(x.dtype)


def swiglu(h, w_gate_up, w_down):
    gu = h @ w_gate_up
    g, u = jnp.split(gu, 2, axis=-1)
    return (jax.nn.silu(g) * u) @ w_down


def causal_depthwise_conv(u, w):
    s = u.shape[1]
    u_pad = jnp.pad(u, ((0, 0), (CONV_K - 1, 0), (0, 0)))
    y = w[0] * u_pad[:, 0:s]
    for k in range(1, CONV_K):
        y = y + w[k] * u_pad[:, k:k + s]
    return y


def trailing_mean(u, win):
    s = u.shape[1]
    cs = jnp.cumsum(u, axis=1)
    cs_shift = jnp.pad(cs, ((0, 0), (win, 0), (0, 0)))[:, :s]
    count = jnp.minimum(jnp.arange(1, s + 1), win).astype(jnp.float32)
    return (cs - cs_shift) / count[None, :, None]


def pool_mixer(p, w_pg, b_pg, scale):
    b, s, _ = p.shape
    pf = p.astype(jnp.float32).reshape(b, s, POOL_GROUPS, POOL_GC)
    pooled = jnp.stack([trailing_mean(pf[:, :, gi], win) for gi, win in enumerate(POOL_WINDOWS)], axis=2)
    d = (pooled - pf).astype(p.dtype)
    y = jnp.einsum('bsgc,gcd->bsgd', d, w_pg) + b_pg
    return y.reshape(b, s, POOL_W) * scale


def hybrid_mixer(h, w_in, b_gate, conv_w, w_conv_out, w_pg, b_pg, pool_scale, w_pool_out, w_o):
    z = h @ w_in
    b_g, c_g, v, p, gates = jnp.split(
        z, [CONV_W, 2 * CONV_W, 3 * CONV_W, 3 * CONV_W + POOL_W], axis=-1)
    y_a = (b_g * causal_depthwise_conv(c_g * v, conv_w)) @ w_conv_out
    y_p = pool_mixer(p, w_pg, b_pg, pool_scale) @ w_pool_out
    g = jax.nn.sigmoid((gates + b_gate).astype(jnp.float32)).astype(h.dtype)
    g_a, g_p = jnp.split(g, N_BRANCH, axis=-1)
    return (g_a * y_a + g_p * y_p) @ w_o


def setup_inputs(seed: int = 0) -> dict:
    key = jax.random.key(seed)
    ks = jax.random.split(key, 24)
    f32 = jnp.float32

    def nrm(k, shape, fan_in):
        return jax.random.normal(k, shape, f32) * (fan_in ** -0.5)

    def gain(k, shape):
        return 1.0 + 0.05 * jax.random.normal(k, shape, f32)

    L = DEPTH
    return {
        "x": jax.random.normal(ks[0], (BATCH, SEQ, D_MODEL), f32),
        "ffn1_pre": gain(ks[1], (L, D_MODEL)),
        "ffn1_post": gain(ks[2], (L, D_MODEL)),
        "ffn1_w_gate_up": nrm(ks[3], (L, D_MODEL, 2 * D_FF), D_MODEL),
        "ffn1_w_down": nrm(ks[4], (L, D_FF, D_MODEL), D_FF),
        "mix_pre": gain(ks[5], (L, D_MODEL)),
        "mix_post": gain(ks[6], (L, D_MODEL)),
        "w_in": nrm(ks[7], (L, D_MODEL, IN_COLS), D_MODEL),
        "b_gate": 0.01 * jax.random.normal(ks[8], (L, N_BRANCH * D_MODEL), f32),
        "conv_w": nrm(ks[9], (L, CONV_K, CONV_W), CONV_K),
        "w_conv_out": nrm(ks[10], (L, CONV_W, D_MODEL), CONV_W),
        "w_pool_group": nrm(ks[11], (L, POOL_GROUPS, POOL_GC, POOL_GC), POOL_GC),
        "b_pool_group": 0.01 * jax.random.normal(ks[12], (L, POOL_GROUPS, POOL_GC), f32),
        "pool_scale": gain(ks[13], (L, POOL_W)),
        "w_pool_out": nrm(ks[14], (L, POOL_W, D_MODEL), POOL_W),
        "w_o": nrm(ks[15], (L, D_MODEL, D_MODEL), D_MODEL),
        "ffn2_pre": gain(ks[16], (L, D_MODEL)),
        "ffn2_post": gain(ks[17], (L, D_MODEL)),
        "ffn2_w_gate_up": nrm(ks[18], (L, D_MODEL, 2 * D_FF), D_MODEL),
        "ffn2_w_down": nrm(ks[19], (L, D_FF, D_MODEL), D_FF),
    }


def reference(x, ffn1_pre, ffn1_post, ffn1_w_gate_up, ffn1_w_down,
              mix_pre, mix_post, w_in, b_gate, conv_w, w_conv_out,
              w_pool_group, b_pool_group, pool_scale, w_pool_out, w_o,
              ffn2_pre, ffn2_post, ffn2_w_gate_up, ffn2_w_down):
    for l in range(DEPTH):
        h = swiglu(rms_norm(x, ffn1_pre[l]), ffn1_w_gate_up[l], ffn1_w_down[l])
        x = x + 0.5 * rms_norm(h, ffn1_post[l])
        h = hybrid_mixer(rms_norm(x, mix_pre[l]), w_in[l], b_gate[l], conv_w[l],
                         w_conv_out[l], w_pool_group[l], b_pool_group[l],
                         pool_scale[l], w_pool_out[l], w_o[l])
        x = x + rms_norm(h, mix_post[l])
        h = swiglu(rms_norm(x, ffn2_pre[l]), ffn2_w_gate_up[l], ffn2_w_down[l])
        x = x + 0.5 * rms_norm(h, ffn2_post[l])
    return x
```

```cpp
#include <hip/hip_runtime.h>
#include <hip/hip_cooperative_groups.h>
#include <cstdio>
#include <cstdint>
namespace cg = cooperative_groups;

#ifndef MK_STOP
#define MK_STOP (MK_DUMP ? (MK_DUMP == 8 ? 7 : MK_DUMP + 1) : 999)
#endif
#ifndef MK_ONE_LAUNCH
#define MK_ONE_LAUNCH 1
#endif

#define LAS __attribute__((address_space(3)))
typedef unsigned short bf16_t;
typedef short bf16x8 __attribute__((ext_vector_type(8)));
typedef float f32x4 __attribute__((ext_vector_type(4)));
typedef unsigned u32x4 __attribute__((ext_vector_type(4)));
typedef unsigned u32x2 __attribute__((ext_vector_type(2)));

constexpr int D = 1024, SEQ = 2048, BATCH = 16, M = BATCH * SEQ, FF = 2816, NGU = 2 * FF, NIN = 6144, DEPTH = 2;
constexpr float EPS = 1e-6f;
constexpr size_t MiB = 1u << 20;
constexpr size_t WS_W = 1 * MiB;
constexpr size_t W_GU1 = WS_W, W_D1 = W_GU1 + (size_t)NGU * D * 2, W_IN = W_D1 + (size_t)D * FF * 2, W_PG = W_IN + (size_t)NIN * D * 2,
                 W_CO = W_PG + (size_t)D * 256 * 2, W_PO = W_CO + (size_t)D * D * 2, W_WO = W_PO + (size_t)D * D * 2, W_GU2 = W_WO + (size_t)D * D * 2,
                 W_D2 = W_GU2 + (size_t)NGU * D * 2, W_END = W_D2 + (size_t)D * FF * 2;
static_assert(W_END <= 56 * MiB, "weights");
constexpr size_t WS_A = 56 * MiB;
constexpr size_t WS_R0 = 120 * MiB;
constexpr size_t WS_ZG = WS_R0;
constexpr size_t WS_ZB = WS_R0 + 128 * MiB;
constexpr size_t WS_ZCV = WS_ZB + 64 * MiB;
constexpr size_t WS_ZP = WS_ZCV + 64 * MiB;
constexpr size_t WS_DD = WS_ZP + 64 * MiB;
constexpr size_t WS_YP0 = WS_ZB;
constexpr size_t WS_M1 = WS_ZCV;
constexpr size_t WS_MM = WS_DD;
constexpr size_t WS_HMIX = WS_R0;
constexpr size_t WS_HH = WS_R0;
constexpr size_t WS_HFFN = WS_ZCV;
constexpr size_t WS_END = WS_DD + 64 * MiB;
static_assert(WS_HH + (size_t)M * FF * 2 <= WS_HFFN, "H overlay");
constexpr int LDS_BYTES = 147456, MISC_OFF = 131072 + 320;
constexpr size_t WS_BAR = 16384, CTL_ZERO_BYTES = 65536;

typedef float f32x2 __attribute__((ext_vector_type(2)));
typedef __bf16 bf16x2 __attribute__((ext_vector_type(2)));
__device__ __forceinline__ unsigned cvt_pk_bf16(float lo, float hi) { const f32x2 v = {lo, hi}; const bf16x2 b = __builtin_convertvector(v, bf16x2); return __builtin_bit_cast(unsigned, b); }
__device__ __forceinline__ float bf_lo(unsigned u) { return __builtin_bit_cast(float, u << 16); }
__device__ __forceinline__ float bf_hi(unsigned u) { return __builtin_bit_cast(float, u & 0xffff0000u); }
__device__ __forceinline__ float sigmoid_f(float x) { return __builtin_amdgcn_rcpf(1.0f + __expf(-x)); }
__device__ __forceinline__ float wave_sum(float v, int lane) {
#pragma unroll
    for (int o = 1; o < 64; o <<= 1) v += __builtin_bit_cast(float, __builtin_amdgcn_ds_bpermute((lane ^ o) << 2, __builtin_bit_cast(int, v)));
    return v;
}
#define LDS_WAIT() asm volatile("s_waitcnt lgkmcnt(0)" ::: "memory")

namespace pg8 {
constexpr int BM = 256, BK = 64, HALF = 128, HTB = HALF * BK * 2, STAGE_BYTES = 8 * HTB, NXCD = 8, WGM = 8;
__host__ __device__ __forceinline__ int lds_byte(int r, int c) { const int st = (r >> 4) * 2 + (c >> 5), rr = r & 15, cc = c & 31, ob = rr * 64 + cc * 2; return st * 1024 + (ob ^ (((ob >> 9) & 1) << 5)); }
__host__ __device__ __forceinline__ void stage_rc(int b, int& R, int& C) { const int st = b / 1024, sb = b % 1024, swz = sb ^ (((sb >> 9) & 1) << 5); R = (st >> 1) * 16 + swz / 64; C = (st & 1) * 32 + (swz % 64) / 2; }
__host__ __device__ __forceinline__ int perm32(int rho) { const int n = rho >> 4, i = rho & 15; return 8 * (i >> 2) + 4 * n + (i & 3); }

struct Unit { int pm, pn; };
struct Gemm { const bf16_t* A; const bf16_t* Bt; int M, N, K, lda, a_pn_cols; };

struct StaticOrder {
    int nM, nN, nwg, G, c;
    __host__ __device__ void init(int M_, int N_, int G_, int c_) { nM = M_ / BM; nN = N_ / BM; nwg = nM * nN; G = G_; c = c_; }
    __host__ __device__ bool next(int i, Unit& u) const {
        const long L = (long)i * G + c; if (L >= nwg) return false;
        int wgid = (int)L; { const int q = nwg / NXCD, r = nwg % NXCD, xcd = wgid % NXCD, off = wgid / NXCD; wgid = (xcd < r ? xcd * (q + 1) : r * (q + 1) + (xcd - r) * q) + off; }
        const int nig = WGM * nN, gid = wgid / nig, fm = gid * WGM, gsz = (nM - fm) < WGM ? (nM - fm) : WGM;
        u.pm = fm + ((wgid % nig) % gsz); u.pn = (wgid % nig) / gsz; return true;
    }
};

typedef f32x4 Acc[2][2][4][2];
__device__ __forceinline__ const char* uni(const char* p) { const unsigned long long v = (unsigned long long)p; const unsigned lo = __builtin_amdgcn_readfirstlane((unsigned)v), hi = __builtin_amdgcn_readfirstlane((unsigned)(v >> 32)); return (const char*)(((unsigned long long)hi << 32) | lo); }

template <class Epi>
__device__ __forceinline__ void gemm_phase(LAS unsigned char* lds, const Gemm g, const StaticOrder& S, const Epi& E, const int tid) {
    const int wid = __builtin_amdgcn_readfirstlane(tid >> 6), lane = tid & 63, wr = wid >> 2, wc = wid & 3, fr = lane & 15, fq = lane >> 4;
    const int K = g.K, nt = K / BK;
    unsigned voffA[2], voffB[2];
#pragma unroll
    for (int i = 0; i < 2; ++i) { int R, C; stage_rc(tid * 16 + i * 8192, R, C); const int Rb = (R & ~31) + perm32(R & 31);
        voffA[i] = (unsigned)(R * g.lda + C) * 2u; voffB[i] = (unsigned)(Rb * K + C) * 2u; }
    const size_t kstep = (size_t)(BK * 2);
    const size_t hstepA = (size_t)HALF * g.lda * 2, tstepA = 2 * hstepA;
    const size_t hstepB = (size_t)HALF * K * 2, tstepB = 2 * hstepB;
    const size_t pnA = (size_t)g.a_pn_cols * 2;
    const unsigned ldsw = (unsigned)wid * 1024u;
    const int aoff = lds_byte(wr * 64 + fr, fq * 8), boff = lds_byte(wc * 32 + fr, fq * 8);
#define PG8_SA(b, h) (((b) * 2 + (h)) * HTB)
#define PG8_SB(b, h) ((4 + (b) * 2 + (h)) * HTB)
#define PG8_STAGE(bufoff, gbase, voff) do { _Pragma("unroll") for (int _i = 0; _i < 2; ++_i) \
        __builtin_amdgcn_global_load_lds((const unsigned*)((const char*)(gbase) + (voff)[_i]), (LAS unsigned*)(lds + (bufoff) + ldsw + _i * 8192), 16, 0, 0); } while (0)
#define PG8_LDA(dst, b, h) do { _Pragma("unroll") for (int m = 0; m < 4; ++m) _Pragma("unroll") for (int k = 0; k < 2; ++k) dst[m][k] = *(const LAS bf16x8*)(lds + PG8_SA(b, h) + aoff + m * 2048 + k * 1024); } while (0)
#define PG8_LDB(dst, b, h) do { _Pragma("unroll") for (int n = 0; n < 2; ++n) _Pragma("unroll") for (int k = 0; k < 2; ++k) dst[n][k] = *(const LAS bf16x8*)(lds + PG8_SB(b, h) + boff + n * 2048 + k * 1024); } while (0)
#define PG8_MMA(ai, bj, At, Bt) do { __builtin_amdgcn_s_setprio(1); _Pragma("unroll") for (int m = 0; m < 4; ++m) _Pragma("unroll") for (int n = 0; n < 2; ++n) _Pragma("unroll") for (int k = 0; k < 2; ++k) \
        acc[ai][bj][m][n] = __builtin_amdgcn_mfma_f32_16x16x32_bf16(Bt[n][k], At[m][k], acc[ai][bj][m][n], 0, 0, 0); __builtin_amdgcn_s_setprio(0); } while (0)
#define PG8_WAIT_V(n) asm volatile("s_waitcnt vmcnt(" #n ")" ::: "memory")
#define PG8_WAIT_L(n) asm volatile("s_waitcnt lgkmcnt(" #n ")" ::: "memory")
#define PG8_BAR __builtin_amdgcn_s_barrier()
#define PG8_SCHED __builtin_amdgcn_sched_barrier(0)
    Unit cur, nxt; int ui = 0;
    if (!S.next(0, cur)) return;
    Acc acc;
#pragma unroll
    for (int a = 0; a < 2; ++a)
#pragma unroll
        for (int b = 0; b < 2; ++b)
#pragma unroll
            for (int m = 0; m < 4; ++m)
#pragma unroll
                for (int n = 0; n < 2; ++n) acc[a][b][m][n] = (f32x4){0.f, 0.f, 0.f, 0.f};
    bf16x8 At[4][2], B0[2][2], B1[2][2];
    const char* cA = uni((const char*)g.A + (size_t)cur.pm * tstepA + (size_t)cur.pn * pnA); const char* cB = uni((const char*)g.Bt + (size_t)cur.pn * tstepB);
    PG8_STAGE(PG8_SB(0, 0), cB, voffB); PG8_STAGE(PG8_SB(0, 1), cB + hstepB, voffB); PG8_STAGE(PG8_SA(0, 0), cA, voffA); PG8_STAGE(PG8_SA(0, 1), cA + hstepA, voffA);
    if (wr == 1) PG8_BAR;
    PG8_WAIT_V(2); PG8_BAR;
    PG8_STAGE(PG8_SB(1, 0), cB + kstep, voffB); PG8_STAGE(PG8_SA(1, 0), cA + kstep, voffA); PG8_STAGE(PG8_SB(1, 1), cB + hstepB + kstep, voffB);
    PG8_WAIT_V(6); PG8_BAR;
    for (;;) {
        const bool has_next = S.next(ui + 1, nxt);
        const char* nA = uni(has_next ? (const char*)g.A + (size_t)nxt.pm * tstepA + (size_t)nxt.pn * pnA : cA); const char* nB = uni(has_next ? (const char*)g.Bt + (size_t)nxt.pn * tstepB : cB);
#pragma unroll 1
        for (int t = 0; t < nt; t += 2) {
            const bool last = (t == nt - 2);
            const char* a1 = cA + (size_t)(t + 1) * kstep;
            const char* a2 = last ? nA : cA + (size_t)(t + 2) * kstep; const char* b2 = last ? nB : cB + (size_t)(t + 2) * kstep;
            const char* a3 = a2 + kstep; const char* b3 = b2 + kstep;
            PG8_LDB(B0, 0, 0); PG8_LDB(B1, 0, 1); PG8_SCHED; PG8_LDA(At, 0, 0); PG8_STAGE(PG8_SA(1, 1), a1 + hstepA, voffA);
            PG8_WAIT_V(8); PG8_WAIT_L(0); PG8_BAR; PG8_MMA(0, 0, At, B0); PG8_MMA(0, 1, At, B1); PG8_BAR; PG8_SCHED;
            PG8_LDA(At, 0, 1); PG8_STAGE(PG8_SB(0, 0), b2, voffB); PG8_STAGE(PG8_SB(0, 1), b2 + hstepB, voffB); PG8_STAGE(PG8_SA(0, 0), a2, voffA);
            PG8_WAIT_V(8); PG8_WAIT_L(0); PG8_BAR; PG8_MMA(1, 0, At, B0); PG8_MMA(1, 1, At, B1); PG8_BAR; PG8_SCHED;
            PG8_LDB(B0, 1, 0); PG8_LDB(B1, 1, 1); PG8_SCHED; PG8_LDA(At, 1, 0); PG8_STAGE(PG8_SA(0, 1), a2 + hstepA, voffA);
            PG8_WAIT_V(8); PG8_WAIT_L(0); PG8_BAR; PG8_MMA(0, 0, At, B0); PG8_MMA(0, 1, At, B1); PG8_BAR; PG8_SCHED;
            PG8_LDA(At, 1, 1); PG8_STAGE(PG8_SB(1, 0), b3, voffB); PG8_STAGE(PG8_SB(1, 1), b3 + hstepB, voffB); PG8_STAGE(PG8_SA(1, 0), a3, voffA);
            PG8_WAIT_V(8); PG8_WAIT_L(0); PG8_BAR; PG8_MMA(1, 0, At, B0); PG8_MMA(1, 1, At, B1); PG8_BAR; PG8_SCHED;
        }
        if (wr == 0) PG8_BAR;
        E(acc, cur, wr, wc, fr, fq);
        if (!has_next) break;
#pragma unroll
        for (int a = 0; a < 2; ++a)
#pragma unroll
            for (int b = 0; b < 2; ++b)
#pragma unroll
                for (int m = 0; m < 4; ++m)
#pragma unroll
                    for (int n = 0; n < 2; ++n) acc[a][b][m][n] = (f32x4){0.f, 0.f, 0.f, 0.f};
        cur = nxt; cA = nA; cB = nB; ++ui;
        if (wr == 1) PG8_BAR;
    }
    PG8_WAIT_V(0);
    PG8_BAR;
#undef PG8_SA
#undef PG8_SB
#undef PG8_STAGE
#undef PG8_LDA
#undef PG8_LDB
#undef PG8_MMA
#undef PG8_WAIT_V
#undef PG8_WAIT_L
#undef PG8_BAR
#undef PG8_SCHED
}

__device__ __forceinline__ u32x4 pack8(const f32x4 v0, const f32x4 v1) { u32x4 w; w.x = cvt_pk_bf16(v0[0], v0[1]); w.y = cvt_pk_bf16(v0[2], v0[3]); w.z = cvt_pk_bf16(v1[0], v1[1]); w.w = cvt_pk_bf16(v1[2], v1[3]); return w; }

struct EpiSwiglu {
    bf16_t* O;
    __device__ __forceinline__ void operator()(const Acc& acc, const Unit& u, int wr, int wc, int fr, int fq) const {
        const int row0 = u.pm * BM + wr * 64 + fr, col0 = u.pn * HALF + wc * 32 + 8 * fq;
#pragma unroll
        for (int ai = 0; ai < 2; ++ai)
#pragma unroll
            for (int m = 0; m < 4; ++m) {
                f32x4 v[2];
#pragma unroll
                for (int n = 0; n < 2; ++n) { const f32x4 gt = acc[ai][0][m][n], up = acc[ai][1][m][n];
#pragma unroll
                    for (int j = 0; j < 4; ++j) v[n][j] = gt[j] * sigmoid_f(gt[j]) * up[j]; }
                *(u32x4*)(O + (size_t)(row0 + ai * HALF + m * 16) * FF + col0) = pack8(v[0], v[1]);
            }
    }
};
struct EpiF32 {
    float* C;
    __device__ __forceinline__ void operator()(const Acc& acc, const Unit& u, int wr, int wc, int fr, int fq) const {
        const int row0 = u.pm * BM + wr * 64 + fr, col0 = u.pn * BM + wc * 32 + 8 * fq;
#pragma unroll
        for (int ai = 0; ai < 2; ++ai)
#pragma unroll
            for (int m = 0; m < 4; ++m) { float* rowp = C + (size_t)(row0 + ai * HALF + m * 16) * D + col0;
#pragma unroll
                for (int bj = 0; bj < 2; ++bj) { *(f32x4*)(rowp + bj * HALF) = acc[ai][bj][m][0]; *(f32x4*)(rowp + bj * HALF + 4) = acc[ai][bj][m][1]; } }
    }
};
struct EpiWin {
    bf16_t *ZB, *ZCV, *ZP, *ZG; const float* bgate;
    __device__ __forceinline__ void operator()(const Acc& acc, const Unit& u, int wr, int wc, int fr, int fq) const {
        const int row0 = u.pm * BM + wr * 64 + fr, pn = u.pn, cw = wc * 32 + 8 * fq;
        if (pn >= 4 && pn < 12) {
            const int col0 = (pn - 4) * HALF + cw;
#pragma unroll
            for (int ai = 0; ai < 2; ++ai)
#pragma unroll
                for (int m = 0; m < 4; ++m)
                    *(u32x4*)(ZCV + (size_t)(row0 + ai * HALF + m * 16) * D + col0) = pack8(acc[ai][0][m][0] * acc[ai][1][m][0], acc[ai][0][m][1] * acc[ai][1][m][1]);
        } else if (pn < 16) {
            bf16_t* base = pn < 4 ? ZB : ZP; const int col0 = (pn < 4 ? pn : pn - 12) * BM + cw;
#pragma unroll
            for (int ai = 0; ai < 2; ++ai)
#pragma unroll
                for (int m = 0; m < 4; ++m) { bf16_t* rowp = base + (size_t)(row0 + ai * HALF + m * 16) * D + col0;
#pragma unroll
                    for (int bj = 0; bj < 2; ++bj) *(u32x4*)(rowp + bj * HALF) = pack8(acc[ai][bj][m][0], acc[ai][bj][m][1]); }
        } else {
            const int col0 = (pn - 16) * BM + cw;
            f32x4 bv[2][2];
#pragma unroll
            for (int bj = 0; bj < 2; ++bj)
#pragma unroll
                for (int n = 0; n < 2; ++n) bv[bj][n] = *(const f32x4*)(bgate + col0 + bj * HALF + 4 * n);
#pragma unroll
            for (int ai = 0; ai < 2; ++ai)
#pragma unroll
                for (int m = 0; m < 4; ++m) { bf16_t* rowp = ZG + (size_t)(row0 + ai * HALF + m * 16) * 2048 + col0;
#pragma unroll
                    for (int bj = 0; bj < 2; ++bj) { f32x4 v[2];
#pragma unroll
                        for (int n = 0; n < 2; ++n) { const f32x4 a = acc[ai][bj][m][n] + bv[bj][n];
#pragma unroll
                            for (int j = 0; j < 4; ++j) v[n][j] = sigmoid_f(a[j]); }
                        *(u32x4*)(rowp + bj * HALF) = pack8(v[0], v[1]); } }
        }
    }
};
struct EpiPoolGroup {
    bf16_t* O; const float* bias; const float* scale;
    __device__ __forceinline__ void operator()(const Acc& acc, const Unit& u, int wr, int wc, int fr, int fq) const {
        const int row0 = u.pm * BM + wr * 64 + fr, col0 = u.pn * BM + wc * 32 + 8 * fq;
        f32x4 bv[2][2], sv[2][2];
#pragma unroll
        for (int bj = 0; bj < 2; ++bj)
#pragma unroll
            for (int n = 0; n < 2; ++n) { bv[bj][n] = *(const f32x4*)(bias + col0 + bj * HALF + 4 * n); sv[bj][n] = *(const f32x4*)(scale + col0 + bj * HALF + 4 * n); }
#pragma unroll
        for (int ai = 0; ai < 2; ++ai)
#pragma unroll
            for (int m = 0; m < 4; ++m) { bf16_t* rowp = O + (size_t)(row0 + ai * HALF + m * 16) * D + col0;
#pragma unroll
                for (int bj = 0; bj < 2; ++bj) *(u32x4*)(rowp + bj * HALF) = pack8((acc[ai][bj][m][0] + bv[bj][0]) * sv[bj][0], (acc[ai][bj][m][1] + bv[bj][1]) * sv[bj][1]); }
    }
};
struct EpiGateA {
    const bf16_t* ZG; float* M1;
    __device__ __forceinline__ void operator()(const Acc& acc, const Unit& u, int wr, int wc, int fr, int fq) const {
        const int row0 = u.pm * BM + wr * 64 + fr, col0 = u.pn * BM + wc * 32 + 8 * fq;
#pragma unroll
        for (int ai = 0; ai < 2; ++ai)
#pragma unroll
            for (int m = 0; m < 4; ++m) { const size_t r = (size_t)(row0 + ai * HALF + m * 16);
#pragma unroll
                for (int bj = 0; bj < 2; ++bj) { const u32x4 gq = *(const u32x4*)(ZG + r * 2048 + col0 + bj * HALF);
                    const f32x4 g0 = {bf_lo(gq.x), bf_hi(gq.x), bf_lo(gq.y), bf_hi(gq.y)}, g1 = {bf_lo(gq.z), bf_hi(gq.z), bf_lo(gq.w), bf_hi(gq.w)};
                    float* o = M1 + r * D + col0 + bj * HALF; *(f32x4*)o = g0 * acc[ai][bj][m][0]; *(f32x4*)(o + 4) = g1 * acc[ai][bj][m][1]; } }
    }
};
struct EpiGateP {
    const bf16_t* ZG; const float* M1; bf16_t* MM;
    __device__ __forceinline__ void operator()(const Acc& acc, const Unit& u, int wr, int wc, int fr, int fq) const {
        const int row0 = u.pm * BM + wr * 64 + fr, col0 = u.pn * BM + wc * 32 + 8 * fq;
#pragma unroll
        for (int ai = 0; ai < 2; ++ai)
#pragma unroll
            for (int m = 0; m < 4; ++m) { const size_t r = (size_t)(row0 + ai * HALF + m * 16);
#pragma unroll
                for (int bj = 0; bj < 2; ++bj) { const u32x4 gq = *(const u32x4*)(ZG + r * 2048 + D + col0 + bj * HALF);
                    const f32x4 g0 = {bf_lo(gq.x), bf_hi(gq.x), bf_lo(gq.y), bf_hi(gq.y)}, g1 = {bf_lo(gq.z), bf_hi(gq.z), bf_lo(gq.w), bf_hi(gq.w)};
                    const float* mi = M1 + r * D + col0 + bj * HALF; const f32x4 m0 = *(const f32x4*)mi, m1 = *(const f32x4*)(mi + 4);
                    *(u32x4*)(MM + r * D + col0 + bj * HALF) = pack8(m0 + g0 * acc[ai][bj][m][0], m1 + g1 * acc[ai][bj][m][1]); } }
    }
};
}


#define XB_TMO      128
#define XB_XCNT(j)  (256  + 64 * (j))
#define XB_XSUB(j)  (1280 + 64 * (j))
#define XB_XGEN(j)  (2304 + 64 * (j))
#define XB_TOP      3328
#define XB_TOPGEN   3392
#define XCD_BAR_WORDS 3456
#define XB_SPIN_CAP (1u << 18)

__device__ __forceinline__ unsigned xb_ld(unsigned* p)              { return __hip_atomic_load(p, __ATOMIC_RELAXED, __HIP_MEMORY_SCOPE_AGENT); }
__device__ __forceinline__ unsigned xb_add(unsigned* p, unsigned v) { return __hip_atomic_fetch_add(p, v, __ATOMIC_RELAXED, __HIP_MEMORY_SCOPE_AGENT); }
__device__ __forceinline__ unsigned xb_xcc_id() { return (unsigned)__builtin_amdgcn_s_getreg((3 << 11) | 20) & 0xFu; }
#define XB_SPIN(cond, bar) do { unsigned _sp = 0; while (cond) { __builtin_amdgcn_s_sleep(1); \
    if ((++_sp & 255u) == 0u) { if (xb_ld(&(bar)[XB_TMO])) break; if (_sp > XB_SPIN_CAP) { atomicAdd(&(bar)[XB_TMO], 1u); break; } } } } while (0)

struct XcdBarrier {
    unsigned* bar; unsigned x;
    volatile LAS unsigned* st;
};

__device__ __forceinline__ XcdBarrier xcd_barrier_post(unsigned* bar, volatile LAS unsigned* st) {
    XcdBarrier b; b.bar = bar; b.x = xb_xcc_id(); b.st = st;
    if (threadIdx.x == 0) (void)xb_add(&bar[XB_XCNT(b.x)], 1u);
    return b;
}
__device__ __forceinline__ void xcd_barrier_complete(unsigned* bar, unsigned x, unsigned& nloc, unsigned& nx) {
    const unsigned G = gridDim.x * gridDim.y * gridDim.z;
    unsigned sum, cnt, mine, sp = 0u;
    for (;;) {
        sum = 0u; cnt = 0u; mine = 0u;
#pragma unroll
        for (unsigned j = 0; j < 16; ++j) { const unsigned c = xb_ld(&bar[XB_XCNT(j)]); sum += c; cnt += (c > 0u) ? 1u : 0u; mine = (j == x) ? c : mine; }
        if (sum == G) break;
        __builtin_amdgcn_s_sleep(1);
        if ((++sp & 255u) == 0u) { if (xb_ld(&bar[XB_TMO])) break; if (sp > XB_SPIN_CAP) { atomicAdd(&bar[XB_TMO], 1u); break; } }
    }
    nloc = mine > 0u ? mine : 1u; nx = cnt > 0u ? cnt : 1u;
}

__device__ __forceinline__ void xcd_barrier(const XcdBarrier& b) {
    asm volatile("s_waitcnt vmcnt(0)" ::: "memory");
    __syncthreads();
    if (threadIdx.x == 0) {
        unsigned* bar = b.bar;
        __builtin_amdgcn_s_waitcnt(0);
        unsigned nloc = b.st[0], nx = b.st[1];
        if (nloc == 0u) { xcd_barrier_complete(bar, b.x, nloc, nx); b.st[0] = nloc; b.st[1] = nx; }
        const unsigned old = xb_add(&bar[XB_XSUB(b.x)], 1u);
        const unsigned gen = old / nloc;
        if (old + 1u == (gen + 1u) * nloc) {
            __builtin_amdgcn_fence(__ATOMIC_RELEASE, "agent");
            asm volatile("s_waitcnt vmcnt(0)" ::: "memory");
            const unsigned og = xb_add(&bar[XB_TOP], 1u);
            const unsigned tg = og / nx;
            if (og + 1u == (tg + 1u) * nx) xb_add(&bar[XB_TOPGEN], 1u);
            else XB_SPIN(xb_ld(&bar[XB_TOPGEN]) == tg, bar);
            __builtin_amdgcn_fence(__ATOMIC_ACQUIRE, "agent");
            xb_add(&bar[XB_XGEN(b.x)], 1u);
            asm volatile("s_waitcnt vmcnt(0)" ::: "memory");
        } else {
            XB_SPIN(xb_ld(&bar[XB_XGEN(b.x)]) == gen, bar);
            __builtin_amdgcn_fence(__ATOMIC_ACQUIRE, "agent");
            asm volatile("s_waitcnt vmcnt(0)" ::: "memory");
        }
    }
    __syncthreads();
}

struct Args { const float* in[20]; float* out; unsigned char* ws; int ph_lo, ph_hi; };
struct Ctx { LAS unsigned char* lds; int lane, wave, gw, NGW, G; };

__device__ __forceinline__ void transpose_item(const float* W, int ldsrc, int K, int src_col0, bf16_t* WT, int dst_row0, int k0, LAS float* scr, int lane) {
#pragma unroll 8
    for (int i = 0; i < 32; ++i) { const int kk = 2 * i + (lane >> 5); scr[kk * 33 + (lane & 31)] = W[(size_t)(k0 + kk) * ldsrc + src_col0 + (lane & 31)]; }
    LDS_WAIT(); asm volatile("" ::: "memory");
    const int c = lane & 7;
#pragma unroll
    for (int j = 0; j < 4; ++j) { const int n = (lane >> 3) + 8 * j; const LAS float* s = scr + (8 * c) * 33 + n;
        u32x4 o; o.x = cvt_pk_bf16(s[0 * 33], s[1 * 33]); o.y = cvt_pk_bf16(s[2 * 33], s[3 * 33]); o.z = cvt_pk_bf16(s[4 * 33], s[5 * 33]); o.w = cvt_pk_bf16(s[6 * 33], s[7 * 33]);
        *(u32x4*)(WT + (size_t)(dst_row0 + n) * K + k0 + 8 * c) = o; }
    LDS_WAIT(); asm volatile("" ::: "memory");
}
__device__ __forceinline__ int map_gu(int n) { return ((n >> 7) & 1) * FF + (n >> 8) * 128 + (n & 127); }
__device__ __forceinline__ int map_in(int n) { if (n < 1024 || n >= 3072) return n; const int q = (n - 1024) >> 8, h = (n >> 7) & 1; return (h ? 2048 : 1024) + q * 128 + (n & 127); }

__device__ __forceinline__ void prep_weights(const Ctx& F, const Args& a, int l) {
    LAS float* scr = (LAS float*)(F.lds + F.wave * 16384);
    unsigned char* ws = a.ws;
    constexpr int I_GU = (D / 64) * (NGU / 32), I_D = (FF / 64) * (D / 32), I_IN = (D / 64) * (NIN / 32), I_SQ = (D / 64) * (D / 32), I_PG = 4 * (256 / 64) * (256 / 32);
    constexpr int NITEMS = 2 * I_GU + 2 * I_D + I_IN + 3 * I_SQ + I_PG;
    for (int it = F.gw; it < NITEMS; it += F.NGW) {
        int r = it;
        if (r < 2 * I_GU) { const int w = r / I_GU; r -= w * I_GU; const int kb = r / (NGU / 32), nb = r % (NGU / 32);
            transpose_item(a.in[w ? 18 : 3] + (size_t)l * D * NGU, NGU, D, map_gu(32 * nb), (bf16_t*)(ws + (w ? W_GU2 : W_GU1)), 32 * nb, 64 * kb, scr, F.lane); continue; }
        r -= 2 * I_GU;
        if (r < 2 * I_D) { const int w = r / I_D; r -= w * I_D; const int kb = r / (D / 32), nb = r % (D / 32);
            transpose_item(a.in[w ? 19 : 4] + (size_t)l * FF * D, D, FF, 32 * nb, (bf16_t*)(ws + (w ? W_D2 : W_D1)), 32 * nb, 64 * kb, scr, F.lane); continue; }
        r -= 2 * I_D;
        if (r < I_IN) { const int kb = r / (NIN / 32), nb = r % (NIN / 32);
            transpose_item(a.in[7] + (size_t)l * D * NIN, NIN, D, map_in(32 * nb), (bf16_t*)(ws + W_IN), 32 * nb, 64 * kb, scr, F.lane); continue; }
        r -= I_IN;
        if (r < 3 * I_SQ) { const int w = r / I_SQ; r -= w * I_SQ; const int kb = r / (D / 32), nb = r % (D / 32);
            transpose_item(a.in[w == 0 ? 10 : (w == 1 ? 14 : 15)] + (size_t)l * D * D, D, D, 32 * nb, (bf16_t*)(ws + (w == 0 ? W_CO : (w == 1 ? W_PO : W_WO))), 32 * nb, 64 * kb, scr, F.lane); continue; }
        r -= 3 * I_SQ;
        { const int gi = r / 32; r -= gi * 32; const int kb = r / 8, nb = r % 8;
            transpose_item(a.in[11] + (size_t)l * 4 * 65536 + (size_t)gi * 65536, 256, 256, 32 * nb, (bf16_t*)(ws + W_PG), gi * 256 + 32 * nb, 64 * kb, scr, F.lane); }
    }
}

__device__ __forceinline__ void norm_rows(const Ctx& F, const float* x, const float* g, bf16_t* A) {
    f32x4 gv[4];
#pragma unroll
    for (int j = 0; j < 4; ++j) gv[j] = ((const f32x4*)g)[F.lane + 64 * j];
    for (int m = F.gw; m < M; m += F.NGW) {
        const f32x4* xr = (const f32x4*)(x + (size_t)m * D) + F.lane;
        f32x4 v[4]; float s = 0.f;
#pragma unroll
        for (int j = 0; j < 4; ++j) { v[j] = xr[64 * j]; s += (v[j].x * v[j].x + v[j].y * v[j].y) + (v[j].z * v[j].z + v[j].w * v[j].w); }
        const float r = 1.0f / sqrtf(wave_sum(s, F.lane) * (1.f / D) + EPS);
        u32x2* o = (u32x2*)(A + (size_t)m * D) + F.lane;
#pragma unroll
        for (int j = 0; j < 4; ++j) { const f32x4 y = v[j] * r * gv[j]; u32x2 w; w.x = cvt_pk_bf16(y.x, y.y); w.y = cvt_pk_bf16(y.z, y.w); o[64 * j] = w; }
    }
}
__device__ __forceinline__ void resid_rows(const Ctx& F, const float* xin, float* xout, const float* h, const float* post, float cs, const float* pre, bf16_t* A) {
    f32x4 pv[4], qv[4];
#pragma unroll
    for (int j = 0; j < 4; ++j) { pv[j] = ((const f32x4*)post)[F.lane + 64 * j] * cs; qv[j] = pre ? ((const f32x4*)pre)[F.lane + 64 * j] : (f32x4){0.f, 0.f, 0.f, 0.f}; }
    for (int m = F.gw; m < M; m += F.NGW) {
        const f32x4* hr = (const f32x4*)(h + (size_t)m * D) + F.lane; const f32x4* xr = (const f32x4*)(xin + (size_t)m * D) + F.lane;
        f32x4 hv[4], xv[4]; float s = 0.f;
#pragma unroll
        for (int j = 0; j < 4; ++j) { hv[j] = hr[64 * j]; xv[j] = xr[64 * j]; }
#pragma unroll
        for (int j = 0; j < 4; ++j) s += (hv[j].x * hv[j].x + hv[j].y * hv[j].y) + (hv[j].z * hv[j].z + hv[j].w * hv[j].w);
        const float r1 = 1.0f / sqrtf(wave_sum(s, F.lane) * (1.f / D) + EPS);
        float s2 = 0.f;
        f32x4* xo = (f32x4*)(xout + (size_t)m * D) + F.lane;
#pragma unroll
        for (int j = 0; j < 4; ++j) { xv[j] = xv[j] + hv[j] * r1 * pv[j]; xo[64 * j] = xv[j]; s2 += (xv[j].x * xv[j].x + xv[j].y * xv[j].y) + (xv[j].z * xv[j].z + xv[j].w * xv[j].w); }
        if (pre) {
            const float r2 = 1.0f / sqrtf(wave_sum(s2, F.lane) * (1.f / D) + EPS);
            u32x2* o = (u32x2*)(A + (size_t)m * D) + F.lane;
#pragma unroll
            for (int j = 0; j < 4; ++j) { const f32x4 y = xv[j] * r2 * qv[j]; u32x2 w; w.x = cvt_pk_bf16(y.x, y.y); w.y = cvt_pk_bf16(y.z, y.w); o[64 * j] = w; }
        }
    }
}
__device__ __forceinline__ void unpack8(const u32x4 q, float (&f)[8]) { f[0] = bf_lo(q.x); f[1] = bf_hi(q.x); f[2] = bf_lo(q.y); f[3] = bf_hi(q.y); f[4] = bf_lo(q.z); f[5] = bf_hi(q.z); f[6] = bf_lo(q.w); f[7] = bf_hi(q.w); }
__device__ __forceinline__ void mix_rows(const Ctx& F, const bf16_t* ZB, const bf16_t* ZCV, const bf16_t* ZP, const float* convw, bf16_t* CA, bf16_t* DDo) {
    const int half = F.gw & 1, c0 = half * 512 + F.lane * 8;
    const int npair = F.NGW >> 1, tpw = (M + npair - 1) / npair, t0 = (F.gw >> 1) * tpw;
    float w0[8], w1[8], w2[8];
#pragma unroll
    for (int j = 0; j < 8; ++j) { w0[j] = convw[c0 + j]; w1[j] = convw[D + c0 + j]; w2[j] = convw[2 * D + c0 + j]; }
    const int win = 2 << (c0 >> 8), wmax = half ? 16 : 4;
    for (int t = t0; t < t0 + tpw && t < M; ++t) {
        const int s = t & (SEQ - 1);
        const size_t off = (size_t)t * D + c0;
        const u32x4 zero = {0u, 0u, 0u, 0u};
        const u32x4 qb = *(const u32x4*)(ZB + off), q2 = *(const u32x4*)(ZCV + off);
        const u32x4 q1 = s >= 1 ? *(const u32x4*)(ZCV + off - D) : zero, q0 = s >= 2 ? *(const u32x4*)(ZCV + off - 2 * D) : zero;
        const u32x4 qp = *(const u32x4*)(ZP + off);
        float fb[8], f0[8], f1[8], f2[8], fp[8], acc[8];
        unpack8(qb, fb); unpack8(q0, f0); unpack8(q1, f1); unpack8(q2, f2); unpack8(qp, fp);
#pragma unroll
        for (int j = 0; j < 8; ++j) acc[j] = fp[j];
        for (int k = 1; k < wmax; ++k) {
            const bool ok = (k < win) && (s >= k);
            const u32x4 q = ok ? *(const u32x4*)(ZP + off - (size_t)k * D) : zero;
            float f[8]; unpack8(q, f);
#pragma unroll
            for (int j = 0; j < 8; ++j) acc[j] += f[j];
        }
        const float inv = 1.0f / (float)((s + 1) < win ? (s + 1) : win);
        float ca[8], dd[8];
#pragma unroll
        for (int j = 0; j < 8; ++j) { ca[j] = fb[j] * (w0[j] * f0[j] + w1[j] * f1[j] + w2[j] * f2[j]); dd[j] = acc[j] * inv - fp[j]; }
        u32x4 o1, o2;
        o1.x = cvt_pk_bf16(ca[0], ca[1]); o1.y = cvt_pk_bf16(ca[2], ca[3]); o1.z = cvt_pk_bf16(ca[4], ca[5]); o1.w = cvt_pk_bf16(ca[6], ca[7]);
        o2.x = cvt_pk_bf16(dd[0], dd[1]); o2.y = cvt_pk_bf16(dd[2], dd[3]); o2.z = cvt_pk_bf16(dd[4], dd[5]); o2.w = cvt_pk_bf16(dd[6], dd[7]);
        *(u32x4*)(CA + off) = o1; *(u32x4*)(DDo + off) = o2;
    }
}


__device__ __forceinline__ void dump_cols(const Ctx& F, float* out, int c0, int ncols, const void* src, int ld, bool isf32) {
    for (int m = F.gw; m < M; m += F.NGW)
        for (int c = F.lane; c < ncols; c += 64)
            out[(size_t)m * D + c0 + c] = isf32 ? ((const float*)src)[(size_t)m * ld + c] : bf_lo((unsigned)((const bf16_t*)src)[(size_t)m * ld + c]);
}
#ifndef MK_DUMP
#define MK_DUMP 0
#endif
__device__ __forceinline__ bool launder(Ctx& F, unsigned char*& ws, int& tidv) { int t; asm volatile("v_mbcnt_lo_u32_b32 %0, -1, 0\n\tv_mbcnt_hi_u32_b32 %0, -1, %0" : "=v"(t)); F.lane = t; tidv = F.wave * 64 + t; const unsigned long long w0 = (unsigned long long)ws; unsigned wl = __builtin_amdgcn_readfirstlane((unsigned)w0), wh = __builtin_amdgcn_readfirstlane((unsigned)(w0 >> 32)); asm volatile("" : "+s"(wl), "+s"(wh));
    const unsigned long long w = ((unsigned long long)wh << 32) | wl; ws = (unsigned char*)(__attribute__((address_space(1))) unsigned char*)w; return true; }
constexpr int PH_PER_LAYER = 13, N_PHASES = 1 + DEPTH * PH_PER_LAYER;

__global__ void __launch_bounds__(512, 2) mega_fwd(Args a) {
    extern __shared__ __attribute__((aligned(16))) unsigned char lds_raw[];
    Ctx F; F.lds = (LAS unsigned char*)lds_raw; F.lane = threadIdx.x & 63; F.wave = __builtin_amdgcn_readfirstlane(threadIdx.x >> 6);
    F.G = gridDim.x; F.gw = blockIdx.x * 8 + F.wave; F.NGW = F.G * 8;
    unsigned char* ws = a.ws; int tidv = threadIdx.x;
    const int lo = a.ph_lo, hi = a.ph_hi;
    volatile LAS unsigned* MISC = (volatile LAS unsigned*)(F.lds + MISC_OFF);
    if (threadIdx.x < 32) MISC[threadIdx.x] = 0u;
    __syncthreads();
    XcdBarrier bar; bar.bar = (unsigned*)(ws + WS_BAR); bar.x = 0; bar.st = nullptr;
    if (hi - lo > 1) bar = xcd_barrier_post((unsigned*)(ws + WS_BAR), MISC + 8);
    if (lo < 0) cg::this_grid().sync();
#if MK_DUMP == 4
    if (lo == 100) { dump_cols(F, a.out, 0, 256, ws + WS_ZB, D, false); dump_cols(F, a.out, 256, 256, ws + WS_ZCV, D, false); dump_cols(F, a.out, 512, 256, ws + WS_ZP, D, false); dump_cols(F, a.out, 768, 256, ws + WS_ZG, 2048, false); return; }
#endif
    int ph = 0;
#define IN_PH (lo <= ph && ph < hi && launder(F, ws, tidv))
#define SEAM() do { if (lo <= ph && ph + 1 < hi) { xcd_barrier(bar); } ++ph; } while (0)
    bf16_t* const A = (bf16_t*)(ws + WS_A);
    float* const X = a.out;
    if (IN_PH) { prep_weights(F, a, 0); norm_rows(F, a.in[0], a.in[1], A);
#if MK_DUMP
        { u32x4* z = (u32x4*)(ws + WS_R0); const size_t n16 = (WS_END - WS_R0) / 16; const u32x4 zz = {0u, 0u, 0u, 0u};
          for (size_t i = (size_t)F.gw * 64 + F.lane; i < n16; i += (size_t)F.NGW * 64) z[i] = zz; }
#endif
    }
    SEAM();
    for (int l = 0; l < DEPTH; ++l) {
        const float* xin = (l == 0) ? a.in[0] : X;
        if (IN_PH) { pg8::Gemm g{A, (const bf16_t*)(ws + W_GU1), M, NGU, D, D, 0}; pg8::StaticOrder S; S.init(M, NGU, F.G, blockIdx.x);
            pg8::EpiSwiglu E{(bf16_t*)(ws + WS_HH)}; pg8::gemm_phase(F.lds, g, S, E, tidv); }
        SEAM();
        if (IN_PH) { pg8::Gemm g{(const bf16_t*)(ws + WS_HH), (const bf16_t*)(ws + W_D1), M, D, FF, FF, 0}; pg8::StaticOrder S; S.init(M, D, F.G, blockIdx.x);
            pg8::EpiF32 E{(float*)(ws + WS_HFFN)}; pg8::gemm_phase(F.lds, g, S, E, tidv); }
        SEAM();
        if (IN_PH) resid_rows(F, xin, X, (const float*)(ws + WS_HFFN), a.in[2] + l * D, 0.5f, a.in[5] + l * D, A);
        SEAM();
        if (IN_PH) { pg8::Gemm g{A, (const bf16_t*)(ws + W_IN), M, NIN, D, D, 0}; pg8::StaticOrder S; S.init(M, NIN, F.G, blockIdx.x);
            pg8::EpiWin E{(bf16_t*)(ws + WS_ZB), (bf16_t*)(ws + WS_ZCV), (bf16_t*)(ws + WS_ZP), (bf16_t*)(ws + WS_ZG), a.in[8] + l * 2 * D}; pg8::gemm_phase(F.lds, g, S, E, tidv); }
        SEAM();
        if (IN_PH) mix_rows(F, (const bf16_t*)(ws + WS_ZB), (const bf16_t*)(ws + WS_ZCV), (const bf16_t*)(ws + WS_ZP), a.in[9] + l * 3 * D, A, (bf16_t*)(ws + WS_DD));
        SEAM();
        if (IN_PH) {
            { pg8::Gemm g{(const bf16_t*)(ws + WS_DD), (const bf16_t*)(ws + W_PG), M, D, 256, D, 256}; pg8::StaticOrder S; S.init(M, D, F.G, blockIdx.x);
              pg8::EpiPoolGroup E{(bf16_t*)(ws + WS_YP0), a.in[12] + l * D, a.in[13] + l * D}; pg8::gemm_phase(F.lds, g, S, E, tidv); }
        }
        SEAM();
#if MK_DUMP == 6
        if (l == 0) { xcd_barrier(bar); dump_cols(F, a.out, 0, 1024, ws + WS_YP0, D, false); return; }
#endif
#if MK_DUMP == 8
        if (l == 0) { xcd_barrier(bar); dump_cols(F, a.out, 0, 1024, ws + WS_ZG, 2048, false); return; }
#endif
        if (IN_PH) {
            { pg8::Gemm g{A, (const bf16_t*)(ws + W_CO), M, D, D, D, 0}; pg8::StaticOrder S; S.init(M, D, F.G, blockIdx.x);
              pg8::EpiGateA E{(const bf16_t*)(ws + WS_ZG), (float*)(ws + WS_M1)}; pg8::gemm_phase(F.lds, g, S, E, tidv); }
        }
        SEAM();
#if MK_DUMP == 7
        if (l == 0) { xcd_barrier(bar); dump_cols(F, a.out, 0, 1024, ws + WS_M1, D, true); return; }
#endif
#if MK_DUMP == 3
        if (l == 0) { xcd_barrier(bar); dump_cols(F, a.out, 0, 1024, ws + WS_A, D, false); return; }
#endif
#if MK_DUMP == 4 && MK_ONE_LAUNCH
        if (l == 0) { xcd_barrier(bar); dump_cols(F, a.out, 0, 256, ws + WS_ZB, D, false); dump_cols(F, a.out, 256, 256, ws + WS_ZCV, D, false); dump_cols(F, a.out, 512, 256, ws + WS_ZP, D, false); dump_cols(F, a.out, 768, 256, ws + WS_ZG, 2048, false); return; }
#endif
#if MK_DUMP == 5
        if (l == 0) { xcd_barrier(bar); dump_cols(F, a.out, 0, 512, ws + WS_A, D, false); dump_cols(F, a.out, 512, 512, ws + WS_DD, D, false); return; }
#endif
        if (IN_PH) { pg8::Gemm g{(const bf16_t*)(ws + WS_YP0), (const bf16_t*)(ws + W_PO), M, D, D, D, 0}; pg8::StaticOrder S; S.init(M, D, F.G, blockIdx.x);
            pg8::EpiGateP E{(const bf16_t*)(ws + WS_ZG), (const float*)(ws + WS_M1), (bf16_t*)(ws + WS_MM)}; pg8::gemm_phase(F.lds, g, S, E, tidv); }
        SEAM();
        if (IN_PH) { pg8::Gemm g{(const bf16_t*)(ws + WS_MM), (const bf16_t*)(ws + W_WO), M, D, D, D, 0}; pg8::StaticOrder S; S.init(M, D, F.G, blockIdx.x);
            pg8::EpiF32 E{(float*)(ws + WS_HMIX)}; pg8::gemm_phase(F.lds, g, S, E, tidv); }
        SEAM();
        if (IN_PH) resid_rows(F, X, X, (const float*)(ws + WS_HMIX), a.in[6] + l * D, 1.0f, a.in[16] + l * D, A);
        SEAM();
        if (IN_PH) { pg8::Gemm g{A, (const bf16_t*)(ws + W_GU2), M, NGU, D, D, 0}; pg8::StaticOrder S; S.init(M, NGU, F.G, blockIdx.x);
            pg8::EpiSwiglu E{(bf16_t*)(ws + WS_HH)}; pg8::gemm_phase(F.lds, g, S, E, tidv); }
        SEAM();
        if (IN_PH) { pg8::Gemm g{(const bf16_t*)(ws + WS_HH), (const bf16_t*)(ws + W_D2), M, D, FF, FF, 0}; pg8::StaticOrder S; S.init(M, D, F.G, blockIdx.x);
            pg8::EpiF32 E{(float*)(ws + WS_HFFN)}; pg8::gemm_phase(F.lds, g, S, E, tidv); }
        SEAM();
        if (IN_PH) { const bool more = (l + 1 < DEPTH);
            resid_rows(F, X, X, (const float*)(ws + WS_HFFN), a.in[17] + l * D, 0.5f, more ? a.in[1] + (l + 1) * D : nullptr, A);
            if (more) prep_weights(F, a, l + 1); }
        SEAM();
    }
#undef IN_PH
#undef SEAM
}

extern "C" void kernel_launch(void* const* d_in, const int* in_sizes, int n_in, void* d_out, int out_size, void* d_ws, size_t ws_size, hipStream_t stream) {
    static int grid = 0;
    if (grid == 0) {
        if (n_in != 20 || in_sizes[0] != M * D || out_size != M * D || ws_size < WS_END) { fprintf(stderr, "kernel_launch: unexpected shapes (n_in %d, in0 %d, out %d, ws %zu < %zu)\n", n_in, n_in > 0 ? in_sizes[0] : -1, out_size, ws_size, (size_t)WS_END); grid = -1; return; }
        int dev = 0, cus = 0, per_cu = 0;
        hipGetDevice(&dev); hipDeviceGetAttribute(&cus, hipDeviceAttributeMultiprocessorCount, dev);
        if (hipFuncSetAttribute((const void*)mega_fwd, hipFuncAttributeMaxDynamicSharedMemorySize, LDS_BYTES) != hipSuccess) { fprintf(stderr, "kernel_launch: hipFuncSetAttribute failed\n"); grid = -1; return; }
        if (hipOccupancyMaxActiveBlocksPerMultiprocessor(&per_cu, (const void*)mega_fwd, 512, LDS_BYTES) != hipSuccess || per_cu < 1) { fprintf(stderr, "kernel_launch: occupancy query says %d\n", per_cu); per_cu = 1; (void)hipGetLastError(); }
        grid = cus * per_cu;
    }
    if (grid < 0) return;
    Args a{};
    for (int i = 0; i < 20; ++i) a.in[i] = (const float*)d_in[i];
    a.out = (float*)d_out; a.ws = (unsigned char*)d_ws;
#if MK_ONE_LAUNCH
    if (hipMemsetAsync((char*)d_ws, 0, CTL_ZERO_BYTES, stream) != hipSuccess) { fprintf(stderr, "kernel_launch: memset failed\n"); return; }
    a.ph_lo = 0; a.ph_hi = N_PHASES < MK_STOP ? N_PHASES : MK_STOP;
    void* args[] = {&a};
    hipError_t e = hipLaunchCooperativeKernel((const void*)mega_fwd, dim3(grid), dim3(512), args, LDS_BYTES, stream);
    if (e != hipSuccess) fprintf(stderr, "cooperative launch failed: %s (grid %d)\n", hipGetErrorString(e), grid);
#else
    for (int p = 0; p < N_PHASES && p < MK_STOP; ++p) { a.ph_lo = p; a.ph_hi = p + 1; hipLaunchKernelGGL(mega_fwd, dim3(grid), dim3(512), LDS_BYTES, stream, a); }
#if MK_DUMP == 4
    a.ph_lo = 100; a.ph_hi = 101; hipLaunchKernelGGL(mega_fwd, dim3(grid), dim3(512), LDS_BYTES, stream, a);
#endif
#endif
}
```

```cpp
#include <hip/hip_runtime.h>
#include <hip/hip_cooperative_groups.h>
#include <cstdio>
#include <cstdint>
namespace cg = cooperative_groups;

#ifndef MK_STOP
#define MK_STOP (MK_DUMP ? (MK_DUMP == 8 ? 7 : MK_DUMP + 1) : 999)
#endif
#ifndef MK_ONE_LAUNCH
#define MK_ONE_LAUNCH 1
#endif

#define LAS __attribute__((address_space(3)))
typedef unsigned short bf16_t;
typedef short bf16x8 __attribute__((ext_vector_type(8)));
typedef float f32x4 __attribute__((ext_vector_type(4)));
typedef unsigned u32x4 __attribute__((ext_vector_type(4)));
typedef unsigned u32x2 __attribute__((ext_vector_type(2)));

constexpr int D = 1024, SEQ = 2048, BATCH = 16, M = BATCH * SEQ, FF = 2816, NGU = 2 * FF, NIN = 6144, DEPTH = 2;
constexpr float EPS = 1e-6f;
constexpr size_t MiB = 1u << 20;
constexpr size_t WS_W = 1 * MiB;
constexpr size_t W_GU1 = WS_W, W_D1 = W_GU1 + (size_t)NGU * D * 2, W_IN = W_D1 + (size_t)D * FF * 2, W_PG = W_IN + (size_t)NIN * D * 2,
                 W_CO = W_PG + (size_t)D * 256 * 2, W_PO = W_CO + (size_t)D * D * 2, W_WO = W_PO + (size_t)D * D * 2, W_GU2 = W_WO + (size_t)D * D * 2,
                 W_D2 = W_GU2 + (size_t)NGU * D * 2, W_END = W_D2 + (size_t)D * FF * 2;
static_assert(W_END <= 56 * MiB, "weights");
constexpr size_t WS_A = 56 * MiB;
constexpr size_t WS_R0 = 120 * MiB;
constexpr size_t WS_ZG = WS_R0;
constexpr size_t WS_ZB = WS_R0 + 128 * MiB;
constexpr size_t WS_ZCV = WS_ZB + 64 * MiB;
constexpr size_t WS_ZP = WS_ZCV + 64 * MiB;
constexpr size_t WS_DD = WS_ZP + 64 * MiB;
constexpr size_t WS_YP0 = WS_ZB;
constexpr size_t WS_M1 = WS_ZCV;
constexpr size_t WS_MM = WS_DD;
constexpr size_t WS_HMIX = WS_R0;
constexpr size_t WS_HH = WS_R0;
constexpr size_t WS_HFFN = WS_ZCV;
constexpr size_t WS_END = WS_DD + 64 * MiB;
static_assert(WS_HH + (size_t)M * FF * 2 <= WS_HFFN, "H overlay");
constexpr int LDS_BYTES = 147456, MISC_OFF = 131072 + 320;
constexpr size_t WS_BAR = 16384, CTL_ZERO_BYTES = 65536;

typedef float f32x2 __attribute__((ext_vector_type(2)));
typedef __bf16 bf16x2 __attribute__((ext_vector_type(2)));
__device__ __forceinline__ unsigned cvt_pk_bf16(float lo, float hi) { const f32x2 v = {lo, hi}; const bf16x2 b = __builtin_convertvector(v, bf16x2); return __builtin_bit_cast(unsigned, b); }
__device__ __forceinline__ float bf_lo(unsigned u) { return __builtin_bit_cast(float, u << 16); }
__device__ __forceinline__ float bf_hi(unsigned u) { return __builtin_bit_cast(float, u & 0xffff0000u); }
__device__ __forceinline__ float sigmoid_f(float x) { return __builtin_amdgcn_rcpf(1.0f + __expf(-x)); }
__device__ __forceinline__ float wave_sum(float v, int lane) {
#pragma unroll
    for (int o = 1; o < 64; o <<= 1) v += __builtin_bit_cast(float, __builtin_amdgcn_ds_bpermute((lane ^ o) << 2, __builtin_bit_cast(int, v)));
    return v;
}
#define LDS_WAIT() asm volatile("s_waitcnt lgkmcnt(0)" ::: "memory")

namespace pg8 {
constexpr int BM = 256, BK = 64, HALF = 128, HTB = HALF * BK * 2, STAGE_BYTES = 8 * HTB, NXCD = 8, WGM = 8;
__host__ __device__ __forceinline__ int lds_byte(int r, int c) { const int st = (r >> 4) * 2 + (c >> 5), rr = r & 15, cc = c & 31, ob = rr * 64 + cc * 2; return st * 1024 + (ob ^ (((ob >> 9) & 1) << 5)); }
__host__ __device__ __forceinline__ void stage_rc(int b, int& R, int& C) { const int st = b / 1024, sb = b % 1024, swz = sb ^ (((sb >> 9) & 1) << 5); R = (st >> 1) * 16 + swz / 64; C = (st & 1) * 32 + (swz % 64) / 2; }
__host__ __device__ __forceinline__ int perm32(int rho) { const int n = rho >> 4, i = rho & 15; return 8 * (i >> 2) + 4 * n + (i & 3); }

struct Unit { int pm, pn; };
struct Gemm { const bf16_t* A; const bf16_t* Bt; int M, N, K, lda, a_pn_cols; };

struct StaticOrder {
    int nM, nN, nwg, G, c;
    __host__ __device__ void init(int M_, int N_, int G_, int c_) { nM = M_ / BM; nN = N_ / BM; nwg = nM * nN; G = G_; c = c_; }
    __host__ __device__ bool next(int i, Unit& u) const {
        const long L = (long)i * G + c; if (L >= nwg) return false;
        int wgid = (int)L; { const int q = nwg / NXCD, r = nwg % NXCD, xcd = wgid % NXCD, off = wgid / NXCD; wgid = (xcd < r ? xcd * (q + 1) : r * (q + 1) + (xcd - r) * q) + off; }
        const int nig = WGM * nN, gid = wgid / nig, fm = gid * WGM, gsz = (nM - fm) < WGM ? (nM - fm) : WGM;
        u.pm = fm + ((wgid % nig) % gsz); u.pn = (wgid % nig) / gsz; return true;
    }
};

typedef f32x4 Acc[2][2][4][2];
__device__ __forceinline__ const char* uni(const char* p) { const unsigned long long v = (unsigned long long)p; const unsigned lo = __builtin_amdgcn_readfirstlane((unsigned)v), hi = __builtin_amdgcn_readfirstlane((unsigned)(v >> 32)); return (const char*)(((unsigned long long)hi << 32) | lo); }

template <class Epi>
__device__ __forceinline__ void gemm_phase(LAS unsigned char* lds, const Gemm g, const StaticOrder& S, const Epi& E, const int tid) {
    const int wid = __builtin_amdgcn_readfirstlane(tid >> 6), lane = tid & 63, wr = wid >> 2, wc = wid & 3, fr = lane & 15, fq = lane >> 4;
    const int K = g.K, nt = K / BK;
    unsigned voffA[2], voffB[2];
#pragma unroll
    for (int i = 0; i < 2; ++i) { int R, C; stage_rc(tid * 16 + i * 8192, R, C); const int Rb = (R & ~31) + perm32(R & 31);
        voffA[i] = (unsigned)(R * g.lda + C) * 2u; voffB[i] = (unsigned)(Rb * K + C) * 2u; }
    const size_t kstep = (size_t)(BK * 2);
    const size_t hstepA = (size_t)HALF * g.lda * 2, tstepA = 2 * hstepA;
    const size_t hstepB = (size_t)HALF * K * 2, tstepB = 2 * hstepB;
    const size_t pnA = (size_t)g.a_pn_cols * 2;
    const unsigned ldsw = (unsigned)wid * 1024u;
    const int aoff = lds_byte(wr * 64 + fr, fq * 8), boff = lds_byte(wc * 32 + fr, fq * 8);
#define PG8_SA(b, h) (((b) * 2 + (h)) * HTB)
#define PG8_SB(b, h) ((4 + (b) * 2 + (h)) * HTB)
#define PG8_STAGE(bufoff, gbase, voff) do { _Pragma("unroll") for (int _i = 0; _i < 2; ++_i) \
        __builtin_amdgcn_global_load_lds((const unsigned*)((const char*)(gbase) + (voff)[_i]), (LAS unsigned*)(lds + (bufoff) + ldsw + _i * 8192), 16, 0, 0); } while (0)
#define PG8_LDA(dst, b, h) do { _Pragma("unroll") for (int m = 0; m < 4; ++m) _Pragma("unroll") for (int k = 0; k < 2; ++k) dst[m][k] = *(const LAS bf16x8*)(lds + PG8_SA(b, h) + aoff + m * 2048 + k * 1024); } while (0)
#define PG8_LDB(dst, b, h) do { _Pragma("unroll") for (int n = 0; n < 2; ++n) _Pragma("unroll") for (int k = 0; k < 2; ++k) dst[n][k] = *(const LAS bf16x8*)(lds + PG8_SB(b, h) + boff + n * 2048 + k * 1024); } while (0)
#define PG8_MMA(ai, bj, At, Bt) do { __builtin_amdgcn_s_setprio(1); _Pragma("unroll") for (int m = 0; m < 4; ++m) _Pragma("unroll") for (int n = 0; n < 2; ++n) _Pragma("unroll") for (int k = 0; k < 2; ++k) \
        acc[ai][bj][m][n] = __builtin_amdgcn_mfma_f32_16x16x32_bf16(Bt[n][k], At[m][k], acc[ai][bj][m][n], 0, 0, 0); __builtin_amdgcn_s_setprio(0); } while (0)
#define PG8_WAIT_V(n) asm volatile("s_waitcnt vmcnt(" #n ")" ::: "memory")
#define PG8_WAIT_L(n) asm volatile("s_waitcnt lgkmcnt(" #n ")" ::: "memory")
#define PG8_BAR __builtin_amdgcn_s_barrier()
#define PG8_SCHED __builtin_amdgcn_sched_barrier(0)
    Unit cur, nxt; int ui = 0;
    if (!S.next(0, cur)) return;
    Acc acc;
#pragma unroll
    for (int a = 0; a < 2; ++a)
#pragma unroll
        for (int b = 0; b < 2; ++b)
#pragma unroll
            for (int m = 0; m < 4; ++m)
#pragma unroll
                for (int n = 0; n < 2; ++n) acc[a][b][m][n] = (f32x4){0.f, 0.f, 0.f, 0.f};
    bf16x8 At[4][2], B0[2][2], B1[2][2];
    const char* cA = uni((const char*)g.A + (size_t)cur.pm * tstepA + (size_t)cur.pn * pnA); const char* cB = uni((const char*)g.Bt + (size_t)cur.pn * tstepB);
    PG8_STAGE(PG8_SB(0, 0), cB, voffB); PG8_STAGE(PG8_SB(0, 1), cB + hstepB, voffB); PG8_STAGE(PG8_SA(0, 0), cA, voffA); PG8_STAGE(PG8_SA(0, 1), cA + hstepA, voffA);
    if (wr == 1) PG8_BAR;
    PG8_WAIT_V(2); PG8_BAR;
    PG8_STAGE(PG8_SB(1, 0), cB + kstep, voffB); PG8_STAGE(PG8_SA(1, 0), cA + kstep, voffA); PG8_STAGE(PG8_SB(1, 1), cB + hstepB + kstep, voffB);
    PG8_WAIT_V(6); PG8_BAR;
    for (;;) {
        const bool has_next = S.next(ui + 1, nxt);
        const char* nA = uni(has_next ? (const char*)g.A + (size_t)nxt.pm * tstepA + (size_t)nxt.pn * pnA : cA); const char* nB = uni(has_next ? (const char*)g.Bt + (size_t)nxt.pn * tstepB : cB);
#pragma unroll 1
        for (int t = 0; t < nt; t += 2) {
            const bool last = (t == nt - 2);
            const char* a1 = cA + (size_t)(t + 1) * kstep;
            const char* a2 = last ? nA : cA + (size_t)(t + 2) * kstep; const char* b2 = last ? nB : cB + (size_t)(t + 2) * kstep;
            const char* a3 = a2 + kstep; const char* b3 = b2 + kstep;
            PG8_LDB(B0, 0, 0); PG8_LDB(B1, 0, 1); PG8_SCHED; PG8_LDA(At, 0, 0); PG8_STAGE(PG8_SA(1, 1), a1 + hstepA, voffA);
            PG8_WAIT_V(8); PG8_WAIT_L(0); PG8_BAR; PG8_MMA(0, 0, At, B0); PG8_MMA(0, 1, At, B1); PG8_BAR; PG8_SCHED;
            PG8_LDA(At, 0, 1); PG8_STAGE(PG8_SB(0, 0), b2, voffB); PG8_STAGE(PG8_SB(0, 1), b2 + hstepB, voffB); PG8_STAGE(PG8_SA(0, 0), a2, voffA);
            PG8_WAIT_V(8); PG8_WAIT_L(0); PG8_BAR; PG8_MMA(1, 0, At, B0); PG8_MMA(1, 1, At, B1); PG8_BAR; PG8_SCHED;
            PG8_LDB(B0, 1, 0); PG8_LDB(B1, 1, 1); PG8_SCHED; PG8_LDA(At, 1, 0); PG8_STAGE(PG8_SA(0, 1), a2 + hstepA, voffA);
            PG8_WAIT_V(8); PG8_WAIT_L(0); PG8_BAR; PG8_MMA(0, 0, At, B0); PG8_MMA(0, 1, At, B1); PG8_BAR; PG8_SCHED;
            PG8_LDA(At, 1, 1); PG8_STAGE(PG8_SB(1, 0), b3, voffB); PG8_STAGE(PG8_SB(1, 1), b3 + hstepB, voffB); PG8_STAGE(PG8_SA(1, 0), a3, voffA);
            PG8_WAIT_V(8); PG8_WAIT_L(0); PG8_BAR; PG8_MMA(1, 0, At, B0); PG8_MMA(1, 1, At, B1); PG8_BAR; PG8_SCHED;
        }
        if (wr == 0) PG8_BAR;
        E(acc, cur, wr, wc, fr, fq);
        if (!has_next) break;
#pragma unroll
        for (int a = 0; a < 2; ++a)
#pragma unroll
            for (int b = 0; b < 2; ++b)
#pragma unroll
                for (int m = 0; m < 4; ++m)
#pragma unroll
                    for (int n = 0; n < 2; ++n) acc[a][b][m][n] = (f32x4){0.f, 0.f, 0.f, 0.f};
        cur = nxt; cA = nA; cB = nB; ++ui;
        if (wr == 1) PG8_BAR;
    }
    PG8_WAIT_V(0);
    PG8_BAR;
#undef PG8_SA
#undef PG8_SB
#undef PG8_STAGE
#undef PG8_LDA
#undef PG8_LDB
#undef PG8_MMA
#undef PG8_WAIT_V
#undef PG8_WAIT_L
#undef PG8_BAR
#undef PG8_SCHED
}

__device__ __forceinline__ u32x4 pack8(const f32x4 v0, const f32x4 v1) { u32x4 w; w.x = cvt_pk_bf16(v0[0], v0[1]); w.y = cvt_pk_bf16(v0[2], v0[3]); w.z = cvt_pk_bf16(v1[0], v1[1]); w.w = cvt_pk_bf16(v1[2], v1[3]); return w; }

struct EpiSwiglu {
    bf16_t* O;
    __device__ __forceinline__ void operator()(const Acc& acc, const Unit& u, int wr, int wc, int fr, int fq) const {
        const int row0 = u.pm * BM + wr * 64 + fr, col0 = u.pn * HALF + wc * 32 + 8 * fq;
#pragma unroll
        for (int ai = 0; ai < 2; ++ai)
#pragma unroll
            for (int m = 0; m < 4; ++m) {
                f32x4 v[2];
#pragma unroll
                for (int n = 0; n < 2; ++n) { const f32x4 gt = acc[ai][0][m][n], up = acc[ai][1][m][n];
#pragma unroll
                    for (int j = 0; j < 4; ++j) v[n][j] = gt[j] * sigmoid_f(gt[j]) * up[j]; }
                *(u32x4*)(O + (size_t)(row0 + ai * HALF + m * 16) * FF + col0) = pack8(v[0], v[1]);
            }
    }
};
struct EpiH {
    bf16_t* C;
    __device__ __forceinline__ void operator()(const Acc& acc, const Unit& u, int wr, int wc, int fr, int fq) const {
        const int row0 = u.pm * BM + wr * 64 + fr, col0 = u.pn * BM + wc * 32 + 8 * fq;
#pragma unroll
        for (int ai = 0; ai < 2; ++ai)
#pragma unroll
            for (int m = 0; m < 4; ++m) { bf16_t* rowp = C + (size_t)(row0 + ai * HALF + m * 16) * D + col0;
#pragma unroll
                for (int bj = 0; bj < 2; ++bj) *(u32x4*)(rowp + bj * HALF) = pack8(acc[ai][bj][m][0], acc[ai][bj][m][1]); }
    }
};
struct EpiWin {
    bf16_t *ZB, *ZCV, *ZP, *ZG; const float* bgate;
    __device__ __forceinline__ void operator()(const Acc& acc, const Unit& u, int wr, int wc, int fr, int fq) const {
        const int row0 = u.pm * BM + wr * 64 + fr, pn = u.pn, cw = wc * 32 + 8 * fq;
        if (pn >= 4 && pn < 12) {
            const int col0 = (pn - 4) * HALF + cw;
#pragma unroll
            for (int ai = 0; ai < 2; ++ai)
#pragma unroll
                for (int m = 0; m < 4; ++m)
                    *(u32x4*)(ZCV + (size_t)(row0 + ai * HALF + m * 16) * D + col0) = pack8(acc[ai][0][m][0] * acc[ai][1][m][0], acc[ai][0][m][1] * acc[ai][1][m][1]);
        } else if (pn < 16) {
            bf16_t* base = pn < 4 ? ZB : ZP; const int col0 = (pn < 4 ? pn : pn - 12) * BM + cw;
#pragma unroll
            for (int ai = 0; ai < 2; ++ai)
#pragma unroll
                for (int m = 0; m < 4; ++m) { bf16_t* rowp = base + (size_t)(row0 + ai * HALF + m * 16) * D + col0;
#pragma unroll
                    for (int bj = 0; bj < 2; ++bj) *(u32x4*)(rowp + bj * HALF) = pack8(acc[ai][bj][m][0], acc[ai][bj][m][1]); }
        } else {
            const int col0 = (pn - 16) * BM + cw;
            f32x4 bv[2][2];
#pragma unroll
            for (int bj = 0; bj < 2; ++bj)
#pragma unroll
                for (int n = 0; n < 2; ++n) bv[bj][n] = *(const f32x4*)(bgate + col0 + bj * HALF + 4 * n);
#pragma unroll
            for (int ai = 0; ai < 2; ++ai)
#pragma unroll
                for (int m = 0; m < 4; ++m) { bf16_t* rowp = ZG + (size_t)(row0 + ai * HALF + m * 16) * 2048 + col0;
#pragma unroll
                    for (int bj = 0; bj < 2; ++bj) { f32x4 v[2];
#pragma unroll
                        for (int n = 0; n < 2; ++n) { const f32x4 a = acc[ai][bj][m][n] + bv[bj][n];
#pragma unroll
                            for (int j = 0; j < 4; ++j) v[n][j] = sigmoid_f(a[j]); }
                        *(u32x4*)(rowp + bj * HALF) = pack8(v[0], v[1]); } }
        }
    }
};
struct EpiPoolGroup {
    bf16_t* O; const float* bias; const float* scale;
    __device__ __forceinline__ void operator()(const Acc& acc, const Unit& u, int wr, int wc, int fr, int fq) const {
        const int row0 = u.pm * BM + wr * 64 + fr, col0 = u.pn * BM + wc * 32 + 8 * fq;
        f32x4 bv[2][2], sv[2][2];
#pragma unroll
        for (int bj = 0; bj < 2; ++bj)
#pragma unroll
            for (int n = 0; n < 2; ++n) { bv[bj][n] = *(const f32x4*)(bias + col0 + bj * HALF + 4 * n); sv[bj][n] = *(const f32x4*)(scale + col0 + bj * HALF + 4 * n); }
#pragma unroll
        for (int ai = 0; ai < 2; ++ai)
#pragma unroll
            for (int m = 0; m < 4; ++m) { bf16_t* rowp = O + (size_t)(row0 + ai * HALF + m * 16) * D + col0;
#pragma unroll
                for (int bj = 0; bj < 2; ++bj) *(u32x4*)(rowp + bj * HALF) = pack8((acc[ai][bj][m][0] + bv[bj][0]) * sv[bj][0], (acc[ai][bj][m][1] + bv[bj][1]) * sv[bj][1]); }
    }
};
__device__ __forceinline__ void unpack8v(const u32x4 q, f32x4& a, f32x4& b) { a = (f32x4){bf_lo(q.x), bf_hi(q.x), bf_lo(q.y), bf_hi(q.y)}; b = (f32x4){bf_lo(q.z), bf_hi(q.z), bf_lo(q.w), bf_hi(q.w)}; }
struct EpiGateA {
    const bf16_t* ZG; bf16_t* M1;
    __device__ __forceinline__ void operator()(const Acc& acc, const Unit& u, int wr, int wc, int fr, int fq) const {
        const int row0 = u.pm * BM + wr * 64 + fr, col0 = u.pn * BM + wc * 32 + 8 * fq;
#pragma unroll
        for (int ai = 0; ai < 2; ++ai) {
            u32x4 gq[4][2];
#pragma unroll
            for (int m = 0; m < 4; ++m)
#pragma unroll
                for (int bj = 0; bj < 2; ++bj) gq[m][bj] = *(const u32x4*)(ZG + (size_t)(row0 + ai * HALF + m * 16) * 2048 + col0 + bj * HALF);
#pragma unroll
            for (int m = 0; m < 4; ++m)
#pragma unroll
                for (int bj = 0; bj < 2; ++bj) { f32x4 g0, g1; unpack8v(gq[m][bj], g0, g1);
                    *(u32x4*)(M1 + (size_t)(row0 + ai * HALF + m * 16) * D + col0 + bj * HALF) = pack8(g0 * acc[ai][bj][m][0], g1 * acc[ai][bj][m][1]); }
        }
    }
};
struct EpiGateP {
    const bf16_t* ZG; const bf16_t* M1; bf16_t* MM;
    __device__ __forceinline__ void operator()(const Acc& acc, const Unit& u, int wr, int wc, int fr, int fq) const {
        const int row0 = u.pm * BM + wr * 64 + fr, col0 = u.pn * BM + wc * 32 + 8 * fq;
#pragma unroll
        for (int ai = 0; ai < 2; ++ai) {
            u32x4 gq[4][2], mq[4][2];
#pragma unroll
            for (int m = 0; m < 4; ++m)
#pragma unroll
                for (int bj = 0; bj < 2; ++bj) { const size_t r = (size_t)(row0 + ai * HALF + m * 16);
                    gq[m][bj] = *(const u32x4*)(ZG + r * 2048 + D + col0 + bj * HALF); mq[m][bj] = *(const u32x4*)(M1 + r * D + col0 + bj * HALF); }
#pragma unroll
            for (int m = 0; m < 4; ++m)
#pragma unroll
                for (int bj = 0; bj < 2; ++bj) { f32x4 g0, g1, m0, m1; unpack8v(gq[m][bj], g0, g1); unpack8v(mq[m][bj], m0, m1);
                    *(u32x4*)(MM + (size_t)(row0 + ai * HALF + m * 16) * D + col0 + bj * HALF) = pack8(m0 + g0 * acc[ai][bj][m][0], m1 + g1 * acc[ai][bj][m][1]); }
        }
    }
};
}


#define XB_TMO      128
#define XB_XCNT(j)  (256  + 64 * (j))
#define XB_XSUB(j)  (1280 + 64 * (j))
#define XB_XGEN(j)  (2304 + 64 * (j))
#define XB_TOP      3328
#define XB_TOPGEN   3392
#define XCD_BAR_WORDS 3456
#define XB_SPIN_CAP (1u << 18)

__device__ __forceinline__ unsigned xb_ld(unsigned* p)              { return __hip_atomic_load(p, __ATOMIC_RELAXED, __HIP_MEMORY_SCOPE_AGENT); }
__device__ __forceinline__ unsigned xb_add(unsigned* p, unsigned v) { return __hip_atomic_fetch_add(p, v, __ATOMIC_RELAXED, __HIP_MEMORY_SCOPE_AGENT); }
__device__ __forceinline__ unsigned xb_xcc_id() { return (unsigned)__builtin_amdgcn_s_getreg((3 << 11) | 20) & 0xFu; }
#define XB_SPIN(cond, bar) do { unsigned _sp = 0; while (cond) { __builtin_amdgcn_s_sleep(1); \
    if ((++_sp & 255u) == 0u) { if (xb_ld(&(bar)[XB_TMO])) break; if (_sp > XB_SPIN_CAP) { atomicAdd(&(bar)[XB_TMO], 1u); break; } } } } while (0)

struct XcdBarrier {
    unsigned* bar; unsigned x;
    volatile LAS unsigned* st;
};

__device__ __forceinline__ XcdBarrier xcd_barrier_post(unsigned* bar, volatile LAS unsigned* st) {
    XcdBarrier b; b.bar = bar; b.x = xb_xcc_id(); b.st = st;
    if (threadIdx.x == 0) (void)xb_add(&bar[XB_XCNT(b.x)], 1u);
    return b;
}
__device__ __forceinline__ void xcd_barrier_complete(unsigned* bar, unsigned x, unsigned& nloc, unsigned& nx) {
    const unsigned G = gridDim.x * gridDim.y * gridDim.z;
    unsigned sum, cnt, mine, sp = 0u;
    for (;;) {
        sum = 0u; cnt = 0u; mine = 0u;
#pragma unroll
        for (unsigned j = 0; j < 16; ++j) { const unsigned c = xb_ld(&bar[XB_XCNT(j)]); sum += c; cnt += (c > 0u) ? 1u : 0u; mine = (j == x) ? c : mine; }
        if (sum == G) break;
        __builtin_amdgcn_s_sleep(1);
        if ((++sp & 255u) == 0u) { if (xb_ld(&bar[XB_TMO])) break; if (sp > XB_SPIN_CAP) { atomicAdd(&bar[XB_TMO], 1u); break; } }
    }
    nloc = mine > 0u ? mine : 1u; nx = cnt > 0u ? cnt : 1u;
}

__device__ __forceinline__ void xcd_barrier(const XcdBarrier& b) {
    asm volatile("s_waitcnt vmcnt(0)" ::: "memory");
    __syncthreads();
    if (threadIdx.x == 0) {
        unsigned* bar = b.bar;
        __builtin_amdgcn_s_waitcnt(0);
        unsigned nloc = b.st[0], nx = b.st[1];
        if (nloc == 0u) { xcd_barrier_complete(bar, b.x, nloc, nx); b.st[0] = nloc; b.st[1] = nx; }
        const unsigned old = xb_add(&bar[XB_XSUB(b.x)], 1u);
        const unsigned gen = old / nloc;
        if (old + 1u == (gen + 1u) * nloc) {
            __builtin_amdgcn_fence(__ATOMIC_RELEASE, "agent");
            asm volatile("s_waitcnt vmcnt(0)" ::: "memory");
            const unsigned og = xb_add(&bar[XB_TOP], 1u);
            const unsigned tg = og / nx;
            if (og + 1u == (tg + 1u) * nx) xb_add(&bar[XB_TOPGEN], 1u);
            else XB_SPIN(xb_ld(&bar[XB_TOPGEN]) == tg, bar);
            __builtin_amdgcn_fence(__ATOMIC_ACQUIRE, "agent");
            xb_add(&bar[XB_XGEN(b.x)], 1u);
            asm volatile("s_waitcnt vmcnt(0)" ::: "memory");
        } else {
            XB_SPIN(xb_ld(&bar[XB_XGEN(b.x)]) == gen, bar);
            __builtin_amdgcn_fence(__ATOMIC_ACQUIRE, "agent");
            asm volatile("s_waitcnt vmcnt(0)" ::: "memory");
        }
    }
    __syncthreads();
}

struct Args { const float* in[20]; float* out; unsigned char* ws; int ph_lo, ph_hi; };
struct Ctx { LAS unsigned char* lds; int lane, wave, gw, NGW, G; };

__device__ __forceinline__ void transpose_item(const float* W, int ldsrc, int K, int src_col0, bf16_t* WT, int dst_row0, int k0, LAS float* scr, int lane) {
#pragma unroll 8
    for (int i = 0; i < 32; ++i) { const int kk = 2 * i + (lane >> 5); scr[kk * 33 + (lane & 31)] = W[(size_t)(k0 + kk) * ldsrc + src_col0 + (lane & 31)]; }
    LDS_WAIT(); asm volatile("" ::: "memory");
    const int c = lane & 7;
#pragma unroll
    for (int j = 0; j < 4; ++j) { const int n = (lane >> 3) + 8 * j; const LAS float* s = scr + (8 * c) * 33 + n;
        u32x4 o; o.x = cvt_pk_bf16(s[0 * 33], s[1 * 33]); o.y = cvt_pk_bf16(s[2 * 33], s[3 * 33]); o.z = cvt_pk_bf16(s[4 * 33], s[5 * 33]); o.w = cvt_pk_bf16(s[6 * 33], s[7 * 33]);
        *(u32x4*)(WT + (size_t)(dst_row0 + n) * K + k0 + 8 * c) = o; }
    LDS_WAIT(); asm volatile("" ::: "memory");
}
__device__ __forceinline__ int map_gu(int n) { return ((n >> 7) & 1) * FF + (n >> 8) * 128 + (n & 127); }
__device__ __forceinline__ int map_in(int n) { if (n < 1024 || n >= 3072) return n; const int q = (n - 1024) >> 8, h = (n >> 7) & 1; return (h ? 2048 : 1024) + q * 128 + (n & 127); }

__device__ __forceinline__ void prep_weights(const Ctx& F, const Args& a, int l) {
    LAS float* scr = (LAS float*)(F.lds + F.wave * 16384);
    unsigned char* ws = a.ws;
    constexpr int I_GU = (D / 64) * (NGU / 32), I_D = (FF / 64) * (D / 32), I_IN = (D / 64) * (NIN / 32), I_SQ = (D / 64) * (D / 32), I_PG = 4 * (256 / 64) * (256 / 32);
    constexpr int NITEMS = 2 * I_GU + 2 * I_D + I_IN + 3 * I_SQ + I_PG;
    for (int it = F.gw; it < NITEMS; it += F.NGW) {
        int r = it;
        if (r < 2 * I_GU) { const int w = r / I_GU; r -= w * I_GU; const int kb = r / (NGU / 32), nb = r % (NGU / 32);
            transpose_item(a.in[w ? 18 : 3] + (size_t)l * D * NGU, NGU, D, map_gu(32 * nb), (bf16_t*)(ws + (w ? W_GU2 : W_GU1)), 32 * nb, 64 * kb, scr, F.lane); continue; }
        r -= 2 * I_GU;
        if (r < 2 * I_D) { const int w = r / I_D; r -= w * I_D; const int kb = r / (D / 32), nb = r % (D / 32);
            transpose_item(a.in[w ? 19 : 4] + (size_t)l * FF * D, D, FF, 32 * nb, (bf16_t*)(ws + (w ? W_D2 : W_D1)), 32 * nb, 64 * kb, scr, F.lane); continue; }
        r -= 2 * I_D;
        if (r < I_IN) { const int kb = r / (NIN / 32), nb = r % (NIN / 32);
            transpose_item(a.in[7] + (size_t)l * D * NIN, NIN, D, map_in(32 * nb), (bf16_t*)(ws + W_IN), 32 * nb, 64 * kb, scr, F.lane); continue; }
        r -= I_IN;
        if (r < 3 * I_SQ) { const int w = r / I_SQ; r -= w * I_SQ; const int kb = r / (D / 32), nb = r % (D / 32);
            transpose_item(a.in[w == 0 ? 10 : (w == 1 ? 14 : 15)] + (size_t)l * D * D, D, D, 32 * nb, (bf16_t*)(ws + (w == 0 ? W_CO : (w == 1 ? W_PO : W_WO))), 32 * nb, 64 * kb, scr, F.lane); continue; }
        r -= 3 * I_SQ;
        { const int gi = r / 32; r -= gi * 32; const int kb = r / 8, nb = r % 8;
            transpose_item(a.in[11] + (size_t)l * 4 * 65536 + (size_t)gi * 65536, 256, 256, 32 * nb, (bf16_t*)(ws + W_PG), gi * 256 + 32 * nb, 64 * kb, scr, F.lane); }
    }
}

__device__ __forceinline__ void norm_rows(const Ctx& F, const float* x, const float* g, bf16_t* A) {
    f32x4 gv[4];
#pragma unroll
    for (int j = 0; j < 4; ++j) gv[j] = ((const f32x4*)g)[F.lane + 64 * j];
    for (int m = F.gw; m < M; m += F.NGW) {
        const f32x4* xr = (const f32x4*)(x + (size_t)m * D) + F.lane;
        f32x4 v[4]; float s = 0.f;
#pragma unroll
        for (int j = 0; j < 4; ++j) { v[j] = xr[64 * j]; s += (v[j].x * v[j].x + v[j].y * v[j].y) + (v[j].z * v[j].z + v[j].w * v[j].w); }
        const float r = 1.0f / sqrtf(wave_sum(s, F.lane) * (1.f / D) + EPS);
        u32x2* o = (u32x2*)(A + (size_t)m * D) + F.lane;
#pragma unroll
        for (int j = 0; j < 4; ++j) { const f32x4 y = v[j] * r * gv[j]; u32x2 w; w.x = cvt_pk_bf16(y.x, y.y); w.y = cvt_pk_bf16(y.z, y.w); o[64 * j] = w; }
    }
}
__device__ __forceinline__ void resid_rows(const Ctx& F, const float* xin, float* xout, const bf16_t* h, const float* post, float cs, const float* pre, bf16_t* A) {
    f32x4 pv[4], qv[4];
#pragma unroll
    for (int j = 0; j < 4; ++j) { pv[j] = ((const f32x4*)post)[F.lane + 64 * j] * cs; qv[j] = pre ? ((const f32x4*)pre)[F.lane + 64 * j] : (f32x4){0.f, 0.f, 0.f, 0.f}; }
    for (int m = F.gw; m < M; m += F.NGW) {
        const u32x2* hr = (const u32x2*)(h + (size_t)m * D) + F.lane; const f32x4* xr = (const f32x4*)(xin + (size_t)m * D) + F.lane;
        f32x4 hv[4], xv[4]; float s = 0.f;
#pragma unroll
        for (int j = 0; j < 4; ++j) { const u32x2 q = hr[64 * j]; hv[j] = (f32x4){bf_lo(q.x), bf_hi(q.x), bf_lo(q.y), bf_hi(q.y)}; xv[j] = xr[64 * j]; }
#pragma unroll
        for (int j = 0; j < 4; ++j) s += (hv[j].x * hv[j].x + hv[j].y * hv[j].y) + (hv[j].z * hv[j].z + hv[j].w * hv[j].w);
        const float r1 = 1.0f / sqrtf(wave_sum(s, F.lane) * (1.f / D) + EPS);
        float s2 = 0.f;
        f32x4* xo = (f32x4*)(xout + (size_t)m * D) + F.lane;
#pragma unroll
        for (int j = 0; j < 4; ++j) { xv[j] = xv[j] + hv[j] * r1 * pv[j]; xo[64 * j] = xv[j]; s2 += (xv[j].x * xv[j].x + xv[j].y * xv[j].y) + (xv[j].z * xv[j].z + xv[j].w * xv[j].w); }
        if (pre) {
            const float r2 = 1.0f / sqrtf(wave_sum(s2, F.lane) * (1.f / D) + EPS);
            u32x2* o = (u32x2*)(A + (size_t)m * D) + F.lane;
#pragma unroll
            for (int j = 0; j < 4; ++j) { const f32x4 y = xv[j] * r2 * qv[j]; u32x2 w; w.x = cvt_pk_bf16(y.x, y.y); w.y = cvt_pk_bf16(y.z, y.w); o[64 * j] = w; }
        }
    }
}
__device__ __forceinline__ void unpack8(const u32x4 q, float (&f)[8]) { f[0] = bf_lo(q.x); f[1] = bf_hi(q.x); f[2] = bf_lo(q.y); f[3] = bf_hi(q.y); f[4] = bf_lo(q.z); f[5] = bf_hi(q.z); f[6] = bf_lo(q.w); f[7] = bf_hi(q.w); }
__device__ __forceinline__ void mix_rows(const Ctx& F, const bf16_t* ZB, const bf16_t* ZCV, const bf16_t* ZP, const float* convw, bf16_t* CA, bf16_t* DDo) {
    const int half = F.gw & 1, c0 = half * 512 + F.lane * 8;
    const int npair = F.NGW >> 1, tpw = (M + npair - 1) / npair, t0 = (F.gw >> 1) * tpw;
    float w0[8], w1[8], w2[8];
#pragma unroll
    for (int j = 0; j < 8; ++j) { w0[j] = convw[c0 + j]; w1[j] = convw[D + c0 + j]; w2[j] = convw[2 * D + c0 + j]; }
    const int win = 2 << (c0 >> 8), wmax = half ? 16 : 4;
    for (int t = t0; t < t0 + tpw && t < M; ++t) {
        const int s = t & (SEQ - 1);
        const size_t off = (size_t)t * D + c0;
        const u32x4 zero = {0u, 0u, 0u, 0u};
        const u32x4 qb = *(const u32x4*)(ZB + off), q2 = *(const u32x4*)(ZCV + off);
        const u32x4 q1 = s >= 1 ? *(const u32x4*)(ZCV + off - D) : zero, q0 = s >= 2 ? *(const u32x4*)(ZCV + off - 2 * D) : zero;
        const u32x4 qp = *(const u32x4*)(ZP + off);
        float fb[8], f0[8], f1[8], f2[8], fp[8], acc[8];
        unpack8(qb, fb); unpack8(q0, f0); unpack8(q1, f1); unpack8(q2, f2); unpack8(qp, fp);
#pragma unroll
        for (int j = 0; j < 8; ++j) acc[j] = fp[j];
        for (int k = 1; k < wmax; ++k) {
            const bool ok = (k < win) && (s >= k);
            const u32x4 q = ok ? *(const u32x4*)(ZP + off - (size_t)k * D) : zero;
            float f[8]; unpack8(q, f);
#pragma unroll
            for (int j = 0; j < 8; ++j) acc[j] += f[j];
        }
        const float inv = 1.0f / (float)((s + 1) < win ? (s + 1) : win);
        float ca[8], dd[8];
#pragma unroll
        for (int j = 0; j < 8; ++j) { ca[j] = fb[j] * (w0[j] * f0[j] + w1[j] * f1[j] + w2[j] * f2[j]); dd[j] = acc[j] * inv - fp[j]; }
        u32x4 o1, o2;
        o1.x = cvt_pk_bf16(ca[0], ca[1]); o1.y = cvt_pk_bf16(ca[2], ca[3]); o1.z = cvt_pk_bf16(ca[4], ca[5]); o1.w = cvt_pk_bf16(ca[6], ca[7]);
        o2.x = cvt_pk_bf16(dd[0], dd[1]); o2.y = cvt_pk_bf16(dd[2], dd[3]); o2.z = cvt_pk_bf16(dd[4], dd[5]); o2.w = cvt_pk_bf16(dd[6], dd[7]);
        *(u32x4*)(CA + off) = o1; *(u32x4*)(DDo + off) = o2;
    }
}


__device__ __forceinline__ void dump_cols(const Ctx& F, float* out, int c0, int ncols, const void* src, int ld, bool isf32) {
    for (int m = F.gw; m < M; m += F.NGW)
        for (int c = F.lane; c < ncols; c += 64)
            out[(size_t)m * D + c0 + c] = isf32 ? ((const float*)src)[(size_t)m * ld + c] : bf_lo((unsigned)((const bf16_t*)src)[(size_t)m * ld + c]);
}
#ifndef MK_DUMP
#define MK_DUMP 0
#endif
__device__ __forceinline__ bool launder(Ctx& F, unsigned char*& ws, int& tidv) { int t; asm volatile("v_mbcnt_lo_u32_b32 %0, -1, 0\n\tv_mbcnt_hi_u32_b32 %0, -1, %0" : "=v"(t)); F.lane = t; tidv = F.wave * 64 + t; const unsigned long long w0 = (unsigned long long)ws; unsigned wl = __builtin_amdgcn_readfirstlane((unsigned)w0), wh = __builtin_amdgcn_readfirstlane((unsigned)(w0 >> 32)); asm volatile("" : "+s"(wl), "+s"(wh));
    const unsigned long long w = ((unsigned long long)wh << 32) | wl; ws = (unsigned char*)(__attribute__((address_space(1))) unsigned char*)w; return true; }
constexpr int PH_PER_LAYER = 13, N_PHASES = 1 + DEPTH * PH_PER_LAYER;

__global__ void __launch_bounds__(512, 2) mega_fwd(Args a) {
    extern __shared__ __attribute__((aligned(16))) unsigned char lds_raw[];
    Ctx F; F.lds = (LAS unsigned char*)lds_raw; F.lane = threadIdx.x & 63; F.wave = __builtin_amdgcn_readfirstlane(threadIdx.x >> 6);
    F.G = gridDim.x; F.gw = blockIdx.x * 8 + F.wave; F.NGW = F.G * 8;
    unsigned char* ws = a.ws; int tidv = threadIdx.x;
    const int lo = a.ph_lo, hi = a.ph_hi;
    volatile LAS unsigned* MISC = (volatile LAS unsigned*)(F.lds + MISC_OFF);
    if (threadIdx.x < 32) MISC[threadIdx.x] = 0u;
    __syncthreads();
    XcdBarrier bar; bar.bar = (unsigned*)(ws + WS_BAR); bar.x = 0; bar.st = nullptr;
    if (hi - lo > 1) bar = xcd_barrier_post((unsigned*)(ws + WS_BAR), MISC + 8);
    if (lo < 0) cg::this_grid().sync();
#if MK_DUMP == 4
    if (lo == 100) { dump_cols(F, a.out, 0, 256, ws + WS_ZB, D, false); dump_cols(F, a.out, 256, 256, ws + WS_ZCV, D, false); dump_cols(F, a.out, 512, 256, ws + WS_ZP, D, false); dump_cols(F, a.out, 768, 256, ws + WS_ZG, 2048, false); return; }
#endif
    int ph = 0;
#define IN_PH (lo <= ph && ph < hi && launder(F, ws, tidv))
#define SEAM() do { if (lo <= ph && ph + 1 < hi) { xcd_barrier(bar); } ++ph; } while (0)
    bf16_t* const A = (bf16_t*)(ws + WS_A);
    float* const X = a.out;
    if (IN_PH) { prep_weights(F, a, 0); norm_rows(F, a.in[0], a.in[1], A);
#if MK_DUMP
        { u32x4* z = (u32x4*)(ws + WS_R0); const size_t n16 = (WS_END - WS_R0) / 16; const u32x4 zz = {0u, 0u, 0u, 0u};
          for (size_t i = (size_t)F.gw * 64 + F.lane; i < n16; i += (size_t)F.NGW * 64) z[i] = zz; }
#endif
    }
    SEAM();
    for (int l = 0; l < DEPTH; ++l) {
        const float* xin = (l == 0) ? a.in[0] : X;
        if (IN_PH) { pg8::Gemm g{A, (const bf16_t*)(ws + W_GU1), M, NGU, D, D, 0}; pg8::StaticOrder S; S.init(M, NGU, F.G, blockIdx.x);
            pg8::EpiSwiglu E{(bf16_t*)(ws + WS_HH)}; pg8::gemm_phase(F.lds, g, S, E, tidv); }
        SEAM();
        if (IN_PH) { pg8::Gemm g{(const bf16_t*)(ws + WS_HH), (const bf16_t*)(ws + W_D1), M, D, FF, FF, 0}; pg8::StaticOrder S; S.init(M, D, F.G, blockIdx.x);
            pg8::EpiH E{(bf16_t*)(ws + WS_HFFN)}; pg8::gemm_phase(F.lds, g, S, E, tidv); }
        SEAM();
        if (IN_PH) resid_rows(F, xin, X, (const bf16_t*)(ws + WS_HFFN), a.in[2] + l * D, 0.5f, a.in[5] + l * D, A);
        SEAM();
        if (IN_PH) { pg8::Gemm g{A, (const bf16_t*)(ws + W_IN), M, NIN, D, D, 0}; pg8::StaticOrder S; S.init(M, NIN, F.G, blockIdx.x);
            pg8::EpiWin E{(bf16_t*)(ws + WS_ZB), (bf16_t*)(ws + WS_ZCV), (bf16_t*)(ws + WS_ZP), (bf16_t*)(ws + WS_ZG), a.in[8] + l * 2 * D}; pg8::gemm_phase(F.lds, g, S, E, tidv); }
        SEAM();
        if (IN_PH) mix_rows(F, (const bf16_t*)(ws + WS_ZB), (const bf16_t*)(ws + WS_ZCV), (const bf16_t*)(ws + WS_ZP), a.in[9] + l * 3 * D, A, (bf16_t*)(ws + WS_DD));
        SEAM();
        if (IN_PH) {
            { pg8::Gemm g{(const bf16_t*)(ws + WS_DD), (const bf16_t*)(ws + W_PG), M, D, 256, D, 256}; pg8::StaticOrder S; S.init(M, D, F.G, blockIdx.x);
              pg8::EpiPoolGroup E{(bf16_t*)(ws + WS_YP0), a.in[12] + l * D, a.in[13] + l * D}; pg8::gemm_phase(F.lds, g, S, E, tidv); }
        }
        SEAM();
#if MK_DUMP == 6
        if (l == 0) { xcd_barrier(bar); dump_cols(F, a.out, 0, 1024, ws + WS_YP0, D, false); return; }
#endif
#if MK_DUMP == 8
        if (l == 0) { xcd_barrier(bar); dump_cols(F, a.out, 0, 1024, ws + WS_ZG, 2048, false); return; }
#endif
        if (IN_PH) {
            { pg8::Gemm g{A, (const bf16_t*)(ws + W_CO), M, D, D, D, 0}; pg8::StaticOrder S; S.init(M, D, F.G, blockIdx.x);
              pg8::EpiGateA E{(const bf16_t*)(ws + WS_ZG), (bf16_t*)(ws + WS_M1)}; pg8::gemm_phase(F.lds, g, S, E, tidv); }
        }
        SEAM();
#if MK_DUMP == 7
        if (l == 0) { xcd_barrier(bar); dump_cols(F, a.out, 0, 1024, ws + WS_M1, D, false); return; }
#endif
#if MK_DUMP == 3
        if (l == 0) { xcd_barrier(bar); dump_cols(F, a.out, 0, 1024, ws + WS_A, D, false); return; }
#endif
#if MK_DUMP == 4 && MK_ONE_LAUNCH
        if (l == 0) { xcd_barrier(bar); dump_cols(F, a.out, 0, 256, ws + WS_ZB, D, false); dump_cols(F, a.out, 256, 256, ws + WS_ZCV, D, false); dump_cols(F, a.out, 512, 256, ws + WS_ZP, D, false); dump_cols(F, a.out, 768, 256, ws + WS_ZG, 2048, false); return; }
#endif
#if MK_DUMP == 5
        if (l == 0) { xcd_barrier(bar); dump_cols(F, a.out, 0, 512, ws + WS_A, D, false); dump_cols(F, a.out, 512, 512, ws + WS_DD, D, false); return; }
#endif
        if (IN_PH) { pg8::Gemm g{(const bf16_t*)(ws + WS_YP0), (const bf16_t*)(ws + W_PO), M, D, D, D, 0}; pg8::StaticOrder S; S.init(M, D, F.G, blockIdx.x);
            pg8::EpiGateP E{(const bf16_t*)(ws + WS_ZG), (const bf16_t*)(ws + WS_M1), (bf16_t*)(ws + WS_MM)}; pg8::gemm_phase(F.lds, g, S, E, tidv); }
        SEAM();
        if (IN_PH) { pg8::Gemm g{(const bf16_t*)(ws + WS_MM), (const bf16_t*)(ws + W_WO), M, D, D, D, 0}; pg8::StaticOrder S; S.init(M, D, F.G, blockIdx.x);
            pg8::EpiH E{(bf16_t*)(ws + WS_HMIX)}; pg8::gemm_phase(F.lds, g, S, E, tidv); }
        SEAM();
        if (IN_PH) resid_rows(F, X, X, (const bf16_t*)(ws + WS_HMIX), a.in[6] + l * D, 1.0f, a.in[16] + l * D, A);
        SEAM();
        if (IN_PH) { pg8::Gemm g{A, (const bf16_t*)(ws + W_GU2), M, NGU, D, D, 0}; pg8::StaticOrder S; S.init(M, NGU, F.G, blockIdx.x);
            pg8::EpiSwiglu E{(bf16_t*)(ws + WS_HH)}; pg8::gemm_phase(F.lds, g, S, E, tidv); }
        SEAM();
        if (IN_PH) { pg8::Gemm g{(const bf16_t*)(ws + WS_HH), (const bf16_t*)(ws + W_D2), M, D, FF, FF, 0}; pg8::StaticOrder S; S.init(M, D, F.G, blockIdx.x);
            pg8::EpiH E{(bf16_t*)(ws + WS_HFFN)}; pg8::gemm_phase(F.lds, g, S, E, tidv); }
        SEAM();
        if (IN_PH) { const bool more = (l + 1 < DEPTH);
            resid_rows(F, X, X, (const bf16_t*)(ws + WS_HFFN), a.in[17] + l * D, 0.5f, more ? a.in[1] + (l + 1) * D : nullptr, A);
            if (more) prep_weights(F, a, l + 1); }
        SEAM();
    }
#undef IN_PH
#undef SEAM
}

extern "C" void kernel_launch(void* const* d_in, const int* in_sizes, int n_in, void* d_out, int out_size, void* d_ws, size_t ws_size, hipStream_t stream) {
    static int grid = 0;
    if (grid == 0) {
        if (n_in != 20 || in_sizes[0] != M * D || out_size != M * D || ws_size < WS_END) { fprintf(stderr, "kernel_launch: unexpected shapes (n_in %d, in0 %d, out %d, ws %zu < %zu)\n", n_in, n_in > 0 ? in_sizes[0] : -1, out_size, ws_size, (size_t)WS_END); grid = -1; return; }
        int dev = 0, cus = 0, per_cu = 0;
        hipGetDevice(&dev); hipDeviceGetAttribute(&cus, hipDeviceAttributeMultiprocessorCount, dev);
        if (hipFuncSetAttribute((const void*)mega_fwd, hipFuncAttributeMaxDynamicSharedMemorySize, LDS_BYTES) != hipSuccess) { fprintf(stderr, "kernel_launch: hipFuncSetAttribute failed\n"); grid = -1; return; }
        if (hipOccupancyMaxActiveBlocksPerMultiprocessor(&per_cu, (const void*)mega_fwd, 512, LDS_BYTES) != hipSuccess || per_cu < 1) { fprintf(stderr, "kernel_launch: occupancy query says %d\n", per_cu); per_cu = 1; (void)hipGetLastError(); }
        grid = cus * per_cu;
    }
    if (grid < 0) return;
    Args a{};
    for (int i = 0; i < 20; ++i) a.in[i] = (const float*)d_in[i];
    a.out = (float*)d_out; a.ws = (unsigned char*)d_ws;
#if MK_ONE_LAUNCH
    if (hipMemsetAsync((char*)d_ws, 0, CTL_ZERO_BYTES, stream) != hipSuccess) { fprintf(stderr, "kernel_launch: memset failed\n"); return; }
    a.ph_lo = 0; a.ph_hi = N_PHASES < MK_STOP ? N_PHASES : MK_STOP;
    void* args[] = {&a};
    hipError_t e = hipLaunchCooperativeKernel((const void*)mega_fwd, dim3(grid), dim3(512), args, LDS_BYTES, stream);
    if (e != hipSuccess) fprintf(stderr, "cooperative launch failed: %s (grid %d)\n", hipGetErrorString(e), grid);
#else
    for (int p = 0; p < N_PHASES && p < MK_STOP; ++p) { a.ph_lo = p; a.ph_hi = p + 1; hipLaunchKernelGGL(mega_fwd, dim3(grid), dim3(512), LDS_BYTES, stream, a); }
#if MK_DUMP == 4
    a.ph_lo = 100; a.ph_hi = 101; hipLaunchKernelGGL(mega_fwd, dim3(grid), dim3(512), LDS_BYTES, stream, a);
#endif
#endif
}
```

```cpp
#include <hip/hip_runtime.h>
#include <hip/hip_cooperative_groups.h>
#include <cstdio>
#include <cstdint>
namespace cg = cooperative_groups;

#ifndef MK_ONE_LAUNCH
#define MK_ONE_LAUNCH 1
#endif

#define LAS __attribute__((address_space(3)))
typedef unsigned short bf16_t;
typedef short bf16x8 __attribute__((ext_vector_type(8)));
typedef float f32x4 __attribute__((ext_vector_type(4)));
typedef unsigned u32x4 __attribute__((ext_vector_type(4)));
typedef unsigned u32x2 __attribute__((ext_vector_type(2)));

constexpr int D = 1024, SEQ = 2048, BATCH = 16, M = BATCH * SEQ, FF = 2816, NGU = 2 * FF, NIN = 6144, DEPTH = 2;
constexpr float EPS = 1e-6f;
constexpr size_t MiB = 1u << 20;
constexpr size_t WS_W = 1 * MiB;
constexpr size_t W_GU1 = WS_W, W_D1 = W_GU1 + (size_t)NGU * D * 2, W_IN = W_D1 + (size_t)D * FF * 2, W_PG = W_IN + (size_t)NIN * D * 2,
                 W_CO = W_PG + (size_t)D * 256 * 2, W_PO = W_CO + (size_t)D * D * 2, W_WO = W_PO + (size_t)D * D * 2, W_GU2 = W_WO + (size_t)D * D * 2,
                 W_D2 = W_GU2 + (size_t)NGU * D * 2, W_END = W_D2 + (size_t)D * FF * 2;
static_assert(W_END <= 56 * MiB, "weights");
constexpr size_t WS_SSQ = 512 * 1024;
constexpr size_t WS_XB = 56 * MiB;
constexpr size_t WS_R0 = 120 * MiB;
constexpr size_t WS_ZG = WS_R0;
constexpr size_t WS_ZB = WS_R0 + 128 * MiB;
constexpr size_t WS_ZCV = WS_ZB + 64 * MiB;
constexpr size_t WS_ZP = WS_ZCV + 64 * MiB;
constexpr size_t WS_DD = WS_ZP + 64 * MiB;
constexpr size_t WS_CA = WS_ZB;
constexpr size_t WS_YP0 = WS_ZCV;
constexpr size_t WS_M1 = WS_ZP;
constexpr size_t WS_MM = WS_DD;
constexpr size_t WS_HMIX = WS_R0;
constexpr size_t WS_HH = WS_R0;
constexpr size_t WS_HFFN = WS_ZCV;
constexpr size_t WS_END = WS_DD + 64 * MiB;
static_assert(WS_HH + (size_t)M * FF * 2 <= WS_HFFN, "H overlay");
constexpr int LDS_BYTES = 147456, MISC_OFF = 131072 + 320;
constexpr size_t WS_BAR = 16384, CTL_ZERO_BYTES = 65536;

typedef float f32x2 __attribute__((ext_vector_type(2)));
typedef __bf16 bf16x2 __attribute__((ext_vector_type(2)));
__device__ __forceinline__ unsigned cvt_pk_bf16(float lo, float hi) { const f32x2 v = {lo, hi}; const bf16x2 b = __builtin_convertvector(v, bf16x2); return __builtin_bit_cast(unsigned, b); }
__device__ __forceinline__ float bf_lo(unsigned u) { return __builtin_bit_cast(float, u << 16); }
__device__ __forceinline__ float bf_hi(unsigned u) { return __builtin_bit_cast(float, u & 0xffff0000u); }
__device__ __forceinline__ float sigmoid_f(float x) { return __builtin_amdgcn_rcpf(1.0f + __expf(-x)); }
__device__ __forceinline__ float wave_sum(float v, int lane) {
#pragma unroll
    for (int o = 1; o < 64; o <<= 1) v += __builtin_bit_cast(float, __builtin_amdgcn_ds_bpermute((lane ^ o) << 2, __builtin_bit_cast(int, v)));
    return v;
}
#define LDS_WAIT() asm volatile("s_waitcnt lgkmcnt(0)" ::: "memory")

namespace pg8 {
constexpr int BM = 256, BK = 64, HALF = 128, HTB = HALF * BK * 2, STAGE_BYTES = 8 * HTB, NXCD = 8, WGM = 8;
__host__ __device__ __forceinline__ int lds_byte(int r, int c) { const int st = (r >> 4) * 2 + (c >> 5), rr = r & 15, cc = c & 31, ob = rr * 64 + cc * 2; return st * 1024 + (ob ^ (((ob >> 9) & 1) << 5)); }
__host__ __device__ __forceinline__ void stage_rc(int b, int& R, int& C) { const int st = b / 1024, sb = b % 1024, swz = sb ^ (((sb >> 9) & 1) << 5); R = (st >> 1) * 16 + swz / 64; C = (st & 1) * 32 + (swz % 64) / 2; }
__host__ __device__ __forceinline__ int perm32(int rho) { const int n = rho >> 4, i = rho & 15; return 8 * (i >> 2) + 4 * n + (i & 3); }

struct Unit { int pm, pn; };
struct Gemm { const bf16_t* A; const bf16_t* Bt; int M, N, K, lda, a_pn_cols; };

struct StaticOrder {
    int nM, nN, nwg, G, c;
    __host__ __device__ void init(int M_, int N_, int G_, int c_) { nM = M_ / BM; nN = N_ / BM; nwg = nM * nN; G = G_; c = c_; }
    __host__ __device__ bool next(int i, Unit& u) const {
        const long L = (long)i * G + c; if (L >= nwg) return false;
        int wgid = (int)L; { const int q = nwg / NXCD, r = nwg % NXCD, xcd = wgid % NXCD, off = wgid / NXCD; wgid = (xcd < r ? xcd * (q + 1) : r * (q + 1) + (xcd - r) * q) + off; }
        const int nig = WGM * nN, gid = wgid / nig, fm = gid * WGM, gsz = (nM - fm) < WGM ? (nM - fm) : WGM;
        u.pm = fm + ((wgid % nig) % gsz); u.pn = (wgid % nig) / gsz; return true;
    }
};

typedef f32x4 Acc[2][2][4][2];
__device__ __forceinline__ const char* uni(const char* p) { const unsigned long long v = (unsigned long long)p; const unsigned lo = __builtin_amdgcn_readfirstlane((unsigned)v), hi = __builtin_amdgcn_readfirstlane((unsigned)(v >> 32)); return (const char*)(((unsigned long long)hi << 32) | lo); }

template <class Epi>
__device__ __forceinline__ void gemm_phase(LAS unsigned char* lds, const Gemm g, const StaticOrder& S, const Epi& E, const int tid) {
    const int wid = __builtin_amdgcn_readfirstlane(tid >> 6), lane = tid & 63, wr = wid >> 2, wc = wid & 3, fr = lane & 15, fq = lane >> 4;
    const int K = g.K, nt = K / BK;
    unsigned voffA[2], voffB[2];
#pragma unroll
    for (int i = 0; i < 2; ++i) { int R, C; stage_rc(tid * 16 + i * 8192, R, C); const int Rb = (R & ~31) + perm32(R & 31);
        voffA[i] = (unsigned)(R * g.lda + C) * 2u; voffB[i] = (unsigned)(Rb * K + C) * 2u; }
    const size_t kstep = (size_t)(BK * 2);
    const size_t hstepA = (size_t)HALF * g.lda * 2, tstepA = 2 * hstepA;
    const size_t hstepB = (size_t)HALF * K * 2, tstepB = 2 * hstepB;
    const size_t pnA = (size_t)g.a_pn_cols * 2;
    const unsigned ldsw = (unsigned)wid * 1024u;
    const int aoff = lds_byte(wr * 64 + fr, fq * 8), boff = lds_byte(wc * 32 + fr, fq * 8);
#define PG8_SA(b, h) (((b) * 2 + (h)) * HTB)
#define PG8_SB(b, h) ((4 + (b) * 2 + (h)) * HTB)
#define PG8_STAGE(bufoff, gbase, voff) do { _Pragma("unroll") for (int _i = 0; _i < 2; ++_i) \
        __builtin_amdgcn_global_load_lds((const unsigned*)((const char*)(gbase) + (voff)[_i]), (LAS unsigned*)(lds + (bufoff) + ldsw + _i * 8192), 16, 0, 0); } while (0)
#define PG8_LDA(dst, b, h) do { _Pragma("unroll") for (int m = 0; m < 4; ++m) _Pragma("unroll") for (int k = 0; k < 2; ++k) dst[m][k] = *(const LAS bf16x8*)(lds + PG8_SA(b, h) + aoff + m * 2048 + k * 1024); } while (0)
#define PG8_LDB(dst, b, h) do { _Pragma("unroll") for (int n = 0; n < 2; ++n) _Pragma("unroll") for (int k = 0; k < 2; ++k) dst[n][k] = *(const LAS bf16x8*)(lds + PG8_SB(b, h) + boff + n * 2048 + k * 1024); } while (0)
#define PG8_MMA(ai, bj, At, Bt) do { __builtin_amdgcn_s_setprio(1); _Pragma("unroll") for (int m = 0; m < 4; ++m) _Pragma("unroll") for (int n = 0; n < 2; ++n) _Pragma("unroll") for (int k = 0; k < 2; ++k) \
        acc[ai][bj][m][n] = __builtin_amdgcn_mfma_f32_16x16x32_bf16(Bt[n][k], At[m][k], acc[ai][bj][m][n], 0, 0, 0); __builtin_amdgcn_s_setprio(0); } while (0)
#define PG8_WAIT_V(n) asm volatile("s_waitcnt vmcnt(" #n ")" ::: "memory")
#define PG8_WAIT_L(n) asm volatile("s_waitcnt lgkmcnt(" #n ")" ::: "memory")
#define PG8_BAR __builtin_amdgcn_s_barrier()
#define PG8_SCHED __builtin_amdgcn_sched_barrier(0)
    Unit cur, nxt; int ui = 0;
    if (!S.next(0, cur)) return;
    Acc acc;
#pragma unroll
    for (int a = 0; a < 2; ++a)
#pragma unroll
        for (int b = 0; b < 2; ++b)
#pragma unroll
            for (int m = 0; m < 4; ++m)
#pragma unroll
                for (int n = 0; n < 2; ++n) acc[a][b][m][n] = (f32x4){0.f, 0.f, 0.f, 0.f};
    bf16x8 At[4][2], B0[2][2], B1[2][2];
    const char* cA = uni((const char*)g.A + (size_t)cur.pm * tstepA + (size_t)cur.pn * pnA); const char* cB = uni((const char*)g.Bt + (size_t)cur.pn * tstepB);
    PG8_STAGE(PG8_SB(0, 0), cB, voffB); PG8_STAGE(PG8_SB(0, 1), cB + hstepB, voffB); PG8_STAGE(PG8_SA(0, 0), cA, voffA); PG8_STAGE(PG8_SA(0, 1), cA + hstepA, voffA);
    if (wr == 1) PG8_BAR;
    PG8_WAIT_V(2); PG8_BAR;
    PG8_STAGE(PG8_SB(1, 0), cB + kstep, voffB); PG8_STAGE(PG8_SA(1, 0), cA + kstep, voffA); PG8_STAGE(PG8_SB(1, 1), cB + hstepB + kstep, voffB);
    PG8_WAIT_V(6); PG8_BAR;
    for (;;) {
        const bool has_next = S.next(ui + 1, nxt);
        const char* nA = uni(has_next ? (const char*)g.A + (size_t)nxt.pm * tstepA + (size_t)nxt.pn * pnA : cA); const char* nB = uni(has_next ? (const char*)g.Bt + (size_t)nxt.pn * tstepB : cB);
#pragma unroll 1
        for (int t = 0; t < nt; t += 2) {
            const bool last = (t == nt - 2);
            const char* a1 = cA + (size_t)(t + 1) * kstep;
            const char* a2 = last ? nA : cA + (size_t)(t + 2) * kstep; const char* b2 = last ? nB : cB + (size_t)(t + 2) * kstep;
            const char* a3 = a2 + kstep; const char* b3 = b2 + kstep;
            PG8_LDB(B0, 0, 0); PG8_LDB(B1, 0, 1); PG8_SCHED; PG8_LDA(At, 0, 0); PG8_STAGE(PG8_SA(1, 1), a1 + hstepA, voffA);
            PG8_WAIT_V(8); PG8_WAIT_L(0); PG8_BAR; PG8_MMA(0, 0, At, B0); PG8_MMA(0, 1, At, B1); PG8_BAR; PG8_SCHED;
            PG8_LDA(At, 0, 1); PG8_STAGE(PG8_SB(0, 0), b2, voffB); PG8_STAGE(PG8_SB(0, 1), b2 + hstepB, voffB); PG8_STAGE(PG8_SA(0, 0), a2, voffA);
            PG8_WAIT_V(8); PG8_WAIT_L(0); PG8_BAR; PG8_MMA(1, 0, At, B0); PG8_MMA(1, 1, At, B1); PG8_BAR; PG8_SCHED;
            PG8_LDB(B0, 1, 0); PG8_LDB(B1, 1, 1); PG8_SCHED; PG8_LDA(At, 1, 0); PG8_STAGE(PG8_SA(0, 1), a2 + hstepA, voffA);
            PG8_WAIT_V(8); PG8_WAIT_L(0); PG8_BAR; PG8_MMA(0, 0, At, B0); PG8_MMA(0, 1, At, B1); PG8_BAR; PG8_SCHED;
            PG8_LDA(At, 1, 1); PG8_STAGE(PG8_SB(1, 0), b3, voffB); PG8_STAGE(PG8_SB(1, 1), b3 + hstepB, voffB); PG8_STAGE(PG8_SA(1, 0), a3, voffA);
            PG8_WAIT_V(8); PG8_WAIT_L(0); PG8_BAR; PG8_MMA(1, 0, At, B0); PG8_MMA(1, 1, At, B1); PG8_BAR; PG8_SCHED;
        }
        if (wr == 0) PG8_BAR;
        E(acc, cur, wr, wc, fr, fq);
        if (!has_next) break;
#pragma unroll
        for (int a = 0; a < 2; ++a)
#pragma unroll
            for (int b = 0; b < 2; ++b)
#pragma unroll
                for (int m = 0; m < 4; ++m)
#pragma unroll
                    for (int n = 0; n < 2; ++n) acc[a][b][m][n] = (f32x4){0.f, 0.f, 0.f, 0.f};
        cur = nxt; cA = nA; cB = nB; ++ui;
        if (wr == 1) PG8_BAR;
    }
    PG8_WAIT_V(0);
    PG8_BAR;
#undef PG8_SA
#undef PG8_SB
#undef PG8_STAGE
#undef PG8_LDA
#undef PG8_LDB
#undef PG8_MMA
#undef PG8_WAIT_V
#undef PG8_WAIT_L
#undef PG8_BAR
#undef PG8_SCHED
}

__device__ __forceinline__ u32x4 pack8(const f32x4 v0, const f32x4 v1) { u32x4 w; w.x = cvt_pk_bf16(v0[0], v0[1]); w.y = cvt_pk_bf16(v0[2], v0[3]); w.z = cvt_pk_bf16(v1[0], v1[1]); w.w = cvt_pk_bf16(v1[2], v1[3]); return w; }

__device__ __forceinline__ float row_scale(const float* ssq, int row) { return __builtin_amdgcn_rsqf(ssq[row] * (1.0f / D) + EPS); }
struct EpiSwiglu {
    bf16_t* O; const float* ssq;
    __device__ __forceinline__ void operator()(const Acc& acc, const Unit& u, int wr, int wc, int fr, int fq) const {
        const int row0 = u.pm * BM + wr * 64 + fr, col0 = u.pn * HALF + wc * 32 + 8 * fq;
        float rs[2][4];
#pragma unroll
        for (int ai = 0; ai < 2; ++ai)
#pragma unroll
            for (int m = 0; m < 4; ++m) rs[ai][m] = row_scale(ssq, row0 + ai * HALF + m * 16);
#pragma unroll
        for (int ai = 0; ai < 2; ++ai)
#pragma unroll
            for (int m = 0; m < 4; ++m) {
                f32x4 v[2];
#pragma unroll
                for (int n = 0; n < 2; ++n) { const f32x4 gt = acc[ai][0][m][n] * rs[ai][m], up = acc[ai][1][m][n] * rs[ai][m];
#pragma unroll
                    for (int j = 0; j < 4; ++j) v[n][j] = gt[j] * sigmoid_f(gt[j]) * up[j]; }
                *(u32x4*)(O + (size_t)(row0 + ai * HALF + m * 16) * FF + col0) = pack8(v[0], v[1]);
            }
    }
};
struct EpiH {
    bf16_t* C;
    __device__ __forceinline__ void operator()(const Acc& acc, const Unit& u, int wr, int wc, int fr, int fq) const {
        const int row0 = u.pm * BM + wr * 64 + fr, col0 = u.pn * BM + wc * 32 + 8 * fq;
#pragma unroll
        for (int ai = 0; ai < 2; ++ai)
#pragma unroll
            for (int m = 0; m < 4; ++m) { bf16_t* rowp = C + (size_t)(row0 + ai * HALF + m * 16) * D + col0;
#pragma unroll
                for (int bj = 0; bj < 2; ++bj) *(u32x4*)(rowp + bj * HALF) = pack8(acc[ai][bj][m][0], acc[ai][bj][m][1]); }
    }
};
struct EpiWin {
    bf16_t *ZB, *ZCV, *ZP, *ZG; const float* bgate; const float* ssq;
    __device__ __forceinline__ void operator()(const Acc& acc, const Unit& u, int wr, int wc, int fr, int fq) const {
        const int row0 = u.pm * BM + wr * 64 + fr, pn = u.pn, cw = wc * 32 + 8 * fq;
        float rs[2][4];
#pragma unroll
        for (int ai = 0; ai < 2; ++ai)
#pragma unroll
            for (int m = 0; m < 4; ++m) rs[ai][m] = row_scale(ssq, row0 + ai * HALF + m * 16);
        if (pn >= 4 && pn < 12) {
            const int col0 = (pn - 4) * HALF + cw;
#pragma unroll
            for (int ai = 0; ai < 2; ++ai)
#pragma unroll
                for (int m = 0; m < 4; ++m) { const float r2 = rs[ai][m] * rs[ai][m];
                    *(u32x4*)(ZCV + (size_t)(row0 + ai * HALF + m * 16) * D + col0) = pack8(acc[ai][0][m][0] * acc[ai][1][m][0] * r2, acc[ai][0][m][1] * acc[ai][1][m][1] * r2); }
        } else if (pn < 16) {
            bf16_t* base = pn < 4 ? ZB : ZP; const int col0 = (pn < 4 ? pn : pn - 12) * BM + cw;
#pragma unroll
            for (int ai = 0; ai < 2; ++ai)
#pragma unroll
                for (int m = 0; m < 4; ++m) { bf16_t* rowp = base + (size_t)(row0 + ai * HALF + m * 16) * D + col0;
#pragma unroll
                    for (int bj = 0; bj < 2; ++bj) *(u32x4*)(rowp + bj * HALF) = pack8(acc[ai][bj][m][0] * rs[ai][m], acc[ai][bj][m][1] * rs[ai][m]); }
        } else {
            const int col0 = (pn - 16) * BM + cw;
            f32x4 bv[2][2];
#pragma unroll
            for (int bj = 0; bj < 2; ++bj)
#pragma unroll
                for (int n = 0; n < 2; ++n) bv[bj][n] = *(const f32x4*)(bgate + col0 + bj * HALF + 4 * n);
#pragma unroll
            for (int ai = 0; ai < 2; ++ai)
#pragma unroll
                for (int m = 0; m < 4; ++m) { bf16_t* rowp = ZG + (size_t)(row0 + ai * HALF + m * 16) * 2048 + col0;
#pragma unroll
                    for (int bj = 0; bj < 2; ++bj) { f32x4 v[2];
#pragma unroll
                        for (int n = 0; n < 2; ++n) { const f32x4 a = acc[ai][bj][m][n] * rs[ai][m] + bv[bj][n];
#pragma unroll
                            for (int j = 0; j < 4; ++j) v[n][j] = sigmoid_f(a[j]); }
                        *(u32x4*)(rowp + bj * HALF) = pack8(v[0], v[1]); } }
        }
    }
};
struct EpiPoolGroup {
    bf16_t* O; const float* bias; const float* scale;
    __device__ __forceinline__ void operator()(const Acc& acc, const Unit& u, int wr, int wc, int fr, int fq) const {
        const int row0 = u.pm * BM + wr * 64 + fr, col0 = u.pn * BM + wc * 32 + 8 * fq;
        f32x4 bv[2][2], sv[2][2];
#pragma unroll
        for (int bj = 0; bj < 2; ++bj)
#pragma unroll
            for (int n = 0; n < 2; ++n) { bv[bj][n] = *(const f32x4*)(bias + col0 + bj * HALF + 4 * n); sv[bj][n] = *(const f32x4*)(scale + col0 + bj * HALF + 4 * n); }
#pragma unroll
        for (int ai = 0; ai < 2; ++ai)
#pragma unroll
            for (int m = 0; m < 4; ++m) { bf16_t* rowp = O + (size_t)(row0 + ai * HALF + m * 16) * D + col0;
#pragma unroll
                for (int bj = 0; bj < 2; ++bj) *(u32x4*)(rowp + bj * HALF) = pack8((acc[ai][bj][m][0] + bv[bj][0]) * sv[bj][0], (acc[ai][bj][m][1] + bv[bj][1]) * sv[bj][1]); }
    }
};
__device__ __forceinline__ void unpack8v(const u32x4 q, f32x4& a, f32x4& b) { a = (f32x4){bf_lo(q.x), bf_hi(q.x), bf_lo(q.y), bf_hi(q.y)}; b = (f32x4){bf_lo(q.z), bf_hi(q.z), bf_lo(q.w), bf_hi(q.w)}; }
struct EpiGateA {
    const bf16_t* ZG; bf16_t* M1;
    __device__ __forceinline__ void operator()(const Acc& acc, const Unit& u, int wr, int wc, int fr, int fq) const {
        const int row0 = u.pm * BM + wr * 64 + fr, col0 = u.pn * BM + wc * 32 + 8 * fq;
#pragma unroll
        for (int ai = 0; ai < 2; ++ai) {
            u32x4 gq[4][2];
#pragma unroll
            for (int m = 0; m < 4; ++m)
#pragma unroll
                for (int bj = 0; bj < 2; ++bj) gq[m][bj] = *(const u32x4*)(ZG + (size_t)(row0 + ai * HALF + m * 16) * 2048 + col0 + bj * HALF);
#pragma unroll
            for (int m = 0; m < 4; ++m)
#pragma unroll
                for (int bj = 0; bj < 2; ++bj) { f32x4 g0, g1; unpack8v(gq[m][bj], g0, g1);
                    *(u32x4*)(M1 + (size_t)(row0 + ai * HALF + m * 16) * D + col0 + bj * HALF) = pack8(g0 * acc[ai][bj][m][0], g1 * acc[ai][bj][m][1]); }
        }
    }
};
struct EpiGateP {
    const bf16_t* ZG; const bf16_t* M1; bf16_t* MM;
    __device__ __forceinline__ void operator()(const Acc& acc, const Unit& u, int wr, int wc, int fr, int fq) const {
        const int row0 = u.pm * BM + wr * 64 + fr, col0 = u.pn * BM + wc * 32 + 8 * fq;
#pragma unroll
        for (int ai = 0; ai < 2; ++ai) {
            u32x4 gq[4][2], mq[4][2];
#pragma unroll
            for (int m = 0; m < 4; ++m)
#pragma unroll
                for (int bj = 0; bj < 2; ++bj) { const size_t r = (size_t)(row0 + ai * HALF + m * 16);
                    gq[m][bj] = *(const u32x4*)(ZG + r * 2048 + D + col0 + bj * HALF); mq[m][bj] = *(const u32x4*)(M1 + r * D + col0 + bj * HALF); }
#pragma unroll
            for (int m = 0; m < 4; ++m)
#pragma unroll
                for (int bj = 0; bj < 2; ++bj) { f32x4 g0, g1, m0, m1; unpack8v(gq[m][bj], g0, g1); unpack8v(mq[m][bj], m0, m1);
                    *(u32x4*)(MM + (size_t)(row0 + ai * HALF + m * 16) * D + col0 + bj * HALF) = pack8(m0 + g0 * acc[ai][bj][m][0], m1 + g1 * acc[ai][bj][m][1]); }
        }
    }
};
}


#define XB_TMO      128
#define XB_XCNT(j)  (256  + 64 * (j))
#define XB_XSUB(j)  (1280 + 64 * (j))
#define XB_XGEN(j)  (2304 + 64 * (j))
#define XB_TOP      3328
#define XB_TOPGEN   3392
#define XCD_BAR_WORDS 3456
#define XB_SPIN_CAP (1u << 18)

__device__ __forceinline__ unsigned xb_ld(unsigned* p)              { return __hip_atomic_load(p, __ATOMIC_RELAXED, __HIP_MEMORY_SCOPE_AGENT); }
__device__ __forceinline__ unsigned xb_add(unsigned* p, unsigned v) { return __hip_atomic_fetch_add(p, v, __ATOMIC_RELAXED, __HIP_MEMORY_SCOPE_AGENT); }
__device__ __forceinline__ unsigned xb_xcc_id() { return (unsigned)__builtin_amdgcn_s_getreg((3 << 11) | 20) & 0xFu; }
#define XB_SPIN(cond, bar) do { unsigned _sp = 0; while (cond) { __builtin_amdgcn_s_sleep(1); \
    if ((++_sp & 255u) == 0u) { if (xb_ld(&(bar)[XB_TMO])) break; if (_sp > XB_SPIN_CAP) { atomicAdd(&(bar)[XB_TMO], 1u); break; } } } } while (0)

struct XcdBarrier {
    unsigned* bar; unsigned x;
    volatile LAS unsigned* st;
};

__device__ __forceinline__ XcdBarrier xcd_barrier_post(unsigned* bar, volatile LAS unsigned* st) {
    XcdBarrier b; b.bar = bar; b.x = xb_xcc_id(); b.st = st;
    if (threadIdx.x == 0) (void)xb_add(&bar[XB_XCNT(b.x)], 1u);
    return b;
}
__device__ __forceinline__ void xcd_barrier_complete(unsigned* bar, unsigned x, unsigned& nloc, unsigned& nx) {
    const unsigned G = gridDim.x * gridDim.y * gridDim.z;
    unsigned sum, cnt, mine, sp = 0u;
    for (;;) {
        sum = 0u; cnt = 0u; mine = 0u;
#pragma unroll
        for (unsigned j = 0; j < 16; ++j) { const unsigned c = xb_ld(&bar[XB_XCNT(j)]); sum += c; cnt += (c > 0u) ? 1u : 0u; mine = (j == x) ? c : mine; }
        if (sum == G) break;
        __builtin_amdgcn_s_sleep(1);
        if ((++sp & 255u) == 0u) { if (xb_ld(&bar[XB_TMO])) break; if (sp > XB_SPIN_CAP) { atomicAdd(&bar[XB_TMO], 1u); break; } }
    }
    nloc = mine > 0u ? mine : 1u; nx = cnt > 0u ? cnt : 1u;
}

__device__ __forceinline__ void xcd_barrier(const XcdBarrier& b) {
    asm volatile("s_waitcnt vmcnt(0)" ::: "memory");
    __syncthreads();
    if (threadIdx.x == 0) {
        unsigned* bar = b.bar;
        __builtin_amdgcn_s_waitcnt(0);
        unsigned nloc = b.st[0], nx = b.st[1];
        if (nloc == 0u) { xcd_barrier_complete(bar, b.x, nloc, nx); b.st[0] = nloc; b.st[1] = nx; }
        const unsigned old = xb_add(&bar[XB_XSUB(b.x)], 1u);
        const unsigned gen = old / nloc;
        if (old + 1u == (gen + 1u) * nloc) {
            __builtin_amdgcn_fence(__ATOMIC_RELEASE, "agent");
            asm volatile("s_waitcnt vmcnt(0)" ::: "memory");
            const unsigned og = xb_add(&bar[XB_TOP], 1u);
            const unsigned tg = og / nx;
            if (og + 1u == (tg + 1u) * nx) xb_add(&bar[XB_TOPGEN], 1u);
            else XB_SPIN(xb_ld(&bar[XB_TOPGEN]) == tg, bar);
            __builtin_amdgcn_fence(__ATOMIC_ACQUIRE, "agent");
            xb_add(&bar[XB_XGEN(b.x)], 1u);
            asm volatile("s_waitcnt vmcnt(0)" ::: "memory");
        } else {
            XB_SPIN(xb_ld(&bar[XB_XGEN(b.x)]) == gen, bar);
            __builtin_amdgcn_fence(__ATOMIC_ACQUIRE, "agent");
            asm volatile("s_waitcnt vmcnt(0)" ::: "memory");
        }
    }
    __syncthreads();
}

struct Args { const float* in[20]; float* out; unsigned char* ws; int ph_lo, ph_hi; };
struct Ctx { LAS unsigned char* lds; int lane, wave, gw, NGW, G; };

__device__ __forceinline__ void transpose_item(const float* W, int ldsrc, int K, int src_col0, bf16_t* WT, int dst_row0, int k0, const float* kscale, LAS float* scr, int lane) {
#pragma unroll 8
    for (int i = 0; i < 32; ++i) { const int kk = 2 * i + (lane >> 5); const float sc = kscale ? kscale[k0 + kk] : 1.0f; scr[kk * 33 + (lane & 31)] = W[(size_t)(k0 + kk) * ldsrc + src_col0 + (lane & 31)] * sc; }
    LDS_WAIT(); asm volatile("" ::: "memory");
    const int c = lane & 7;
#pragma unroll
    for (int j = 0; j < 4; ++j) { const int n = (lane >> 3) + 8 * j; const LAS float* sp = scr + (8 * c) * 33 + n;
        u32x4 o; o.x = cvt_pk_bf16(sp[0 * 33], sp[1 * 33]); o.y = cvt_pk_bf16(sp[2 * 33], sp[3 * 33]); o.z = cvt_pk_bf16(sp[4 * 33], sp[5 * 33]); o.w = cvt_pk_bf16(sp[6 * 33], sp[7 * 33]);
        *(u32x4*)(WT + (size_t)(dst_row0 + n) * K + k0 + 8 * c) = o; }
    LDS_WAIT(); asm volatile("" ::: "memory");
}
__device__ __forceinline__ int map_gu(int n) { return ((n >> 7) & 1) * FF + (n >> 8) * 128 + (n & 127); }
__device__ __forceinline__ int map_in(int n) { if (n < 1024 || n >= 3072) return n; const int q = (n - 1024) >> 8, h = (n >> 7) & 1; return (h ? 2048 : 1024) + q * 128 + (n & 127); }

__device__ __forceinline__ void prep_weights(const Ctx& F, const Args& a, unsigned char* ws, int l) {
    LAS float* scr = (LAS float*)(F.lds + F.wave * 16384);
    constexpr int I_GU = (D / 64) * (NGU / 32), I_D = (FF / 64) * (D / 32), I_IN = (D / 64) * (NIN / 32), I_SQ = (D / 64) * (D / 32), I_PG = 4 * (256 / 64) * (256 / 32);
    constexpr int NITEMS = 2 * I_GU + 2 * I_D + I_IN + 3 * I_SQ + I_PG;
    for (int it = F.gw; it < NITEMS; it += F.NGW) {
        int r = it;
        if (r < 2 * I_GU) { const int w = r / I_GU; r -= w * I_GU; const int kb = r / (NGU / 32), nb = r % (NGU / 32);
            transpose_item(a.in[w ? 18 : 3] + (size_t)l * D * NGU, NGU, D, map_gu(32 * nb), (bf16_t*)(ws + (w ? W_GU2 : W_GU1)), 32 * nb, 64 * kb, a.in[w ? 16 : 1] + l * D, scr, F.lane); continue; }
        r -= 2 * I_GU;
        if (r < 2 * I_D) { const int w = r / I_D; r -= w * I_D; const int kb = r / (D / 32), nb = r % (D / 32);
            transpose_item(a.in[w ? 19 : 4] + (size_t)l * FF * D, D, FF, 32 * nb, (bf16_t*)(ws + (w ? W_D2 : W_D1)), 32 * nb, 64 * kb, nullptr, scr, F.lane); continue; }
        r -= 2 * I_D;
        if (r < I_IN) { const int kb = r / (NIN / 32), nb = r % (NIN / 32);
            transpose_item(a.in[7] + (size_t)l * D * NIN, NIN, D, map_in(32 * nb), (bf16_t*)(ws + W_IN), 32 * nb, 64 * kb, a.in[5] + l * D, scr, F.lane); continue; }
        r -= I_IN;
        if (r < 3 * I_SQ) { const int w = r / I_SQ; r -= w * I_SQ; const int kb = r / (D / 32), nb = r % (D / 32);
            transpose_item(a.in[w == 0 ? 10 : (w == 1 ? 14 : 15)] + (size_t)l * D * D, D, D, 32 * nb, (bf16_t*)(ws + (w == 0 ? W_CO : (w == 1 ? W_PO : W_WO))), 32 * nb, 64 * kb, nullptr, scr, F.lane); continue; }
        r -= 3 * I_SQ;
        { const int gi = r / 32; r -= gi * 32; const int kb = r / 8, nb = r % 8;
            transpose_item(a.in[11] + (size_t)l * 4 * 65536 + (size_t)gi * 65536, 256, 256, 32 * nb, (bf16_t*)(ws + W_PG), gi * 256 + 32 * nb, 64 * kb, nullptr, scr, F.lane); }
    }
}

__device__ __forceinline__ void cast_rows(const Ctx& F, const float* x, bf16_t* Xb, float* ssq) {
    for (int m = F.gw; m < M; m += F.NGW) {
        const f32x4* xr = (const f32x4*)(x + (size_t)m * D) + F.lane;
        f32x4 v[4]; float s = 0.f;
#pragma unroll
        for (int j = 0; j < 4; ++j) { v[j] = xr[64 * j]; s += (v[j].x * v[j].x + v[j].y * v[j].y) + (v[j].z * v[j].z + v[j].w * v[j].w); }
        s = wave_sum(s, F.lane);
        u32x2* o = (u32x2*)(Xb + (size_t)m * D) + F.lane;
#pragma unroll
        for (int j = 0; j < 4; ++j) { u32x2 w; w.x = cvt_pk_bf16(v[j].x, v[j].y); w.y = cvt_pk_bf16(v[j].z, v[j].w); o[64 * j] = w; }
        if (F.lane == 0) ssq[m] = s;
    }
}
__device__ __forceinline__ void resid_rows(const Ctx& F, bf16_t* Xb, const bf16_t* h, const float* post, float cs, float* ssq, float* outf) {
    f32x4 pv[4];
#pragma unroll
    for (int j = 0; j < 4; ++j) pv[j] = ((const f32x4*)post)[F.lane + 64 * j] * cs;
    for (int m0 = F.gw; m0 < M; m0 += 2 * F.NGW) {
        const int m1 = m0 + F.NGW; const bool two = m1 < M; const int mb = two ? m1 : m0;
        f32x4 hv[2][4], xv[2][4];
#pragma unroll
        for (int r = 0; r < 2; ++r) { const int m = r ? mb : m0;
            const u32x2* hr = (const u32x2*)(h + (size_t)m * D) + F.lane; const u32x2* xr = (const u32x2*)(Xb + (size_t)m * D) + F.lane;
#pragma unroll
            for (int j = 0; j < 4; ++j) { const u32x2 q = hr[64 * j]; hv[r][j] = (f32x4){bf_lo(q.x), bf_hi(q.x), bf_lo(q.y), bf_hi(q.y)};
                const u32x2 p = xr[64 * j]; xv[r][j] = (f32x4){bf_lo(p.x), bf_hi(p.x), bf_lo(p.y), bf_hi(p.y)}; } }
#pragma unroll
        for (int r = 0; r < 2; ++r) { const int m = r ? mb : m0; if (r && !two) break;
            float s = 0.f;
#pragma unroll
            for (int j = 0; j < 4; ++j) s += (hv[r][j].x * hv[r][j].x + hv[r][j].y * hv[r][j].y) + (hv[r][j].z * hv[r][j].z + hv[r][j].w * hv[r][j].w);
            const float r1 = 1.0f / sqrtf(wave_sum(s, F.lane) * (1.f / D) + EPS);
            if (outf) {
                f32x4* xo = (f32x4*)(outf + (size_t)m * D) + F.lane;
#pragma unroll
                for (int j = 0; j < 4; ++j) xo[64 * j] = xv[r][j] + hv[r][j] * r1 * pv[j];
            } else {
                float s2 = 0.f;
                u32x2* o = (u32x2*)(Xb + (size_t)m * D) + F.lane;
#pragma unroll
                for (int j = 0; j < 4; ++j) { const f32x4 xn = xv[r][j] + hv[r][j] * r1 * pv[j]; u32x2 w; w.x = cvt_pk_bf16(xn.x, xn.y); w.y = cvt_pk_bf16(xn.z, xn.w); o[64 * j] = w;
                    const f32x4 xr_ = {bf_lo(w.x), bf_hi(w.x), bf_lo(w.y), bf_hi(w.y)};
                    s2 += (xr_.x * xr_.x + xr_.y * xr_.y) + (xr_.z * xr_.z + xr_.w * xr_.w); }
                s2 = wave_sum(s2, F.lane);
                if (F.lane == 0) ssq[m] = s2;
            }
        }
    }
}
__device__ __forceinline__ void unpack8(const u32x4 q, float (&f)[8]) { f[0] = bf_lo(q.x); f[1] = bf_hi(q.x); f[2] = bf_lo(q.y); f[3] = bf_hi(q.y); f[4] = bf_lo(q.z); f[5] = bf_hi(q.z); f[6] = bf_lo(q.w); f[7] = bf_hi(q.w); }
__device__ __forceinline__ void mix_rows(const Ctx& F, bf16_t* ZBCA, const bf16_t* ZCV, const bf16_t* ZP, const float* convw, bf16_t* DDo) {
    const int half = F.gw & 1, c0 = half * 512 + F.lane * 8;
    const int npair = F.NGW >> 1, tpw = (M + npair - 1) / npair, t0 = (F.gw >> 1) * tpw;
    float w0[8], w1[8], w2[8];
#pragma unroll
    for (int j = 0; j < 8; ++j) { w0[j] = convw[c0 + j]; w1[j] = convw[D + c0 + j]; w2[j] = convw[2 * D + c0 + j]; }
    const int win = 2 << (c0 >> 8), wmax = half ? 16 : 4;
    for (int t = t0; t < t0 + tpw && t < M; ++t) {
        const int s = t & (SEQ - 1);
        const size_t off = (size_t)t * D + c0;
        const u32x4 zero = {0u, 0u, 0u, 0u};
        const u32x4 qb = *(const u32x4*)(ZBCA + off), q2 = *(const u32x4*)(ZCV + off);
        const u32x4 q1 = s >= 1 ? *(const u32x4*)(ZCV + off - D) : zero, q0 = s >= 2 ? *(const u32x4*)(ZCV + off - 2 * D) : zero;
        const u32x4 qp = *(const u32x4*)(ZP + off);
        float fb[8], f0[8], f1[8], f2[8], fp[8], acc[8];
        unpack8(qb, fb); unpack8(q0, f0); unpack8(q1, f1); unpack8(q2, f2); unpack8(qp, fp);
#pragma unroll
        for (int j = 0; j < 8; ++j) acc[j] = fp[j];
        for (int k = 1; k < wmax; ++k) {
            const bool ok = (k < win) && (s >= k);
            const u32x4 q = ok ? *(const u32x4*)(ZP + off - (size_t)k * D) : zero;
            float f[8]; unpack8(q, f);
#pragma unroll
            for (int j = 0; j < 8; ++j) acc[j] += f[j];
        }
        const float inv = 1.0f / (float)((s + 1) < win ? (s + 1) : win);
        float ca[8], dd[8];
#pragma unroll
        for (int j = 0; j < 8; ++j) { ca[j] = fb[j] * (w0[j] * f0[j] + w1[j] * f1[j] + w2[j] * f2[j]); dd[j] = acc[j] * inv - fp[j]; }
        u32x4 o1, o2;
        o1.x = cvt_pk_bf16(ca[0], ca[1]); o1.y = cvt_pk_bf16(ca[2], ca[3]); o1.z = cvt_pk_bf16(ca[4], ca[5]); o1.w = cvt_pk_bf16(ca[6], ca[7]);
        o2.x = cvt_pk_bf16(dd[0], dd[1]); o2.y = cvt_pk_bf16(dd[2], dd[3]); o2.z = cvt_pk_bf16(dd[4], dd[5]); o2.w = cvt_pk_bf16(dd[6], dd[7]);
        *(u32x4*)(ZBCA + off) = o1; *(u32x4*)(DDo + off) = o2;
    }
}

__device__ __forceinline__ bool launder(Ctx& F, unsigned char*& ws, int& tidv) { int t; asm volatile("v_mbcnt_lo_u32_b32 %0, -1, 0\n\tv_mbcnt_hi_u32_b32 %0, -1, %0" : "=v"(t)); F.lane = t; tidv = F.wave * 64 + t;
    const unsigned long long w0 = (unsigned long long)ws; unsigned wl = __builtin_amdgcn_readfirstlane((unsigned)w0), wh = __builtin_amdgcn_readfirstlane((unsigned)(w0 >> 32)); asm volatile("" : "+s"(wl), "+s"(wh));
    const unsigned long long w = ((unsigned long long)wh << 32) | wl; ws = (unsigned char*)(__attribute__((address_space(1))) unsigned char*)w; return true; }
constexpr int PH_PER_LAYER = 12, N_PHASES = 1 + DEPTH * PH_PER_LAYER;

__global__ void __launch_bounds__(512, 2) mega_fwd(Args a) {
    extern __shared__ __attribute__((aligned(16))) unsigned char lds_raw[];
    Ctx F; F.lds = (LAS unsigned char*)lds_raw; F.lane = threadIdx.x & 63; F.wave = __builtin_amdgcn_readfirstlane(threadIdx.x >> 6);
    F.G = gridDim.x; F.gw = blockIdx.x * 8 + F.wave; F.NGW = F.G * 8;
    unsigned char* ws = a.ws; int tidv = threadIdx.x;
    const int lo = a.ph_lo, hi = a.ph_hi;
    volatile LAS unsigned* MISC = (volatile LAS unsigned*)(F.lds + MISC_OFF);
    if (threadIdx.x < 32) MISC[threadIdx.x] = 0u;
    __syncthreads();
    XcdBarrier bar; bar.bar = (unsigned*)(ws + WS_BAR); bar.x = 0; bar.st = nullptr;
    if (hi - lo > 1) bar = xcd_barrier_post((unsigned*)(ws + WS_BAR), MISC + 8);
    if (lo < 0) cg::this_grid().sync();
    int ph = 0;
#define IN_PH (lo <= ph && ph < hi && launder(F, ws, tidv))
#define SEAM() do { if (lo <= ph && ph + 1 < hi) { xcd_barrier(bar); } ++ph; } while (0)
#define XB ((bf16_t*)(ws + WS_XB))
#define SSQ ((float*)(ws + WS_SSQ))
    if (IN_PH) { prep_weights(F, a, ws, 0); cast_rows(F, a.in[0], XB, SSQ); }
    SEAM();
    for (int l = 0; l < DEPTH; ++l) {
        if (IN_PH) { pg8::Gemm g{XB, (const bf16_t*)(ws + W_GU1), M, NGU, D, D, 0}; pg8::StaticOrder S; S.init(M, NGU, F.G, blockIdx.x);
            pg8::EpiSwiglu E{(bf16_t*)(ws + WS_HH), SSQ}; pg8::gemm_phase(F.lds, g, S, E, tidv); }
        SEAM();
        if (IN_PH) { pg8::Gemm g{(const bf16_t*)(ws + WS_HH), (const bf16_t*)(ws + W_D1), M, D, FF, FF, 0}; pg8::StaticOrder S; S.init(M, D, F.G, blockIdx.x);
            pg8::EpiH E{(bf16_t*)(ws + WS_HFFN)}; pg8::gemm_phase(F.lds, g, S, E, tidv); }
        SEAM();
        if (IN_PH) resid_rows(F, XB, (const bf16_t*)(ws + WS_HFFN), a.in[2] + l * D, 0.5f, SSQ, nullptr);
        SEAM();
        if (IN_PH) { pg8::Gemm g{XB, (const bf16_t*)(ws + W_IN), M, NIN, D, D, 0}; pg8::StaticOrder S; S.init(M, NIN, F.G, blockIdx.x);
            pg8::EpiWin E{(bf16_t*)(ws + WS_ZB), (bf16_t*)(ws + WS_ZCV), (bf16_t*)(ws + WS_ZP), (bf16_t*)(ws + WS_ZG), a.in[8] + l * 2 * D, SSQ}; pg8::gemm_phase(F.lds, g, S, E, tidv); }
        SEAM();
        if (IN_PH) mix_rows(F, (bf16_t*)(ws + WS_ZB), (const bf16_t*)(ws + WS_ZCV), (const bf16_t*)(ws + WS_ZP), a.in[9] + l * 3 * D, (bf16_t*)(ws + WS_DD));
        SEAM();
        if (IN_PH) { pg8::Gemm g{(const bf16_t*)(ws + WS_DD), (const bf16_t*)(ws + W_PG), M, D, 256, D, 256}; pg8::StaticOrder S; S.init(M, D, F.G, blockIdx.x);
            pg8::EpiPoolGroup E{(bf16_t*)(ws + WS_YP0), a.in[12] + l * D, a.in[13] + l * D}; pg8::gemm_phase(F.lds, g, S, E, tidv); }
        if (IN_PH) { pg8::Gemm g{(const bf16_t*)(ws + WS_CA), (const bf16_t*)(ws + W_CO), M, D, D, D, 0}; pg8::StaticOrder S; S.init(M, D, F.G, blockIdx.x);
            pg8::EpiGateA E{(const bf16_t*)(ws + WS_ZG), (bf16_t*)(ws + WS_M1)}; pg8::gemm_phase(F.lds, g, S, E, tidv); }
        SEAM();
        if (IN_PH) { pg8::Gemm g{(const bf16_t*)(ws + WS_YP0), (const bf16_t*)(ws + W_PO), M, D, D, D, 0}; pg8::StaticOrder S; S.init(M, D, F.G, blockIdx.x);
            pg8::EpiGateP E{(const bf16_t*)(ws + WS_ZG), (const bf16_t*)(ws + WS_M1), (bf16_t*)(ws + WS_MM)}; pg8::gemm_phase(F.lds, g, S, E, tidv); }
        SEAM();
        if (IN_PH) { pg8::Gemm g{(const bf16_t*)(ws + WS_MM), (const bf16_t*)(ws + W_WO), M, D, D, D, 0}; pg8::StaticOrder S; S.init(M, D, F.G, blockIdx.x);
            pg8::EpiH E{(bf16_t*)(ws + WS_HMIX)}; pg8::gemm_phase(F.lds, g, S, E, tidv); }
        SEAM();
        if (IN_PH) resid_rows(F, XB, (const bf16_t*)(ws + WS_HMIX), a.in[6] + l * D, 1.0f, SSQ, nullptr);
        SEAM();
        if (IN_PH) { pg8::Gemm g{XB, (const bf16_t*)(ws + W_GU2), M, NGU, D, D, 0}; pg8::StaticOrder S; S.init(M, NGU, F.G, blockIdx.x);
            pg8::EpiSwiglu E{(bf16_t*)(ws + WS_HH), SSQ}; pg8::gemm_phase(F.lds, g, S, E, tidv); }
        SEAM();
        if (IN_PH) { pg8::Gemm g{(const bf16_t*)(ws + WS_HH), (const bf16_t*)(ws + W_D2), M, D, FF, FF, 0}; pg8::StaticOrder S; S.init(M, D, F.G, blockIdx.x);
            pg8::EpiH E{(bf16_t*)(ws + WS_HFFN)}; pg8::gemm_phase(F.lds, g, S, E, tidv); }
        SEAM();
        if (IN_PH) { const bool more = (l + 1 < DEPTH);
            resid_rows(F, XB, (const bf16_t*)(ws + WS_HFFN), a.in[17] + l * D, 0.5f, SSQ, more ? nullptr : a.out);
            if (more) prep_weights(F, a, ws, l + 1); }
        SEAM();
    }
#undef IN_PH
#undef SEAM
}

extern "C" void kernel_launch(void* const* d_in, const int* in_sizes, int n_in, void* d_out, int out_size, void* d_ws, size_t ws_size, hipStream_t stream) {
    static int grid = 0;
    if (grid == 0) {
        if (n_in != 20 || in_sizes[0] != M * D || out_size != M * D || ws_size < WS_END) { fprintf(stderr, "kernel_launch: unexpected shapes (n_in %d, in0 %d, out %d, ws %zu < %zu)\n", n_in, n_in > 0 ? in_sizes[0] : -1, out_size, ws_size, (size_t)WS_END); grid = -1; return; }
        int dev = 0, cus = 0, per_cu = 0;
        (void)hipGetDevice(&dev); (void)hipDeviceGetAttribute(&cus, hipDeviceAttributeMultiprocessorCount, dev);
        if (hipFuncSetAttribute((const void*)mega_fwd, hipFuncAttributeMaxDynamicSharedMemorySize, LDS_BYTES) != hipSuccess) { fprintf(stderr, "kernel_launch: hipFuncSetAttribute failed\n"); grid = -1; return; }
        if (hipOccupancyMaxActiveBlocksPerMultiprocessor(&per_cu, (const void*)mega_fwd, 512, LDS_BYTES) != hipSuccess || per_cu < 1) { fprintf(stderr, "kernel_launch: occupancy query says %d\n", per_cu); per_cu = 1; (void)hipGetLastError(); }
        grid = cus * per_cu;
    }
    if (grid < 0) return;
    Args a{};
    for (int i = 0; i < 20; ++i) a.in[i] = (const float*)d_in[i];
    a.out = (float*)d_out; a.ws = (unsigned char*)d_ws;
#if MK_ONE_LAUNCH
    if (hipMemsetAsync((char*)d_ws, 0, CTL_ZERO_BYTES, stream) != hipSuccess) { fprintf(stderr, "kernel_launch: memset failed\n"); return; }
    a.ph_lo = 0; a.ph_hi = N_PHASES;
    void* args[] = {&a};
    hipError_t e = hipLaunchCooperativeKernel((const void*)mega_fwd, dim3(grid), dim3(512), args, LDS_BYTES, stream);
    if (e != hipSuccess) fprintf(stderr, "cooperative launch failed: %s (grid %d)\n", hipGetErrorString(e), grid);
#else
    for (int p = 0; p < N_PHASES; ++p) { a.ph_lo = p; a.ph_hi = p + 1; hipLaunchKernelGGL(mega_fwd, dim3(grid), dim3(512), LDS_BYTES, stream, a); }
#endif
}
```

```cpp
#include <hip/hip_runtime.h>
#include <hip/hip_cooperative_groups.h>
#include <cstdio>
#include <cstdint>
namespace cg = cooperative_groups;

#ifndef MK_ONE_LAUNCH
#define MK_ONE_LAUNCH 1
#endif

#define LAS __attribute__((address_space(3)))
typedef unsigned short bf16_t;
typedef short bf16x8 __attribute__((ext_vector_type(8)));
typedef float f32x4 __attribute__((ext_vector_type(4)));
typedef unsigned u32x4 __attribute__((ext_vector_type(4)));
typedef unsigned u32x2 __attribute__((ext_vector_type(2)));

constexpr int D = 1024, SEQ = 2048, BATCH = 16, M = BATCH * SEQ, FF = 2816, NGU = 2 * FF, NIN = 6144, DEPTH = 2;
constexpr float EPS = 1e-6f;
constexpr size_t MiB = 1u << 20;
constexpr size_t WS_W = 1 * MiB;
constexpr size_t W_GU1 = WS_W, W_D1 = W_GU1 + (size_t)NGU * D * 2, W_IN = W_D1 + (size_t)D * FF * 2, W_PG = W_IN + (size_t)NIN * D * 2,
                 W_CO = W_PG + (size_t)D * 256 * 2, W_PO = W_CO + (size_t)D * D * 2, W_WO = W_PO + (size_t)D * D * 2, W_GU2 = W_WO + (size_t)D * D * 2,
                 W_D2 = W_GU2 + (size_t)NGU * D * 2, W_END = W_D2 + (size_t)D * FF * 2;
static_assert(W_END <= 56 * MiB, "weights");
constexpr size_t WS_SSQ = 512 * 1024;
constexpr size_t WS_XB = 56 * MiB;
constexpr size_t WS_R0 = 120 * MiB;
constexpr size_t WS_ZG = WS_R0;
constexpr size_t WS_ZB = WS_R0 + 128 * MiB;
constexpr size_t WS_ZCV = WS_ZB + 64 * MiB;
constexpr size_t WS_ZP = WS_ZCV + 64 * MiB;
constexpr size_t WS_DD = WS_ZP + 64 * MiB;
constexpr size_t WS_CA = WS_ZB;
constexpr size_t WS_YP0 = WS_ZCV;
constexpr size_t WS_M1 = WS_ZP;
constexpr size_t WS_MM = WS_DD;
constexpr size_t WS_HMIX = WS_R0;
constexpr size_t WS_HH = WS_R0;
constexpr size_t WS_HFFN = WS_ZCV;
constexpr size_t WS_END = WS_DD + 64 * MiB;
static_assert(WS_HH + (size_t)M * FF * 2 <= WS_HFFN, "H overlay");
constexpr int LDS_BYTES = 147456, MISC_OFF = 131072 + 320;
constexpr size_t WS_BAR = 16384, CTL_ZERO_BYTES = 65536;

typedef float f32x2 __attribute__((ext_vector_type(2)));
typedef __bf16 bf16x2 __attribute__((ext_vector_type(2)));
__device__ __forceinline__ unsigned cvt_pk_bf16(float lo, float hi) { const f32x2 v = {lo, hi}; const bf16x2 b = __builtin_convertvector(v, bf16x2); return __builtin_bit_cast(unsigned, b); }
__device__ __forceinline__ float bf_lo(unsigned u) { return __builtin_bit_cast(float, u << 16); }
__device__ __forceinline__ float bf_hi(unsigned u) { return __builtin_bit_cast(float, u & 0xffff0000u); }
__device__ __forceinline__ float sigmoid_f(float x) { return __builtin_amdgcn_rcpf(1.0f + __expf(-x)); }
__device__ __forceinline__ float wave_sum(float v, int lane) {
#pragma unroll
    for (int o = 1; o < 64; o <<= 1) v += __builtin_bit_cast(float, __builtin_amdgcn_ds_bpermute((lane ^ o) << 2, __builtin_bit_cast(int, v)));
    return v;
}
#define LDS_WAIT() asm volatile("s_waitcnt lgkmcnt(0)" ::: "memory")

namespace pg8 {
constexpr int BM = 256, BK = 64, HALF = 128, HTB = HALF * BK * 2, STAGE_BYTES = 8 * HTB, NXCD = 8, WGM = 8;
__host__ __device__ __forceinline__ int lds_byte(int r, int c) { const int st = (r >> 4) * 2 + (c >> 5), rr = r & 15, cc = c & 31, ob = rr * 64 + cc * 2; return st * 1024 + (ob ^ (((ob >> 9) & 1) << 5)); }
__host__ __device__ __forceinline__ void stage_rc(int b, int& R, int& C) { const int st = b / 1024, sb = b % 1024, swz = sb ^ (((sb >> 9) & 1) << 5); R = (st >> 1) * 16 + swz / 64; C = (st & 1) * 32 + (swz % 64) / 2; }
__host__ __device__ __forceinline__ int perm32(int rho) { const int n = rho >> 4, i = rho & 15; return 8 * (i >> 2) + 4 * n + (i & 3); }

struct Unit { int pm, pn; };
struct Gemm { const bf16_t* A; const bf16_t* Bt; int M, N, K, lda, a_pn_cols; };

struct StaticOrder {
    int nM, nN, nwg, G, c;
    __host__ __device__ void init(int M_, int N_, int G_, int c_) { nM = M_ / BM; nN = N_ / BM; nwg = nM * nN; G = G_; c = c_; }
    __host__ __device__ bool next(int i, Unit& u) const {
        const long L = (long)i * G + c; if (L >= nwg) return false;
        int wgid = (int)L; { const int q = nwg / NXCD, r = nwg % NXCD, xcd = wgid % NXCD, off = wgid / NXCD; wgid = (xcd < r ? xcd * (q + 1) : r * (q + 1) + (xcd - r) * q) + off; }
        const int nig = WGM * nN, gid = wgid / nig, fm = gid * WGM, gsz = (nM - fm) < WGM ? (nM - fm) : WGM;
        u.pm = fm + ((wgid % nig) % gsz); u.pn = (wgid % nig) / gsz; return true;
    }
};

typedef f32x4 Acc[2][2][4][2];
__device__ __forceinline__ const char* uni(const char* p) { const unsigned long long v = (unsigned long long)p; const unsigned lo = __builtin_amdgcn_readfirstlane((unsigned)v), hi = __builtin_amdgcn_readfirstlane((unsigned)(v >> 32)); return (const char*)(((unsigned long long)hi << 32) | lo); }

template <class Epi>
__device__ __forceinline__ void gemm_phase(LAS unsigned char* lds, const Gemm g, const StaticOrder& S, const Epi& E, const int tid) {
    const int wid = __builtin_amdgcn_readfirstlane(tid >> 6), lane = tid & 63, wr = wid >> 2, wc = wid & 3, fr = lane & 15, fq = lane >> 4;
    const int K = g.K, nt = K / BK;
    unsigned voffA[2], voffB[2];
#pragma unroll
    for (int i = 0; i < 2; ++i) { int R, C; stage_rc(tid * 16 + i * 8192, R, C); const int Rb = (R & ~31) + perm32(R & 31);
        voffA[i] = (unsigned)(R * g.lda + C) * 2u; voffB[i] = (unsigned)(Rb * K + C) * 2u; }
    const size_t kstep = (size_t)(BK * 2);
    const size_t hstepA = (size_t)HALF * g.lda * 2, tstepA = 2 * hstepA;
    const size_t hstepB = (size_t)HALF * K * 2, tstepB = 2 * hstepB;
    const size_t pnA = (size_t)g.a_pn_cols * 2;
    const unsigned ldsw = (unsigned)wid * 1024u;
    const int aoff = lds_byte(wr * 64 + fr, fq * 8), boff = lds_byte(wc * 32 + fr, fq * 8);
#define PG8_SA(b, h) (((b) * 2 + (h)) * HTB)
#define PG8_SB(b, h) ((4 + (b) * 2 + (h)) * HTB)
#define PG8_STAGE(bufoff, gbase, voff) do { _Pragma("unroll") for (int _i = 0; _i < 2; ++_i) \
        __builtin_amdgcn_global_load_lds((const unsigned*)((const char*)(gbase) + (voff)[_i]), (LAS unsigned*)(lds + (bufoff) + ldsw + _i * 8192), 16, 0, 0); } while (0)
#define PG8_LDA(dst, b, h) do { _Pragma("unroll") for (int m = 0; m < 4; ++m) _Pragma("unroll") for (int k = 0; k < 2; ++k) dst[m][k] = *(const LAS bf16x8*)(lds + PG8_SA(b, h) + aoff + m * 2048 + k * 1024); } while (0)
#define PG8_LDB(dst, b, h) do { _Pragma("unroll") for (int n = 0; n < 2; ++n) _Pragma("unroll") for (int k = 0; k < 2; ++k) dst[n][k] = *(const LAS bf16x8*)(lds + PG8_SB(b, h) + boff + n * 2048 + k * 1024); } while (0)
#define PG8_MMA(ai, bj, At, Bt) do { __builtin_amdgcn_s_setprio(1); _Pragma("unroll") for (int m = 0; m < 4; ++m) _Pragma("unroll") for (int n = 0; n < 2; ++n) _Pragma("unroll") for (int k = 0; k < 2; ++k) \
        acc[ai][bj][m][n] = __builtin_amdgcn_mfma_f32_16x16x32_bf16(Bt[n][k], At[m][k], acc[ai][bj][m][n], 0, 0, 0); __builtin_amdgcn_s_setprio(0); } while (0)
#define PG8_WAIT_V(n) asm volatile("s_waitcnt vmcnt(" #n ")" ::: "memory")
#define PG8_WAIT_L(n) asm volatile("s_waitcnt lgkmcnt(" #n ")" ::: "memory")
#define PG8_BAR __builtin_amdgcn_s_barrier()
#define PG8_SCHED __builtin_amdgcn_sched_barrier(0)
    Unit cur, nxt; int ui = 0;
    if (!S.next(0, cur)) return;
    LAS float* const rs_lds = (LAS float*)(lds + STAGE_BYTES + 1024); LAS float* const bias_lds = (LAS float*)(lds + STAGE_BYTES + 1024 + 2048);
    int rsbuf = 0, rspm = -1; bool rs_loaded = false;
#define PG8_RS_PREP(u) do { rs_loaded = false; if (Epi::ROWSCALE && (u).pm != rspm) { rs_loaded = true; rspm = (u).pm; rsbuf ^= 1; if (tid < 256) rs_lds[rsbuf * 256 + tid] = __builtin_amdgcn_rsqf(E.ssq[rspm * BM + tid] * (1.0f / 1024.0f) + 1e-6f); } } while (0)
    if constexpr (Epi::NBIAS > 0) { for (int i = tid; i < Epi::NBIAS; i += 512) bias_lds[i] = E.bias_src(i); }
    PG8_RS_PREP(cur);
    Acc acc;
#pragma unroll
    for (int a = 0; a < 2; ++a)
#pragma unroll
        for (int b = 0; b < 2; ++b)
#pragma unroll
            for (int m = 0; m < 4; ++m)
#pragma unroll
                for (int n = 0; n < 2; ++n) acc[a][b][m][n] = (f32x4){0.f, 0.f, 0.f, 0.f};
    bf16x8 At[4][2], B0[2][2], B1[2][2];
    const char* cA = uni((const char*)g.A + (size_t)cur.pm * tstepA + (size_t)cur.pn * pnA); const char* cB = uni((const char*)g.Bt + (size_t)cur.pn * tstepB);
    PG8_STAGE(PG8_SB(0, 0), cB, voffB); PG8_STAGE(PG8_SB(0, 1), cB + hstepB, voffB); PG8_STAGE(PG8_SA(0, 0), cA, voffA); PG8_STAGE(PG8_SA(0, 1), cA + hstepA, voffA);
    if (wr == 1) PG8_BAR;
    PG8_WAIT_V(2); PG8_BAR;
    PG8_STAGE(PG8_SB(1, 0), cB + kstep, voffB); PG8_STAGE(PG8_SA(1, 0), cA + kstep, voffA); PG8_STAGE(PG8_SB(1, 1), cB + hstepB + kstep, voffB);
    PG8_WAIT_V(6); PG8_BAR;
    for (;;) {
        const bool has_next = S.next(ui + 1, nxt);
        const char* nA = uni(has_next ? (const char*)g.A + (size_t)nxt.pm * tstepA + (size_t)nxt.pn * pnA : cA); const char* nB = uni(has_next ? (const char*)g.Bt + (size_t)nxt.pn * tstepB : cB);
#pragma unroll 1
        for (int t = 0; t < nt; t += 2) {
            const bool last = (t == nt - 2);
            const char* a1 = cA + (size_t)(t + 1) * kstep;
            const char* a2 = last ? nA : cA + (size_t)(t + 2) * kstep; const char* b2 = last ? nB : cB + (size_t)(t + 2) * kstep;
            const char* a3 = a2 + kstep; const char* b3 = b2 + kstep;
            const bool relax = (Epi::NSTORES > 0) && (t == 0) && (ui > 0) && !rs_loaded;
            PG8_LDB(B0, 0, 0); PG8_LDB(B1, 0, 1); PG8_SCHED; PG8_LDA(At, 0, 0); PG8_STAGE(PG8_SA(1, 1), a1 + hstepA, voffA);
            if (relax) { if constexpr (Epi::NSTORES == 8) PG8_WAIT_V(16); else PG8_WAIT_V(24); } else PG8_WAIT_V(8);
            PG8_WAIT_L(0); PG8_BAR; PG8_MMA(0, 0, At, B0); PG8_MMA(0, 1, At, B1); PG8_BAR; PG8_SCHED;
            PG8_LDA(At, 0, 1); PG8_STAGE(PG8_SB(0, 0), b2, voffB); PG8_STAGE(PG8_SB(0, 1), b2 + hstepB, voffB); PG8_STAGE(PG8_SA(0, 0), a2, voffA);
            if (relax) { if constexpr (Epi::NSTORES == 8) PG8_WAIT_V(16); else PG8_WAIT_V(24); } else PG8_WAIT_V(8);
            PG8_WAIT_L(0); PG8_BAR; PG8_MMA(1, 0, At, B0); PG8_MMA(1, 1, At, B1); PG8_BAR; PG8_SCHED;
            PG8_LDB(B0, 1, 0); PG8_LDB(B1, 1, 1); PG8_SCHED; PG8_LDA(At, 1, 0); PG8_STAGE(PG8_SA(0, 1), a2 + hstepA, voffA);
            PG8_WAIT_V(8); PG8_WAIT_L(0); PG8_BAR; PG8_MMA(0, 0, At, B0); PG8_MMA(0, 1, At, B1); PG8_BAR; PG8_SCHED;
            PG8_LDA(At, 1, 1); PG8_STAGE(PG8_SB(1, 0), b3, voffB); PG8_STAGE(PG8_SB(1, 1), b3 + hstepB, voffB); PG8_STAGE(PG8_SA(1, 0), a3, voffA);
            PG8_WAIT_V(8); PG8_WAIT_L(0); PG8_BAR; PG8_MMA(1, 0, At, B0); PG8_MMA(1, 1, At, B1); PG8_BAR; PG8_SCHED;
        }
        if (wr == 0) PG8_BAR;
        E(acc, cur, wr, wc, fr, fq, rs_lds + rsbuf * 256, bias_lds);
        if (!has_next) break;
#pragma unroll
        for (int a = 0; a < 2; ++a)
#pragma unroll
            for (int b = 0; b < 2; ++b)
#pragma unroll
                for (int m = 0; m < 4; ++m)
#pragma unroll
                    for (int n = 0; n < 2; ++n) acc[a][b][m][n] = (f32x4){0.f, 0.f, 0.f, 0.f};
        cur = nxt; cA = nA; cB = nB; ++ui;
        PG8_RS_PREP(cur);
        if (wr == 1) PG8_BAR;
    }
    PG8_WAIT_V(0);
    PG8_BAR;
#undef PG8_RS_PREP
#undef PG8_SA
#undef PG8_SB
#undef PG8_STAGE
#undef PG8_LDA
#undef PG8_LDB
#undef PG8_MMA
#undef PG8_WAIT_V
#undef PG8_WAIT_L
#undef PG8_BAR
#undef PG8_SCHED
}

__device__ __forceinline__ u32x4 pack8(const f32x4 v0, const f32x4 v1) { u32x4 w; w.x = cvt_pk_bf16(v0[0], v0[1]); w.y = cvt_pk_bf16(v0[2], v0[3]); w.z = cvt_pk_bf16(v1[0], v1[1]); w.w = cvt_pk_bf16(v1[2], v1[3]); return w; }

__device__ __forceinline__ float row_scale(const float* ssq, int row) { return __builtin_amdgcn_rsqf(ssq[row] * (1.0f / D) + EPS); }
struct EpiSwiglu {
    static constexpr bool ROWSCALE = true; static constexpr int NBIAS = 0, NSTORES = 8;
    bf16_t* O; const float* ssq;
    __device__ __forceinline__ void operator()(const Acc& acc, const Unit& u, int wr, int wc, int fr, int fq, const LAS float* rsl, const LAS float* bl) const {
        const int row0 = u.pm * BM + wr * 64 + fr, col0 = u.pn * HALF + wc * 32 + 8 * fq;
        float rs[2][4];
#pragma unroll
        for (int ai = 0; ai < 2; ++ai)
#pragma unroll
            for (int m = 0; m < 4; ++m) rs[ai][m] = rsl[ai * HALF + wr * 64 + m * 16 + fr];
#pragma unroll
        for (int ai = 0; ai < 2; ++ai)
#pragma unroll
            for (int m = 0; m < 4; ++m) {
                f32x4 v[2];
#pragma unroll
                for (int n = 0; n < 2; ++n) { const f32x4 gt = acc[ai][0][m][n] * rs[ai][m], up = acc[ai][1][m][n] * rs[ai][m];
#pragma unroll
                    for (int j = 0; j < 4; ++j) v[n][j] = gt[j] * sigmoid_f(gt[j]) * up[j]; }
                *(u32x4*)(O + (size_t)(row0 + ai * HALF + m * 16) * FF + col0) = pack8(v[0], v[1]);
            }
    }
};
struct EpiH {
    static constexpr bool ROWSCALE = false; static constexpr int NBIAS = 0, NSTORES = 16;
    bf16_t* C; const float* ssq;
    __device__ __forceinline__ void operator()(const Acc& acc, const Unit& u, int wr, int wc, int fr, int fq, const LAS float* rsl, const LAS float* bl) const {
        const int row0 = u.pm * BM + wr * 64 + fr, col0 = u.pn * BM + wc * 32 + 8 * fq;
#pragma unroll
        for (int ai = 0; ai < 2; ++ai)
#pragma unroll
            for (int m = 0; m < 4; ++m) { bf16_t* rowp = C + (size_t)(row0 + ai * HALF + m * 16) * D + col0;
#pragma unroll
                for (int bj = 0; bj < 2; ++bj) *(u32x4*)(rowp + bj * HALF) = pack8(acc[ai][bj][m][0], acc[ai][bj][m][1]); }
    }
};
struct EpiWin {
    static constexpr bool ROWSCALE = true; static constexpr int NBIAS = 2048, NSTORES = 8;
    bf16_t *ZB, *ZCV, *ZP, *ZG; const float* bgate; const float* ssq;
    __device__ __forceinline__ float bias_src(int i) const { return bgate[i]; }
    __device__ __forceinline__ void operator()(const Acc& acc, const Unit& u, int wr, int wc, int fr, int fq, const LAS float* rsl, const LAS float* bl) const {
        const int row0 = u.pm * BM + wr * 64 + fr, pn = u.pn, cw = wc * 32 + 8 * fq;
        float rs[2][4];
#pragma unroll
        for (int ai = 0; ai < 2; ++ai)
#pragma unroll
            for (int m = 0; m < 4; ++m) rs[ai][m] = rsl[ai * HALF + wr * 64 + m * 16 + fr];
        if (pn >= 4 && pn < 12) {
            const int col0 = (pn - 4) * HALF + cw;
#pragma unroll
            for (int ai = 0; ai < 2; ++ai)
#pragma unroll
                for (int m = 0; m < 4; ++m) { const float r2 = rs[ai][m] * rs[ai][m];
                    *(u32x4*)(ZCV + (size_t)(row0 + ai * HALF + m * 16) * D + col0) = pack8(acc[ai][0][m][0] * acc[ai][1][m][0] * r2, acc[ai][0][m][1] * acc[ai][1][m][1] * r2); }
        } else if (pn < 16) {
            bf16_t* base = pn < 4 ? ZB : ZP; const int col0 = (pn < 4 ? pn : pn - 12) * BM + cw;
#pragma unroll
            for (int ai = 0; ai < 2; ++ai)
#pragma unroll
                for (int m = 0; m < 4; ++m) { bf16_t* rowp = base + (size_t)(row0 + ai * HALF + m * 16) * D + col0;
#pragma unroll
                    for (int bj = 0; bj < 2; ++bj) *(u32x4*)(rowp + bj * HALF) = pack8(acc[ai][bj][m][0] * rs[ai][m], acc[ai][bj][m][1] * rs[ai][m]); }
        } else {
            const int col0 = (pn - 16) * BM + cw;
            f32x4 bv[2][2];
#pragma unroll
            for (int bj = 0; bj < 2; ++bj)
#pragma unroll
                for (int n = 0; n < 2; ++n) bv[bj][n] = *(const LAS f32x4*)(bl + col0 + bj * HALF + 4 * n);
#pragma unroll
            for (int ai = 0; ai < 2; ++ai)
#pragma unroll
                for (int m = 0; m < 4; ++m) { bf16_t* rowp = ZG + (size_t)(row0 + ai * HALF + m * 16) * 2048 + col0;
#pragma unroll
                    for (int bj = 0; bj < 2; ++bj) { f32x4 v[2];
#pragma unroll
                        for (int n = 0; n < 2; ++n) { const f32x4 a = acc[ai][bj][m][n] * rs[ai][m] + bv[bj][n];
#pragma unroll
                            for (int j = 0; j < 4; ++j) v[n][j] = sigmoid_f(a[j]); }
                        *(u32x4*)(rowp + bj * HALF) = pack8(v[0], v[1]); } }
        }
    }
};
struct EpiPoolGroup {
    static constexpr bool ROWSCALE = false; static constexpr int NBIAS = 2048, NSTORES = 16;
    bf16_t* O; const float* bias; const float* scale; const float* ssq;
    __device__ __forceinline__ float bias_src(int i) const { return i < 1024 ? bias[i] : scale[i - 1024]; }
    __device__ __forceinline__ void operator()(const Acc& acc, const Unit& u, int wr, int wc, int fr, int fq, const LAS float* rsl, const LAS float* bl) const {
        const int row0 = u.pm * BM + wr * 64 + fr, col0 = u.pn * BM + wc * 32 + 8 * fq;
        f32x4 bv[2][2], sv[2][2];
#pragma unroll
        for (int bj = 0; bj < 2; ++bj)
#pragma unroll
            for (int n = 0; n < 2; ++n) { bv[bj][n] = *(const LAS f32x4*)(bl + col0 + bj * HALF + 4 * n); sv[bj][n] = *(const LAS f32x4*)(bl + 1024 + col0 + bj * HALF + 4 * n); }
#pragma unroll
        for (int ai = 0; ai < 2; ++ai)
#pragma unroll
            for (int m = 0; m < 4; ++m) { bf16_t* rowp = O + (size_t)(row0 + ai * HALF + m * 16) * D + col0;
#pragma unroll
                for (int bj = 0; bj < 2; ++bj) *(u32x4*)(rowp + bj * HALF) = pack8((acc[ai][bj][m][0] + bv[bj][0]) * sv[bj][0], (acc[ai][bj][m][1] + bv[bj][1]) * sv[bj][1]); }
    }
};
__device__ __forceinline__ void unpack8v(const u32x4 q, f32x4& a, f32x4& b) { a = (f32x4){bf_lo(q.x), bf_hi(q.x), bf_lo(q.y), bf_hi(q.y)}; b = (f32x4){bf_lo(q.z), bf_hi(q.z), bf_lo(q.w), bf_hi(q.w)}; }
struct EpiGateA {
    static constexpr bool ROWSCALE = false; static constexpr int NBIAS = 0, NSTORES = 16;
    const bf16_t* ZG; bf16_t* M1; const float* ssq;
    __device__ __forceinline__ void operator()(const Acc& acc, const Unit& u, int wr, int wc, int fr, int fq, const LAS float* rsl, const LAS float* bl) const {
        const int row0 = u.pm * BM + wr * 64 + fr, col0 = u.pn * BM + wc * 32 + 8 * fq;
#pragma unroll
        for (int ai = 0; ai < 2; ++ai) {
            u32x4 gq[4][2];
#pragma unroll
            for (int m = 0; m < 4; ++m)
#pragma unroll
                for (int bj = 0; bj < 2; ++bj) gq[m][bj] = *(const u32x4*)(ZG + (size_t)(row0 + ai * HALF + m * 16) * 2048 + col0 + bj * HALF);
#pragma unroll
            for (int m = 0; m < 4; ++m)
#pragma unroll
                for (int bj = 0; bj < 2; ++bj) { f32x4 g0, g1; unpack8v(gq[m][bj], g0, g1);
                    *(u32x4*)(M1 + (size_t)(row0 + ai * HALF + m * 16) * D + col0 + bj * HALF) = pack8(g0 * acc[ai][bj][m][0], g1 * acc[ai][bj][m][1]); }
        }
    }
};
struct EpiGateP {
    static constexpr bool ROWSCALE = false; static constexpr int NBIAS = 0, NSTORES = 16;
    const bf16_t* ZG; const bf16_t* M1; bf16_t* MM; const float* ssq;
    __device__ __forceinline__ void operator()(const Acc& acc, const Unit& u, int wr, int wc, int fr, int fq, const LAS float* rsl, const LAS float* bl) const {
        const int row0 = u.pm * BM + wr * 64 + fr, col0 = u.pn * BM + wc * 32 + 8 * fq;
#pragma unroll
        for (int ai = 0; ai < 2; ++ai) {
            u32x4 gq[4][2], mq[4][2];
#pragma unroll
            for (int m = 0; m < 4; ++m)
#pragma unroll
                for (int bj = 0; bj < 2; ++bj) { const size_t r = (size_t)(row0 + ai * HALF + m * 16);
                    gq[m][bj] = *(const u32x4*)(ZG + r * 2048 + D + col0 + bj * HALF); mq[m][bj] = *(const u32x4*)(M1 + r * D + col0 + bj * HALF); }
#pragma unroll
            for (int m = 0; m < 4; ++m)
#pragma unroll
                for (int bj = 0; bj < 2; ++bj) { f32x4 g0, g1, m0, m1; unpack8v(gq[m][bj], g0, g1); unpack8v(mq[m][bj], m0, m1);
                    *(u32x4*)(MM + (size_t)(row0 + ai * HALF + m * 16) * D + col0 + bj * HALF) = pack8(m0 + g0 * acc[ai][bj][m][0], m1 + g1 * acc[ai][bj][m][1]); }
        }
    }
};
}


#define XB_TMO      128
#define XB_XCNT(j)  (256  + 64 * (j))
#define XB_XSUB(j)  (1280 + 64 * (j))
#define XB_XGEN(j)  (2304 + 64 * (j))
#define XB_TOP      3328
#define XB_TOPGEN   3392
#define XCD_BAR_WORDS 3456
#define XB_SPIN_CAP (1u << 18)

__device__ __forceinline__ unsigned xb_ld(unsigned* p)              { return __hip_atomic_load(p, __ATOMIC_RELAXED, __HIP_MEMORY_SCOPE_AGENT); }
__device__ __forceinline__ unsigned xb_add(unsigned* p, unsigned v) { return __hip_atomic_fetch_add(p, v, __ATOMIC_RELAXED, __HIP_MEMORY_SCOPE_AGENT); }
__device__ __forceinline__ unsigned xb_xcc_id() { return (unsigned)__builtin_amdgcn_s_getreg((3 << 11) | 20) & 0xFu; }
#define XB_SPIN(cond, bar) do { unsigned _sp = 0; while (cond) { __builtin_amdgcn_s_sleep(1); \
    if ((++_sp & 255u) == 0u) { if (xb_ld(&(bar)[XB_TMO])) break; if (_sp > XB_SPIN_CAP) { atomicAdd(&(bar)[XB_TMO], 1u); break; } } } } while (0)

struct XcdBarrier {
    unsigned* bar; unsigned x;
    volatile LAS unsigned* st;
};

__device__ __forceinline__ XcdBarrier xcd_barrier_post(unsigned* bar, volatile LAS unsigned* st) {
    XcdBarrier b; b.bar = bar; b.x = xb_xcc_id(); b.st = st;
    if (threadIdx.x == 0) (void)xb_add(&bar[XB_XCNT(b.x)], 1u);
    return b;
}
__device__ __forceinline__ void xcd_barrier_complete(unsigned* bar, unsigned x, unsigned& nloc, unsigned& nx) {
    const unsigned G = gridDim.x * gridDim.y * gridDim.z;
    unsigned sum, cnt, mine, sp = 0u;
    for (;;) {
        sum = 0u; cnt = 0u; mine = 0u;
#pragma unroll
        for (unsigned j = 0; j < 16; ++j) { const unsigned c = xb_ld(&bar[XB_XCNT(j)]); sum += c; cnt += (c > 0u) ? 1u : 0u; mine = (j == x) ? c : mine; }
        if (sum == G) break;
        __builtin_amdgcn_s_sleep(1);
        if ((++sp & 255u) == 0u) { if (xb_ld(&bar[XB_TMO])) break; if (sp > XB_SPIN_CAP) { atomicAdd(&bar[XB_TMO], 1u); break; } }
    }
    nloc = mine > 0u ? mine : 1u; nx = cnt > 0u ? cnt : 1u;
}

__device__ __forceinline__ void xcd_barrier(const XcdBarrier& b) {
    asm volatile("s_waitcnt vmcnt(0)" ::: "memory");
    __syncthreads();
    if (threadIdx.x == 0) {
        unsigned* bar = b.bar;
        __builtin_amdgcn_s_waitcnt(0);
        unsigned nloc = b.st[0], nx = b.st[1];
        if (nloc == 0u) { xcd_barrier_complete(bar, b.x, nloc, nx); b.st[0] = nloc; b.st[1] = nx; }
        const unsigned old = xb_add(&bar[XB_XSUB(b.x)], 1u);
        const unsigned gen = old / nloc;
        if (old + 1u == (gen + 1u) * nloc) {
            __builtin_amdgcn_fence(__ATOMIC_RELEASE, "agent");
            asm volatile("s_waitcnt vmcnt(0)" ::: "memory");
            const unsigned og = xb_add(&bar[XB_TOP], 1u);
            const unsigned tg = og / nx;
            if (og + 1u == (tg + 1u) * nx) xb_add(&bar[XB_TOPGEN], 1u);
            else XB_SPIN(xb_ld(&bar[XB_TOPGEN]) == tg, bar);
            __builtin_amdgcn_fence(__ATOMIC_ACQUIRE, "agent");
            xb_add(&bar[XB_XGEN(b.x)], 1u);
            asm volatile("s_waitcnt vmcnt(0)" ::: "memory");
        } else {
            XB_SPIN(xb_ld(&bar[XB_XGEN(b.x)]) == gen, bar);
            __builtin_amdgcn_fence(__ATOMIC_ACQUIRE, "agent");
            asm volatile("s_waitcnt vmcnt(0)" ::: "memory");
        }
    }
    __syncthreads();
}

struct Args { const float* in[20]; float* out; unsigned char* ws; int ph_lo, ph_hi; };
struct Ctx { LAS unsigned char* lds; int lane, wave, gw, NGW, G; };

__device__ __forceinline__ void transpose_item(const float* W, int ldsrc, int K, int src_col0, bf16_t* WT, int dst_row0, int k0, const float* kscale, LAS float* scr, int lane) {
    {
        const int kr = lane >> 3, n4 = (lane & 7) * 4; f32x4 v[8];
#pragma unroll
        for (int i = 0; i < 8; ++i) v[i] = *(const f32x4*)(W + (size_t)(k0 + 8 * i + kr) * ldsrc + src_col0 + n4);
#pragma unroll
        for (int i = 0; i < 8; ++i) { const int kk = 8 * i + kr; const float sc = kscale ? kscale[k0 + kk] : 1.0f; LAS float* d = scr + kk * 33 + n4;
            d[0] = v[i].x * sc; d[1] = v[i].y * sc; d[2] = v[i].z * sc; d[3] = v[i].w * sc; }
    }
    LDS_WAIT(); asm volatile("" ::: "memory");
    const int c = lane & 7;
#pragma unroll
    for (int j = 0; j < 4; ++j) { const int n = (lane >> 3) + 8 * j; const LAS float* sp = scr + (8 * c) * 33 + n;
        u32x4 o; o.x = cvt_pk_bf16(sp[0 * 33], sp[1 * 33]); o.y = cvt_pk_bf16(sp[2 * 33], sp[3 * 33]); o.z = cvt_pk_bf16(sp[4 * 33], sp[5 * 33]); o.w = cvt_pk_bf16(sp[6 * 33], sp[7 * 33]);
        *(u32x4*)(WT + (size_t)(dst_row0 + n) * K + k0 + 8 * c) = o; }
    LDS_WAIT(); asm volatile("" ::: "memory");
}
__device__ __forceinline__ int map_gu(int n) { return ((n >> 7) & 1) * FF + (n >> 8) * 128 + (n & 127); }
__device__ __forceinline__ int map_in(int n) { if (n < 1024 || n >= 3072) return n; const int q = (n - 1024) >> 8, h = (n >> 7) & 1; return (h ? 2048 : 1024) + q * 128 + (n & 127); }

__device__ __forceinline__ void prep_weights(const Ctx& F, const Args& a, unsigned char* ws, int l) {
    LAS float* scr = (LAS float*)(F.lds + F.wave * 16384);
    constexpr int I_GU = (D / 64) * (NGU / 32), I_D = (FF / 64) * (D / 32), I_IN = (D / 64) * (NIN / 32), I_SQ = (D / 64) * (D / 32), I_PG = 4 * (256 / 64) * (256 / 32);
    constexpr int NITEMS = 2 * I_GU + 2 * I_D + I_IN + 3 * I_SQ + I_PG;
    for (int it = F.gw; it < NITEMS; it += F.NGW) {
        int r = it;
        if (r < 2 * I_GU) { const int w = r / I_GU; r -= w * I_GU; const int kb = r / (NGU / 32), nb = r % (NGU / 32);
            transpose_item(a.in[w ? 18 : 3] + (size_t)l * D * NGU, NGU, D, map_gu(32 * nb), (bf16_t*)(ws + (w ? W_GU2 : W_GU1)), 32 * nb, 64 * kb, a.in[w ? 16 : 1] + l * D, scr, F.lane); continue; }
        r -= 2 * I_GU;
        if (r < 2 * I_D) { const int w = r / I_D; r -= w * I_D; const int kb = r / (D / 32), nb = r % (D / 32);
            transpose_item(a.in[w ? 19 : 4] + (size_t)l * FF * D, D, FF, 32 * nb, (bf16_t*)(ws + (w ? W_D2 : W_D1)), 32 * nb, 64 * kb, nullptr, scr, F.lane); continue; }
        r -= 2 * I_D;
        if (r < I_IN) { const int kb = r / (NIN / 32), nb = r % (NIN / 32);
            transpose_item(a.in[7] + (size_t)l * D * NIN, NIN, D, map_in(32 * nb), (bf16_t*)(ws + W_IN), 32 * nb, 64 * kb, a.in[5] + l * D, scr, F.lane); continue; }
        r -= I_IN;
        if (r < 3 * I_SQ) { const int w = r / I_SQ; r -= w * I_SQ; const int kb = r / (D / 32), nb = r % (D / 32);
            transpose_item(a.in[w == 0 ? 10 : (w == 1 ? 14 : 15)] + (size_t)l * D * D, D, D, 32 * nb, (bf16_t*)(ws + (w == 0 ? W_CO : (w == 1 ? W_PO : W_WO))), 32 * nb, 64 * kb, nullptr, scr, F.lane); continue; }
        r -= 3 * I_SQ;
        { const int gi = r / 32; r -= gi * 32; const int kb = r / 8, nb = r % 8;
            transpose_item(a.in[11] + (size_t)l * 4 * 65536 + (size_t)gi * 65536, 256, 256, 32 * nb, (bf16_t*)(ws + W_PG), gi * 256 + 32 * nb, 64 * kb, nullptr, scr, F.lane); }
    }
}

__device__ __forceinline__ void cast_rows(const Ctx& F, const float* x, bf16_t* Xb, float* ssq) {
    for (int m = F.gw; m < M; m += F.NGW) {
        const f32x4* xr = (const f32x4*)(x + (size_t)m * D) + F.lane;
        f32x4 v[4]; float s = 0.f;
#pragma unroll
        for (int j = 0; j < 4; ++j) { v[j] = xr[64 * j]; s += (v[j].x * v[j].x + v[j].y * v[j].y) + (v[j].z * v[j].z + v[j].w * v[j].w); }
        s = wave_sum(s, F.lane);
        u32x2* o = (u32x2*)(Xb + (size_t)m * D) + F.lane;
#pragma unroll
        for (int j = 0; j < 4; ++j) { u32x2 w; w.x = cvt_pk_bf16(v[j].x, v[j].y); w.y = cvt_pk_bf16(v[j].z, v[j].w); o[64 * j] = w; }
        if (F.lane == 0) ssq[m] = s;
    }
}
__device__ __forceinline__ void resid_rows(const Ctx& F, bf16_t* Xb, const bf16_t* h, const float* post, float cs, float* ssq, float* outf) {
    f32x4 pv[4];
#pragma unroll
    for (int j = 0; j < 4; ++j) pv[j] = ((const f32x4*)post)[F.lane + 64 * j] * cs;
    for (int m0 = F.gw; m0 < M; m0 += 2 * F.NGW) {
        const int m1 = m0 + F.NGW; const bool two = m1 < M; const int mb = two ? m1 : m0;
        f32x4 hv[2][4], xv[2][4];
#pragma unroll
        for (int r = 0; r < 2; ++r) { const int m = r ? mb : m0;
            const u32x2* hr = (const u32x2*)(h + (size_t)m * D) + F.lane; const u32x2* xr = (const u32x2*)(Xb + (size_t)m * D) + F.lane;
#pragma unroll
            for (int j = 0; j < 4; ++j) { const u32x2 q = hr[64 * j]; hv[r][j] = (f32x4){bf_lo(q.x), bf_hi(q.x), bf_lo(q.y), bf_hi(q.y)};
                const u32x2 p = xr[64 * j]; xv[r][j] = (f32x4){bf_lo(p.x), bf_hi(p.x), bf_lo(p.y), bf_hi(p.y)}; } }
#pragma unroll
        for (int r = 0; r < 2; ++r) { const int m = r ? mb : m0; if (r && !two) break;
            float s = 0.f;
#pragma unroll
            for (int j = 0; j < 4; ++j) s += (hv[r][j].x * hv[r][j].x + hv[r][j].y * hv[r][j].y) + (hv[r][j].z * hv[r][j].z + hv[r][j].w * hv[r][j].w);
            const float r1 = 1.0f / sqrtf(wave_sum(s, F.lane) * (1.f / D) + EPS);
            if (outf) {
                f32x4* xo = (f32x4*)(outf + (size_t)m * D) + F.lane;
#pragma unroll
                for (int j = 0; j < 4; ++j) xo[64 * j] = xv[r][j] + hv[r][j] * r1 * pv[j];
            } else {
                float s2 = 0.f;
                u32x2* o = (u32x2*)(Xb + (size_t)m * D) + F.lane;
#pragma unroll
                for (int j = 0; j < 4; ++j) { const f32x4 xn = xv[r][j] + hv[r][j] * r1 * pv[j]; u32x2 w; w.x = cvt_pk_bf16(xn.x, xn.y); w.y = cvt_pk_bf16(xn.z, xn.w); o[64 * j] = w;
                    const f32x4 xr_ = {bf_lo(w.x), bf_hi(w.x), bf_lo(w.y), bf_hi(w.y)};
                    s2 += (xr_.x * xr_.x + xr_.y * xr_.y) + (xr_.z * xr_.z + xr_.w * xr_.w); }
                s2 = wave_sum(s2, F.lane);
                if (F.lane == 0) ssq[m] = s2;
            }
        }
    }
}
__device__ __forceinline__ void unpack8(const u32x4 q, float (&f)[8]) { f[0] = bf_lo(q.x); f[1] = bf_hi(q.x); f[2] = bf_lo(q.y); f[3] = bf_hi(q.y); f[4] = bf_lo(q.z); f[5] = bf_hi(q.z); f[6] = bf_lo(q.w); f[7] = bf_hi(q.w); }
__device__ __forceinline__ void mix_rows(const Ctx& F, bf16_t* ZBCA, const bf16_t* ZCV, const bf16_t* ZP, const float* convw, bf16_t* DDo) {
    const int half = F.gw & 1, c0 = half * 512 + F.lane * 8;
    const int npair = F.NGW >> 1, tpw = (M + npair - 1) / npair, t0 = (F.gw >> 1) * tpw;
    float w0[8], w1[8], w2[8];
#pragma unroll
    for (int j = 0; j < 8; ++j) { w0[j] = convw[c0 + j]; w1[j] = convw[D + c0 + j]; w2[j] = convw[2 * D + c0 + j]; }
    const int win = 2 << (c0 >> 8), wmax = half ? 16 : 4;
    for (int t = t0; t < t0 + tpw && t < M; ++t) {
        const int s = t & (SEQ - 1);
        const size_t off = (size_t)t * D + c0;
        const u32x4 zero = {0u, 0u, 0u, 0u};
        const u32x4 qb = *(const u32x4*)(ZBCA + off), q2 = *(const u32x4*)(ZCV + off);
        const u32x4 q1 = s >= 1 ? *(const u32x4*)(ZCV + off - D) : zero, q0 = s >= 2 ? *(const u32x4*)(ZCV + off - 2 * D) : zero;
        const u32x4 qp = *(const u32x4*)(ZP + off);
        float fb[8], f0[8], f1[8], f2[8], fp[8], acc[8];
        unpack8(qb, fb); unpack8(q0, f0); unpack8(q1, f1); unpack8(q2, f2); unpack8(qp, fp);
#pragma unroll
        for (int j = 0; j < 8; ++j) acc[j] = fp[j];
        for (int k = 1; k < wmax; ++k) {
            const bool ok = (k < win) && (s >= k);
            const u32x4 q = ok ? *(const u32x4*)(ZP + off - (size_t)k * D) : zero;
            float f[8]; unpack8(q, f);
#pragma unroll
            for (int j = 0; j < 8; ++j) acc[j] += f[j];
        }
        const float inv = 1.0f / (float)((s + 1) < win ? (s + 1) : win);
        float ca[8], dd[8];
#pragma unroll
        for (int j = 0; j < 8; ++j) { ca[j] = fb[j] * (w0[j] * f0[j] + w1[j] * f1[j] + w2[j] * f2[j]); dd[j] = acc[j] * inv - fp[j]; }
        u32x4 o1, o2;
        o1.x = cvt_pk_bf16(ca[0], ca[1]); o1.y = cvt_pk_bf16(ca[2], ca[3]); o1.z = cvt_pk_bf16(ca[4], ca[5]); o1.w = cvt_pk_bf16(ca[6], ca[7]);
        o2.x = cvt_pk_bf16(dd[0], dd[1]); o2.y = cvt_pk_bf16(dd[2], dd[3]); o2.z = cvt_pk_bf16(dd[4], dd[5]); o2.w = cvt_pk_bf16(dd[6], dd[7]);
        *(u32x4*)(ZBCA + off) = o1; *(u32x4*)(DDo + off) = o2;
    }
}

__device__ __forceinline__ bool launder(Ctx& F, unsigned char*& ws, int& tidv) { int t; asm volatile("v_mbcnt_lo_u32_b32 %0, -1, 0\n\tv_mbcnt_hi_u32_b32 %0, -1, %0" : "=v"(t)); F.lane = t; tidv = F.wave * 64 + t;
    const unsigned long long w0 = (unsigned long long)ws; unsigned wl = __builtin_amdgcn_readfirstlane((unsigned)w0), wh = __builtin_amdgcn_readfirstlane((unsigned)(w0 >> 32)); asm volatile("" : "+s"(wl), "+s"(wh));
    const unsigned long long w = ((unsigned long long)wh << 32) | wl; ws = (unsigned char*)(__attribute__((address_space(1))) unsigned char*)w; return true; }
constexpr int PH_PER_LAYER = 12, N_PHASES = 1 + DEPTH * PH_PER_LAYER;

__global__ void __launch_bounds__(512, 2) mega_fwd(Args a) {
    extern __shared__ __attribute__((aligned(16))) unsigned char lds_raw[];
    Ctx F; F.lds = (LAS unsigned char*)lds_raw; F.lane = threadIdx.x & 63; F.wave = __builtin_amdgcn_readfirstlane(threadIdx.x >> 6);
    F.G = gridDim.x; F.gw = blockIdx.x * 8 + F.wave; F.NGW = F.G * 8;
    unsigned char* ws = a.ws; int tidv = threadIdx.x;
    const int lo = a.ph_lo, hi = a.ph_hi;
    volatile LAS unsigned* MISC = (volatile LAS unsigned*)(F.lds + MISC_OFF);
    if (threadIdx.x < 32) MISC[threadIdx.x] = 0u;
    __syncthreads();
    XcdBarrier bar; bar.bar = (unsigned*)(ws + WS_BAR); bar.x = 0; bar.st = nullptr;
    if (hi - lo > 1) bar = xcd_barrier_post((unsigned*)(ws + WS_BAR), MISC + 8);
    if (lo < 0) cg::this_grid().sync();
    int ph = 0;
#define IN_PH (lo <= ph && ph < hi && launder(F, ws, tidv))
#define SEAM() do { if (lo <= ph && ph + 1 < hi) { xcd_barrier(bar); } ++ph; } while (0)
#define XB ((bf16_t*)(ws + WS_XB))
#define SSQ ((float*)(ws + WS_SSQ))
    if (IN_PH) { prep_weights(F, a, ws, 0); cast_rows(F, a.in[0], XB, SSQ); }
    SEAM();
    for (int l = 0; l < DEPTH; ++l) {
        if (IN_PH) { pg8::Gemm g{XB, (const bf16_t*)(ws + W_GU1), M, NGU, D, D, 0}; pg8::StaticOrder S; S.init(M, NGU, F.G, blockIdx.x);
            pg8::EpiSwiglu E{(bf16_t*)(ws + WS_HH), SSQ}; pg8::gemm_phase(F.lds, g, S, E, tidv); }
        SEAM();
        if (IN_PH) { pg8::Gemm g{(const bf16_t*)(ws + WS_HH), (const bf16_t*)(ws + W_D1), M, D, FF, FF, 0}; pg8::StaticOrder S; S.init(M, D, F.G, blockIdx.x);
            pg8::EpiH E{(bf16_t*)(ws + WS_HFFN), nullptr}; pg8::gemm_phase(F.lds, g, S, E, tidv); }
        SEAM();
        if (IN_PH) resid_rows(F, XB, (const bf16_t*)(ws + WS_HFFN), a.in[2] + l * D, 0.5f, SSQ, nullptr);
        SEAM();
        if (IN_PH) { pg8::Gemm g{XB, (const bf16_t*)(ws + W_IN), M, NIN, D, D, 0}; pg8::StaticOrder S; S.init(M, NIN, F.G, blockIdx.x);
            pg8::EpiWin E{(bf16_t*)(ws + WS_ZB), (bf16_t*)(ws + WS_ZCV), (bf16_t*)(ws + WS_ZP), (bf16_t*)(ws + WS_ZG), a.in[8] + l * 2 * D, SSQ}; pg8::gemm_phase(F.lds, g, S, E, tidv); }
        SEAM();
        if (IN_PH) mix_rows(F, (bf16_t*)(ws + WS_ZB), (const bf16_t*)(ws + WS_ZCV), (const bf16_t*)(ws + WS_ZP), a.in[9] + l * 3 * D, (bf16_t*)(ws + WS_DD));
        SEAM();
        if (IN_PH) { pg8::Gemm g{(const bf16_t*)(ws + WS_DD), (const bf16_t*)(ws + W_PG), M, D, 256, D, 256}; pg8::StaticOrder S; S.init(M, D, F.G, blockIdx.x);
            pg8::EpiPoolGroup E{(bf16_t*)(ws + WS_YP0), a.in[12] + l * D, a.in[13] + l * D, nullptr}; pg8::gemm_phase(F.lds, g, S, E, tidv); }
        if (IN_PH) { pg8::Gemm g{(const bf16_t*)(ws + WS_CA), (const bf16_t*)(ws + W_CO), M, D, D, D, 0}; pg8::StaticOrder S; S.init(M, D, F.G, blockIdx.x);
            pg8::EpiGateA E{(const bf16_t*)(ws + WS_ZG), (bf16_t*)(ws + WS_M1), nullptr}; pg8::gemm_phase(F.lds, g, S, E, tidv); }
        SEAM();
        if (IN_PH) { pg8::Gemm g{(const bf16_t*)(ws + WS_YP0), (const bf16_t*)(ws + W_PO), M, D, D, D, 0}; pg8::StaticOrder S; S.init(M, D, F.G, blockIdx.x);
            pg8::EpiGateP E{(const bf16_t*)(ws + WS_ZG), (const bf16_t*)(ws + WS_M1), (bf16_t*)(ws + WS_MM), nullptr}; pg8::gemm_phase(F.lds, g, S, E, tidv); }
        SEAM();
        if (IN_PH) { pg8::Gemm g{(const bf16_t*)(ws + WS_MM), (const bf16_t*)(ws + W_WO), M, D, D, D, 0}; pg8::StaticOrder S; S.init(M, D, F.G, blockIdx.x);
            pg8::EpiH E{(bf16_t*)(ws + WS_HMIX), nullptr}; pg8::gemm_phase(F.lds, g, S, E, tidv); }
        SEAM();
        if (IN_PH) resid_rows(F, XB, (const bf16_t*)(ws + WS_HMIX), a.in[6] + l * D, 1.0f, SSQ, nullptr);
        SEAM();
        if (IN_PH) { pg8::Gemm g{XB, (const bf16_t*)(ws + W_GU2), M, NGU, D, D, 0}; pg8::StaticOrder S; S.init(M, NGU, F.G, blockIdx.x);
            pg8::EpiSwiglu E{(bf16_t*)(ws + WS_HH), SSQ}; pg8::gemm_phase(F.lds, g, S, E, tidv); }
        SEAM();
        if (IN_PH) { pg8::Gemm g{(const bf16_t*)(ws + WS_HH), (const bf16_t*)(ws + W_D2), M, D, FF, FF, 0}; pg8::StaticOrder S; S.init(M, D, F.G, blockIdx.x);
            pg8::EpiH E{(bf16_t*)(ws + WS_HFFN), nullptr}; pg8::gemm_phase(F.lds, g, S, E, tidv); }
        SEAM();
        if (IN_PH) { const bool more = (l + 1 < DEPTH);
            resid_rows(F, XB, (const bf16_t*)(ws + WS_HFFN), a.in[17] + l * D, 0.5f, SSQ, more ? nullptr : a.out);
            if (more) prep_weights(F, a, ws, l + 1); }
        SEAM();
    }
#undef IN_PH
#undef SEAM
}

extern "C" void kernel_launch(void* const* d_in, const int* in_sizes, int n_in, void* d_out, int out_size, void* d_ws, size_t ws_size, hipStream_t stream) {
    static int grid = 0;
    if (grid == 0) {
        if (n_in != 20 || in_sizes[0] != M * D || out_size != M * D || ws_size < WS_END) { fprintf(stderr, "kernel_launch: unexpected shapes (n_in %d, in0 %d, out %d, ws %zu < %zu)\n", n_in, n_in > 0 ? in_sizes[0] : -1, out_size, ws_size, (size_t)WS_END); grid = -1; return; }
        int dev = 0, cus = 0, per_cu = 0;
        (void)hipGetDevice(&dev); (void)hipDeviceGetAttribute(&cus, hipDeviceAttributeMultiprocessorCount, dev);
        if (hipFuncSetAttribute((const void*)mega_fwd, hipFuncAttributeMaxDynamicSharedMemorySize, LDS_BYTES) != hipSuccess) { fprintf(stderr, "kernel_launch: hipFuncSetAttribute failed\n"); grid = -1; return; }
        if (hipOccupancyMaxActiveBlocksPerMultiprocessor(&per_cu, (const void*)mega_fwd, 512, LDS_BYTES) != hipSuccess || per_cu < 1) { fprintf(stderr, "kernel_launch: occupancy query says %d\n", per_cu); per_cu = 1; (void)hipGetLastError(); }
        grid = cus * per_cu;
    }
    if (grid < 0) return;
    Args a{};
    for (int i = 0; i < 20; ++i) a.in[i] = (const float*)d_in[i];
    a.out = (float*)d_out; a.ws = (unsigned char*)d_ws;
#if MK_ONE_LAUNCH
    if (hipMemsetAsync((char*)d_ws, 0, CTL_ZERO_BYTES, stream) != hipSuccess) { fprintf(stderr, "kernel_launch: memset failed\n"); return; }
    a.ph_lo = 0; a.ph_hi = N_PHASES;
    void* args[] = {&a};
    hipError_t e = hipLaunchCooperativeKernel((const void*)mega_fwd, dim3(grid), dim3(512), args, LDS_BYTES, stream);
    if (e != hipSuccess) fprintf(stderr, "cooperative launch failed: %s (grid %d)\n", hipGetErrorString(e), grid);
#else
    for (int p = 0; p < N_PHASES; ++p) { a.ph_lo = p; a.ph_hi = p + 1; hipLaunchKernelGGL(mega_fwd, dim3(grid), dim3(512), LDS_BYTES, stream, a); }
#endif
}
```

```cpp
#include <hip/hip_runtime.h>
#include <hip/hip_cooperative_groups.h>
#include <cstdio>
#include <cstdint>
namespace cg = cooperative_groups;

#ifndef MK_ONE_LAUNCH
#define MK_ONE_LAUNCH 1
#endif

#define LAS __attribute__((address_space(3)))
typedef unsigned short bf16_t;
typedef short bf16x8 __attribute__((ext_vector_type(8)));
typedef float f32x4 __attribute__((ext_vector_type(4)));
typedef unsigned u32x4 __attribute__((ext_vector_type(4)));
typedef unsigned u32x2 __attribute__((ext_vector_type(2)));

constexpr int D = 1024, SEQ = 2048, BATCH = 16, M = BATCH * SEQ, FF = 2816, NGU = 2 * FF, NIN = 6144, DEPTH = 2;
constexpr float EPS = 1e-6f;
constexpr size_t MiB = 1u << 20;
constexpr size_t WS_W = 1 * MiB;
constexpr size_t W_GU1 = WS_W, W_D1 = W_GU1 + (size_t)NGU * D * 2, W_IN = W_D1 + (size_t)D * FF * 2, W_PG = W_IN + (size_t)NIN * D * 2,
                 W_CO = W_PG + (size_t)D * 256 * 2, W_PO = W_CO + (size_t)D * D * 2, W_WO = W_PO + (size_t)D * D * 2, W_GU2 = W_WO + (size_t)D * D * 2,
                 W_D2 = W_GU2 + (size_t)NGU * D * 2, W_END = W_D2 + (size_t)D * FF * 2;
static_assert(W_END <= 56 * MiB, "weights");
constexpr size_t WS_SSQ = 512 * 1024;
constexpr size_t WS_XB = 56 * MiB;
constexpr size_t WS_R0 = 120 * MiB;
constexpr size_t WS_ZG = WS_R0;
constexpr size_t WS_ZB = WS_R0 + 128 * MiB;
constexpr size_t WS_ZCV = WS_ZB + 64 * MiB;
constexpr size_t WS_ZP = WS_ZCV + 64 * MiB;
constexpr size_t WS_DD = WS_ZP + 64 * MiB;
constexpr size_t WS_CA = WS_ZB;
constexpr size_t WS_YP0 = WS_ZCV;
constexpr size_t WS_M1 = WS_ZP;
constexpr size_t WS_MM = WS_DD;
constexpr size_t WS_HMIX = WS_R0;
constexpr size_t WS_HH = WS_R0;
constexpr size_t WS_HFFN = WS_ZCV;
constexpr size_t WS_END = WS_DD + 64 * MiB;
static_assert(WS_HH + (size_t)M * FF * 2 <= WS_HFFN, "H overlay");
constexpr int LDS_BYTES = 147456, MISC_OFF = 131072 + 320;
constexpr size_t WS_BAR = 16384, CTL_ZERO_BYTES = 65536;

typedef float f32x2 __attribute__((ext_vector_type(2)));
typedef __bf16 bf16x2 __attribute__((ext_vector_type(2)));
__device__ __forceinline__ unsigned cvt_pk_bf16(float lo, float hi) { const f32x2 v = {lo, hi}; const bf16x2 b = __builtin_convertvector(v, bf16x2); return __builtin_bit_cast(unsigned, b); }
__device__ __forceinline__ float bf_lo(unsigned u) { return __builtin_bit_cast(float, u << 16); }
__device__ __forceinline__ float bf_hi(unsigned u) { return __builtin_bit_cast(float, u & 0xffff0000u); }
__device__ __forceinline__ float sigmoid_f(float x) { return __builtin_amdgcn_rcpf(1.0f + __expf(-x)); }
__device__ __forceinline__ float wave_sum(float v, int lane) {
#pragma unroll
    for (int o = 1; o < 64; o <<= 1) v += __builtin_bit_cast(float, __builtin_amdgcn_ds_bpermute((lane ^ o) << 2, __builtin_bit_cast(int, v)));
    return v;
}
#define LDS_WAIT() asm volatile("s_waitcnt lgkmcnt(0)" ::: "memory")

namespace pg8 {
constexpr int BM = 256, BK = 64, HALF = 128, HTB = HALF * BK * 2, STAGE_BYTES = 8 * HTB, NXCD = 8, WGM = 8;
__host__ __device__ __forceinline__ int lds_byte(int r, int c) { const int st = (r >> 4) * 2 + (c >> 5), rr = r & 15, cc = c & 31, ob = rr * 64 + cc * 2; return st * 1024 + (ob ^ (((ob >> 9) & 1) << 5)); }
__host__ __device__ __forceinline__ void stage_rc(int b, int& R, int& C) { const int st = b / 1024, sb = b % 1024, swz = sb ^ (((sb >> 9) & 1) << 5); R = (st >> 1) * 16 + swz / 64; C = (st & 1) * 32 + (swz % 64) / 2; }
__host__ __device__ __forceinline__ int perm32(int rho) { const int n = rho >> 4, i = rho & 15; return 8 * (i >> 2) + 4 * n + (i & 3); }

struct Unit { int pm, pn; };
struct Gemm { const bf16_t* A; const bf16_t* Bt; int M, N, K, lda, a_pn_cols; };

struct StaticOrder {
    int nM, nN, nwg, G, c;
    __host__ __device__ void init(int M_, int N_, int G_, int c_) { nM = M_ / BM; nN = N_ / BM; nwg = nM * nN; G = G_; c = c_; }
    __host__ __device__ bool next(int i, Unit& u) const {
        const long L = (long)i * G + c; if (L >= nwg) return false;
        int wgid = (int)L; { const int q = nwg / NXCD, r = nwg % NXCD, xcd = wgid % NXCD, off = wgid / NXCD; wgid = (xcd < r ? xcd * (q + 1) : r * (q + 1) + (xcd - r) * q) + off; }
        const int nig = WGM * nN, gid = wgid / nig, fm = gid * WGM, gsz = (nM - fm) < WGM ? (nM - fm) : WGM;
        u.pm = fm + ((wgid % nig) % gsz); u.pn = (wgid % nig) / gsz; return true;
    }
};

typedef f32x4 Acc[2][2][4][2];
__device__ __forceinline__ const char* uni(const char* p) { const unsigned long long v = (unsigned long long)p; const unsigned lo = __builtin_amdgcn_readfirstlane((unsigned)v), hi = __builtin_amdgcn_readfirstlane((unsigned)(v >> 32)); return (const char*)(((unsigned long long)hi << 32) | lo); }

template <class Epi>
__device__ __forceinline__ void gemm_phase(LAS unsigned char* lds, const Gemm g, const StaticOrder& S, const Epi& E, const int tid) {
    const int wid = __builtin_amdgcn_readfirstlane(tid >> 6), lane = tid & 63, wr = wid >> 2, wc = wid & 3, fr = lane & 15, fq = lane >> 4;
    const int K = g.K, nt = K / BK;
    unsigned voffA[2], voffB[2];
#pragma unroll
    for (int i = 0; i < 2; ++i) { int R, C; stage_rc(tid * 16 + i * 8192, R, C); const int Rb = (R & ~31) + perm32(R & 31);
        voffA[i] = (unsigned)(R * g.lda + C) * 2u; voffB[i] = (unsigned)(Rb * K + C) * 2u; }
    const size_t kstep = (size_t)(BK * 2);
    const size_t hstepA = (size_t)HALF * g.lda * 2, tstepA = 2 * hstepA;
    const size_t hstepB = (size_t)HALF * K * 2, tstepB = 2 * hstepB;
    const size_t pnA = (size_t)g.a_pn_cols * 2;
    const unsigned ldsw = (unsigned)wid * 1024u;
    const int aoff = lds_byte(wr * 64 + fr, fq * 8), boff = lds_byte(wc * 32 + fr, fq * 8);
#define PG8_SA(b, h) (((b) * 2 + (h)) * HTB)
#define PG8_SB(b, h) ((4 + (b) * 2 + (h)) * HTB)
#define PG8_STAGE(bufoff, gbase, voff) do { _Pragma("unroll") for (int _i = 0; _i < 2; ++_i) \
        __builtin_amdgcn_global_load_lds((const unsigned*)((const char*)(gbase) + (voff)[_i]), (LAS unsigned*)(lds + (bufoff) + ldsw + _i * 8192), 16, 0, 0); } while (0)
#define PG8_LDA(dst, b, h) do { _Pragma("unroll") for (int m = 0; m < 4; ++m) _Pragma("unroll") for (int k = 0; k < 2; ++k) dst[m][k] = *(const LAS bf16x8*)(lds + PG8_SA(b, h) + aoff + m * 2048 + k * 1024); } while (0)
#define PG8_LDB(dst, b, h) do { _Pragma("unroll") for (int n = 0; n < 2; ++n) _Pragma("unroll") for (int k = 0; k < 2; ++k) dst[n][k] = *(const LAS bf16x8*)(lds + PG8_SB(b, h) + boff + n * 2048 + k * 1024); } while (0)
#define PG8_MMA(ai, bj, At, Bt) do { __builtin_amdgcn_s_setprio(1); _Pragma("unroll") for (int m = 0; m < 4; ++m) _Pragma("unroll") for (int n = 0; n < 2; ++n) _Pragma("unroll") for (int k = 0; k < 2; ++k) \
        acc[ai][bj][m][n] = __builtin_amdgcn_mfma_f32_16x16x32_bf16(Bt[n][k], At[m][k], acc[ai][bj][m][n], 0, 0, 0); __builtin_amdgcn_s_setprio(0); } while (0)
#define PG8_WAIT_V(n) asm volatile("s_waitcnt vmcnt(" #n ")" ::: "memory")
#define PG8_WAIT_L(n) asm volatile("s_waitcnt lgkmcnt(" #n ")" ::: "memory")
#define PG8_BAR __builtin_amdgcn_s_barrier()
#define PG8_SCHED __builtin_amdgcn_sched_barrier(0)
    Unit cur, nxt; int ui = 0;
    if (!S.next(0, cur)) return;
    LAS float* const rs_lds = (LAS float*)(lds + STAGE_BYTES + 1024); LAS float* const bias_lds = (LAS float*)(lds + STAGE_BYTES + 1024 + 2048);
    int rsbuf = 0, rspm = -1; bool rs_loaded = false;
#define PG8_RS_PREP(u) do { rs_loaded = false; if (Epi::ROWSCALE && (u).pm != rspm) { rs_loaded = true; rspm = (u).pm; rsbuf ^= 1; if (tid < 256) rs_lds[rsbuf * 256 + tid] = __builtin_amdgcn_rsqf(E.ssq[rspm * BM + tid] * (1.0f / 1024.0f) + 1e-6f); } } while (0)
    if constexpr (Epi::NBIAS > 0) { for (int i = tid; i < Epi::NBIAS; i += 512) bias_lds[i] = E.bias_src(i); }
    PG8_RS_PREP(cur);
    Acc acc;
#pragma unroll
    for (int a = 0; a < 2; ++a)
#pragma unroll
        for (int b = 0; b < 2; ++b)
#pragma unroll
            for (int m = 0; m < 4; ++m)
#pragma unroll
                for (int n = 0; n < 2; ++n) acc[a][b][m][n] = (f32x4){0.f, 0.f, 0.f, 0.f};
    bf16x8 At[4][2], B0[2][2], B1[2][2];
    const char* cA = uni((const char*)g.A + (size_t)cur.pm * tstepA + (size_t)cur.pn * pnA); const char* cB = uni((const char*)g.Bt + (size_t)cur.pn * tstepB);
    PG8_STAGE(PG8_SB(0, 0), cB, voffB); PG8_STAGE(PG8_SB(0, 1), cB + hstepB, voffB); PG8_STAGE(PG8_SA(0, 0), cA, voffA); PG8_STAGE(PG8_SA(0, 1), cA + hstepA, voffA);
    if (wr == 1) PG8_BAR;
    PG8_WAIT_V(2); PG8_BAR;
    PG8_STAGE(PG8_SB(1, 0), cB + kstep, voffB); PG8_STAGE(PG8_SA(1, 0), cA + kstep, voffA); PG8_STAGE(PG8_SB(1, 1), cB + hstepB + kstep, voffB);
    PG8_WAIT_V(6); PG8_BAR;
    for (;;) {
        const bool has_next = S.next(ui + 1, nxt);
        const char* nA = uni(has_next ? (const char*)g.A + (size_t)nxt.pm * tstepA + (size_t)nxt.pn * pnA : cA); const char* nB = uni(has_next ? (const char*)g.Bt + (size_t)nxt.pn * tstepB : cB);
#pragma unroll 1
        for (int t = 0; t < nt; t += 2) {
            const bool last = (t == nt - 2);
            const char* a1 = cA + (size_t)(t + 1) * kstep;
            const char* a2 = last ? nA : cA + (size_t)(t + 2) * kstep; const char* b2 = last ? nB : cB + (size_t)(t + 2) * kstep;
            const char* a3 = a2 + kstep; const char* b3 = b2 + kstep;
            const bool relax = (Epi::NSTORES > 0) && (t == 0) && (ui > 0) && !rs_loaded;
            PG8_LDB(B0, 0, 0); PG8_LDB(B1, 0, 1); PG8_SCHED; PG8_LDA(At, 0, 0); PG8_STAGE(PG8_SA(1, 1), a1 + hstepA, voffA);
            if (relax) { if constexpr (Epi::NSTORES == 8) PG8_WAIT_V(16); else PG8_WAIT_V(24); } else PG8_WAIT_V(8);
            PG8_WAIT_L(0); PG8_BAR; PG8_MMA(0, 0, At, B0); PG8_MMA(0, 1, At, B1); PG8_BAR; PG8_SCHED;
            PG8_LDA(At, 0, 1); PG8_STAGE(PG8_SB(0, 0), b2, voffB); PG8_STAGE(PG8_SB(0, 1), b2 + hstepB, voffB); PG8_STAGE(PG8_SA(0, 0), a2, voffA);
            if (relax) { if constexpr (Epi::NSTORES == 8) PG8_WAIT_V(16); else PG8_WAIT_V(24); } else PG8_WAIT_V(8);
            PG8_WAIT_L(0); PG8_BAR; PG8_MMA(1, 0, At, B0); PG8_MMA(1, 1, At, B1); PG8_BAR; PG8_SCHED;
            PG8_LDB(B0, 1, 0); PG8_LDB(B1, 1, 1); PG8_SCHED; PG8_LDA(At, 1, 0); PG8_STAGE(PG8_SA(0, 1), a2 + hstepA, voffA);
            PG8_WAIT_V(8); PG8_WAIT_L(0); PG8_BAR; PG8_MMA(0, 0, At, B0); PG8_MMA(0, 1, At, B1); PG8_BAR; PG8_SCHED;
            PG8_LDA(At, 1, 1); PG8_STAGE(PG8_SB(1, 0), b3, voffB); PG8_STAGE(PG8_SB(1, 1), b3 + hstepB, voffB); PG8_STAGE(PG8_SA(1, 0), a3, voffA);
            PG8_WAIT_V(8); PG8_WAIT_L(0); PG8_BAR; PG8_MMA(1, 0, At, B0); PG8_MMA(1, 1, At, B1); PG8_BAR; PG8_SCHED;
        }
        if (wr == 0) PG8_BAR;
        E(acc, cur, wr, wc, fr, fq, rs_lds + rsbuf * 256, bias_lds);
        if (!has_next) break;
#pragma unroll
        for (int a = 0; a < 2; ++a)
#pragma unroll
            for (int b = 0; b < 2; ++b)
#pragma unroll
                for (int m = 0; m < 4; ++m)
#pragma unroll
                    for (int n = 0; n < 2; ++n) acc[a][b][m][n] = (f32x4){0.f, 0.f, 0.f, 0.f};
        cur = nxt; cA = nA; cB = nB; ++ui;
        PG8_RS_PREP(cur);
        if (wr == 1) PG8_BAR;
    }
    PG8_WAIT_V(0);
    PG8_BAR;
#undef PG8_RS_PREP
#undef PG8_SA
#undef PG8_SB
#undef PG8_STAGE
#undef PG8_LDA
#undef PG8_LDB
#undef PG8_MMA
#undef PG8_WAIT_V
#undef PG8_WAIT_L
#undef PG8_BAR
#undef PG8_SCHED
}

__device__ __forceinline__ u32x4 pack8(const f32x4 v0, const f32x4 v1) { u32x4 w; w.x = cvt_pk_bf16(v0[0], v0[1]); w.y = cvt_pk_bf16(v0[2], v0[3]); w.z = cvt_pk_bf16(v1[0], v1[1]); w.w = cvt_pk_bf16(v1[2], v1[3]); return w; }

__device__ __forceinline__ float row_scale(const float* ssq, int row) { return __builtin_amdgcn_rsqf(ssq[row] * (1.0f / D) + EPS); }
struct EpiSwiglu {
    static constexpr bool ROWSCALE = true; static constexpr int NBIAS = 0, NSTORES = 8;
    bf16_t* O; const float* ssq;
    __device__ __forceinline__ void operator()(const Acc& acc, const Unit& u, int wr, int wc, int fr, int fq, const LAS float* rsl, const LAS float* bl) const {
        const int row0 = u.pm * BM + wr * 64 + fr, col0 = u.pn * HALF + wc * 32 + 8 * fq;
        float rs[2][4];
#pragma unroll
        for (int ai = 0; ai < 2; ++ai)
#pragma unroll
            for (int m = 0; m < 4; ++m) rs[ai][m] = rsl[ai * HALF + wr * 64 + m * 16 + fr];
#pragma unroll
        for (int ai = 0; ai < 2; ++ai)
#pragma unroll
            for (int m = 0; m < 4; ++m) {
                f32x4 v[2];
#pragma unroll
                for (int n = 0; n < 2; ++n) { const f32x4 gt = acc[ai][0][m][n] * rs[ai][m], up = acc[ai][1][m][n] * rs[ai][m];
#pragma unroll
                    for (int j = 0; j < 4; ++j) v[n][j] = gt[j] * sigmoid_f(gt[j]) * up[j]; }
                *(u32x4*)(O + (size_t)(row0 + ai * HALF + m * 16) * FF + col0) = pack8(v[0], v[1]);
            }
    }
};
struct EpiH {
    static constexpr bool ROWSCALE = false; static constexpr int NBIAS = 0, NSTORES = 16;
    bf16_t* C; const float* ssq;
    __device__ __forceinline__ void operator()(const Acc& acc, const Unit& u, int wr, int wc, int fr, int fq, const LAS float* rsl, const LAS float* bl) const {
        const int row0 = u.pm * BM + wr * 64 + fr, col0 = u.pn * BM + wc * 32 + 8 * fq;
#pragma unroll
        for (int ai = 0; ai < 2; ++ai)
#pragma unroll
            for (int m = 0; m < 4; ++m) { bf16_t* rowp = C + (size_t)(row0 + ai * HALF + m * 16) * D + col0;
#pragma unroll
                for (int bj = 0; bj < 2; ++bj) *(u32x4*)(rowp + bj * HALF) = pack8(acc[ai][bj][m][0], acc[ai][bj][m][1]); }
    }
};
struct EpiWin {
    static constexpr bool ROWSCALE = true; static constexpr int NBIAS = 2048, NSTORES = 8;
    bf16_t *ZB, *ZCV, *ZP, *ZG; const float* bgate; const float* ssq;
    __device__ __forceinline__ float bias_src(int i) const { return bgate[i]; }
    __device__ __forceinline__ void operator()(const Acc& acc, const Unit& u, int wr, int wc, int fr, int fq, const LAS float* rsl, const LAS float* bl) const {
        const int row0 = u.pm * BM + wr * 64 + fr, pn = u.pn, cw = wc * 32 + 8 * fq;
        float rs[2][4];
#pragma unroll
        for (int ai = 0; ai < 2; ++ai)
#pragma unroll
            for (int m = 0; m < 4; ++m) rs[ai][m] = rsl[ai * HALF + wr * 64 + m * 16 + fr];
        if (pn >= 4 && pn < 12) {
            const int col0 = (pn - 4) * HALF + cw;
#pragma unroll
            for (int ai = 0; ai < 2; ++ai)
#pragma unroll
                for (int m = 0; m < 4; ++m) { const float r2 = rs[ai][m] * rs[ai][m];
                    *(u32x4*)(ZCV + (size_t)(row0 + ai * HALF + m * 16) * D + col0) = pack8(acc[ai][0][m][0] * acc[ai][1][m][0] * r2, acc[ai][0][m][1] * acc[ai][1][m][1] * r2); }
        } else if (pn < 16) {
            bf16_t* base = pn < 4 ? ZB : ZP; const int col0 = (pn < 4 ? pn : pn - 12) * BM + cw;
#pragma unroll
            for (int ai = 0; ai < 2; ++ai)
#pragma unroll
                for (int m = 0; m < 4; ++m) { bf16_t* rowp = base + (size_t)(row0 + ai * HALF + m * 16) * D + col0;
#pragma unroll
                    for (int bj = 0; bj < 2; ++bj) *(u32x4*)(rowp + bj * HALF) = pack8(acc[ai][bj][m][0] * rs[ai][m], acc[ai][bj][m][1] * rs[ai][m]); }
        } else {
            const int col0 = (pn - 16) * BM + cw;
            f32x4 bv[2][2];
#pragma unroll
            for (int bj = 0; bj < 2; ++bj)
#pragma unroll
                for (int n = 0; n < 2; ++n) bv[bj][n] = *(const LAS f32x4*)(bl + col0 + bj * HALF + 4 * n);
#pragma unroll
            for (int ai = 0; ai < 2; ++ai)
#pragma unroll
                for (int m = 0; m < 4; ++m) { bf16_t* rowp = ZG + (size_t)(row0 + ai * HALF + m * 16) * 2048 + col0;
#pragma unroll
                    for (int bj = 0; bj < 2; ++bj) { f32x4 v[2];
#pragma unroll
                        for (int n = 0; n < 2; ++n) { const f32x4 a = acc[ai][bj][m][n] * rs[ai][m] + bv[bj][n];
#pragma unroll
                            for (int j = 0; j < 4; ++j) v[n][j] = sigmoid_f(a[j]); }
                        *(u32x4*)(rowp + bj * HALF) = pack8(v[0], v[1]); } }
        }
    }
};
struct EpiPoolGroup {
    static constexpr bool ROWSCALE = false; static constexpr int NBIAS = 2048, NSTORES = 16;
    bf16_t* O; const float* bias; const float* scale; const float* ssq;
    __device__ __forceinline__ float bias_src(int i) const { return i < 1024 ? bias[i] : scale[i - 1024]; }
    __device__ __forceinline__ void operator()(const Acc& acc, const Unit& u, int wr, int wc, int fr, int fq, const LAS float* rsl, const LAS float* bl) const {
        const int row0 = u.pm * BM + wr * 64 + fr, col0 = u.pn * BM + wc * 32 + 8 * fq;
        f32x4 bv[2][2], sv[2][2];
#pragma unroll
        for (int bj = 0; bj < 2; ++bj)
#pragma unroll
            for (int n = 0; n < 2; ++n) { bv[bj][n] = *(const LAS f32x4*)(bl + col0 + bj * HALF + 4 * n); sv[bj][n] = *(const LAS f32x4*)(bl + 1024 + col0 + bj * HALF + 4 * n); }
#pragma unroll
        for (int ai = 0; ai < 2; ++ai)
#pragma unroll
            for (int m = 0; m < 4; ++m) { bf16_t* rowp = O + (size_t)(row0 + ai * HALF + m * 16) * D + col0;
#pragma unroll
                for (int bj = 0; bj < 2; ++bj) *(u32x4*)(rowp + bj * HALF) = pack8((acc[ai][bj][m][0] + bv[bj][0]) * sv[bj][0], (acc[ai][bj][m][1] + bv[bj][1]) * sv[bj][1]); }
    }
};
__device__ __forceinline__ void unpack8v(const u32x4 q, f32x4& a, f32x4& b) { a = (f32x4){bf_lo(q.x), bf_hi(q.x), bf_lo(q.y), bf_hi(q.y)}; b = (f32x4){bf_lo(q.z), bf_hi(q.z), bf_lo(q.w), bf_hi(q.w)}; }
struct EpiGateA {
    static constexpr bool ROWSCALE = false; static constexpr int NBIAS = 0, NSTORES = 16;
    const bf16_t* ZG; bf16_t* M1; const float* ssq;
    __device__ __forceinline__ void operator()(const Acc& acc, const Unit& u, int wr, int wc, int fr, int fq, const LAS float* rsl, const LAS float* bl) const {
        const int row0 = u.pm * BM + wr * 64 + fr, col0 = u.pn * BM + wc * 32 + 8 * fq;
#pragma unroll
        for (int ai = 0; ai < 2; ++ai) {
            u32x4 gq[4][2];
#pragma unroll
            for (int m = 0; m < 4; ++m)
#pragma unroll
                for (int bj = 0; bj < 2; ++bj) gq[m][bj] = *(const u32x4*)(ZG + (size_t)(row0 + ai * HALF + m * 16) * 2048 + col0 + bj * HALF);
#pragma unroll
            for (int m = 0; m < 4; ++m)
#pragma unroll
                for (int bj = 0; bj < 2; ++bj) { f32x4 g0, g1; unpack8v(gq[m][bj], g0, g1);
                    *(u32x4*)(M1 + (size_t)(row0 + ai * HALF + m * 16) * D + col0 + bj * HALF) = pack8(g0 * acc[ai][bj][m][0], g1 * acc[ai][bj][m][1]); }
        }
    }
};
struct EpiGateP {
    static constexpr bool ROWSCALE = false; static constexpr int NBIAS = 0, NSTORES = 16;
    const bf16_t* ZG; const bf16_t* M1; bf16_t* MM; const float* ssq;
    __device__ __forceinline__ void operator()(const Acc& acc, const Unit& u, int wr, int wc, int fr, int fq, const LAS float* rsl, const LAS float* bl) const {
        const int row0 = u.pm * BM + wr * 64 + fr, col0 = u.pn * BM + wc * 32 + 8 * fq;
#pragma unroll
        for (int ai = 0; ai < 2; ++ai) {
            u32x4 gq[4][2], mq[4][2];
#pragma unroll
            for (int m = 0; m < 4; ++m)
#pragma unroll
                for (int bj = 0; bj < 2; ++bj) { const size_t r = (size_t)(row0 + ai * HALF + m * 16);
                    gq[m][bj] = *(const u32x4*)(ZG + r * 2048 + D + col0 + bj * HALF); mq[m][bj] = *(const u32x4*)(M1 + r * D + col0 + bj * HALF); }
#pragma unroll
            for (int m = 0; m < 4; ++m)
#pragma unroll
                for (int bj = 0; bj < 2; ++bj) { f32x4 g0, g1, m0, m1; unpack8v(gq[m][bj], g0, g1); unpack8v(mq[m][bj], m0, m1);
                    *(u32x4*)(MM + (size_t)(row0 + ai * HALF + m * 16) * D + col0 + bj * HALF) = pack8(m0 + g0 * acc[ai][bj][m][0], m1 + g1 * acc[ai][bj][m][1]); }
        }
    }
};
}


#define XB_TMO      128
#define XB_XCNT(j)  (256  + 64 * (j))
#define XB_XSUB(j)  (1280 + 64 * (j))
#define XB_XGEN(j)  (2304 + 64 * (j))
#define XB_TOP      3328
#define XB_TOPGEN   3392
#define XCD_BAR_WORDS 3456
#define XB_SPIN_CAP (1u << 18)

__device__ __forceinline__ unsigned xb_ld(unsigned* p)              { return __hip_atomic_load(p, __ATOMIC_RELAXED, __HIP_MEMORY_SCOPE_AGENT); }
__device__ __forceinline__ unsigned xb_add(unsigned* p, unsigned v) { return __hip_atomic_fetch_add(p, v, __ATOMIC_RELAXED, __HIP_MEMORY_SCOPE_AGENT); }
__device__ __forceinline__ unsigned xb_xcc_id() { return (unsigned)__builtin_amdgcn_s_getreg((3 << 11) | 20) & 0xFu; }
#define XB_SPIN(cond, bar) do { unsigned _sp = 0; while (cond) { __builtin_amdgcn_s_sleep(1); \
    if ((++_sp & 255u) == 0u) { if (xb_ld(&(bar)[XB_TMO])) break; if (_sp > XB_SPIN_CAP) { atomicAdd(&(bar)[XB_TMO], 1u); break; } } } } while (0)

struct XcdBarrier {
    unsigned* bar; unsigned x;
    volatile LAS unsigned* st;
};

__device__ __forceinline__ XcdBarrier xcd_barrier_post(unsigned* bar, volatile LAS unsigned* st) {
    XcdBarrier b; b.bar = bar; b.x = xb_xcc_id(); b.st = st;
    if (threadIdx.x == 0) (void)xb_add(&bar[XB_XCNT(b.x)], 1u);
    return b;
}
__device__ __forceinline__ void xcd_barrier_complete(unsigned* bar, unsigned x, unsigned& nloc, unsigned& nx) {
    const unsigned G = gridDim.x * gridDim.y * gridDim.z;
    unsigned sum, cnt, mine, sp = 0u;
    for (;;) {
        sum = 0u; cnt = 0u; mine = 0u;
#pragma unroll
        for (unsigned j = 0; j < 16; ++j) { const unsigned c = xb_ld(&bar[XB_XCNT(j)]); sum += c; cnt += (c > 0u) ? 1u : 0u; mine = (j == x) ? c : mine; }
        if (sum == G) break;
        __builtin_amdgcn_s_sleep(1);
        if ((++sp & 255u) == 0u) { if (xb_ld(&bar[XB_TMO])) break; if (sp > XB_SPIN_CAP) { atomicAdd(&bar[XB_TMO], 1u); break; } }
    }
    nloc = mine > 0u ? mine : 1u; nx = cnt > 0u ? cnt : 1u;
}

__device__ __forceinline__ void xcd_barrier(const XcdBarrier& b) {
    asm volatile("s_waitcnt vmcnt(0)" ::: "memory");
    __syncthreads();
    if (threadIdx.x == 0) {
        unsigned* bar = b.bar;
        __builtin_amdgcn_s_waitcnt(0);
        unsigned nloc = b.st[0], nx = b.st[1];
        if (nloc == 0u) { xcd_barrier_complete(bar, b.x, nloc, nx); b.st[0] = nloc; b.st[1] = nx; }
        const unsigned old = xb_add(&bar[XB_XSUB(b.x)], 1u);
        const unsigned gen = old / nloc;
        if (old + 1u == (gen + 1u) * nloc) {
            __builtin_amdgcn_fence(__ATOMIC_RELEASE, "agent");
            asm volatile("s_waitcnt vmcnt(0)" ::: "memory");
            const unsigned og = xb_add(&bar[XB_TOP], 1u);
            const unsigned tg = og / nx;
            if (og + 1u == (tg + 1u) * nx) xb_add(&bar[XB_TOPGEN], 1u);
            else XB_SPIN(xb_ld(&bar[XB_TOPGEN]) == tg, bar);
            __builtin_amdgcn_fence(__ATOMIC_ACQUIRE, "agent");
            xb_add(&bar[XB_XGEN(b.x)], 1u);
            asm volatile("s_waitcnt vmcnt(0)" ::: "memory");
        } else {
            XB_SPIN(xb_ld(&bar[XB_XGEN(b.x)]) == gen, bar);
            __builtin_amdgcn_fence(__ATOMIC_ACQUIRE, "agent");
            asm volatile("s_waitcnt vmcnt(0)" ::: "memory");
        }
    }
    __syncthreads();
}

struct Args { const float* in[20]; float* out; unsigned char* ws; int ph_lo, ph_hi; };
struct Ctx { LAS unsigned char* lds; int lane, wave, gw, NGW, G; };

__device__ __forceinline__ void transpose_item(const float* W, int ldsrc, int K, int src_col0, bf16_t* WT, int dst_row0, int k0, const float* kscale, LAS float* scr, int lane) {
    {
        const int kr = lane >> 3, n4 = (lane & 7) * 4; f32x4 v[8];
#pragma unroll
        for (int i = 0; i < 8; ++i) v[i] = *(const f32x4*)(W + (size_t)(k0 + 8 * i + kr) * ldsrc + src_col0 + n4);
#pragma unroll
        for (int i = 0; i < 8; ++i) { const int kk = 8 * i + kr; const float sc = kscale ? kscale[k0 + kk] : 1.0f; LAS float* d = scr + kk * 33 + n4;
            d[0] = v[i].x * sc; d[1] = v[i].y * sc; d[2] = v[i].z * sc; d[3] = v[i].w * sc; }
    }
    LDS_WAIT(); asm volatile("" ::: "memory");
    const int c = lane & 7;
#pragma unroll
    for (int j = 0; j < 4; ++j) { const int n = (lane >> 3) + 8 * j; const LAS float* sp = scr + (8 * c) * 33 + n;
        u32x4 o; o.x = cvt_pk_bf16(sp[0 * 33], sp[1 * 33]); o.y = cvt_pk_bf16(sp[2 * 33], sp[3 * 33]); o.z = cvt_pk_bf16(sp[4 * 33], sp[5 * 33]); o.w = cvt_pk_bf16(sp[6 * 33], sp[7 * 33]);
        *(u32x4*)(WT + (size_t)(dst_row0 + n) * K + k0 + 8 * c) = o; }
    LDS_WAIT(); asm volatile("" ::: "memory");
}
__device__ __forceinline__ int map_gu(int n) { return ((n >> 7) & 1) * FF + (n >> 8) * 128 + (n & 127); }
__device__ __forceinline__ int map_in(int n) { if (n < 1024 || n >= 3072) return n; const int q = (n - 1024) >> 8, h = (n >> 7) & 1; return (h ? 2048 : 1024) + q * 128 + (n & 127); }

__device__ __forceinline__ void prep_weights(const Ctx& F, const Args& a, unsigned char* ws, int l) {
    LAS float* scr = (LAS float*)(F.lds + F.wave * 16384);
    constexpr int I_GU = (D / 64) * (NGU / 32), I_D = (FF / 64) * (D / 32), I_IN = (D / 64) * (NIN / 32), I_SQ = (D / 64) * (D / 32), I_PG = 4 * (256 / 64) * (256 / 32);
    constexpr int NITEMS = 2 * I_GU + 2 * I_D + I_IN + 3 * I_SQ + I_PG;
    for (int it = F.gw; it < NITEMS; it += F.NGW) {
        int r = it;
        if (r < 2 * I_GU) { const int w = r / I_GU; r -= w * I_GU; const int kb = r / (NGU / 32), nb = r % (NGU / 32);
            transpose_item(a.in[w ? 18 : 3] + (size_t)l * D * NGU, NGU, D, map_gu(32 * nb), (bf16_t*)(ws + (w ? W_GU2 : W_GU1)), 32 * nb, 64 * kb, a.in[w ? 16 : 1] + l * D, scr, F.lane); continue; }
        r -= 2 * I_GU;
        if (r < 2 * I_D) { const int w = r / I_D; r -= w * I_D; const int kb = r / (D / 32), nb = r % (D / 32);
            transpose_item(a.in[w ? 19 : 4] + (size_t)l * FF * D, D, FF, 32 * nb, (bf16_t*)(ws + (w ? W_D2 : W_D1)), 32 * nb, 64 * kb, nullptr, scr, F.lane); continue; }
        r -= 2 * I_D;
        if (r < I_IN) { const int kb = r / (NIN / 32), nb = r % (NIN / 32);
            transpose_item(a.in[7] + (size_t)l * D * NIN, NIN, D, map_in(32 * nb), (bf16_t*)(ws + W_IN), 32 * nb, 64 * kb, a.in[5] + l * D, scr, F.lane); continue; }
        r -= I_IN;
        if (r < 3 * I_SQ) { const int w = r / I_SQ; r -= w * I_SQ; const int kb = r / (D / 32), nb = r % (D / 32);
            transpose_item(a.in[w == 0 ? 10 : (w == 1 ? 14 : 15)] + (size_t)l * D * D, D, D, 32 * nb, (bf16_t*)(ws + (w == 0 ? W_CO : (w == 1 ? W_PO : W_WO))), 32 * nb, 64 * kb, nullptr, scr, F.lane); continue; }
        r -= 3 * I_SQ;
        { const int gi = r / 32; r -= gi * 32; const int kb = r / 8, nb = r % 8;
            transpose_item(a.in[11] + (size_t)l * 4 * 65536 + (size_t)gi * 65536, 256, 256, 32 * nb, (bf16_t*)(ws + W_PG), gi * 256 + 32 * nb, 64 * kb, nullptr, scr, F.lane); }
    }
}

__device__ __forceinline__ void cast_rows(const Ctx& F, const float* x, bf16_t* Xb, float* ssq) {
    for (int m = F.gw; m < M; m += F.NGW) {
        const f32x4* xr = (const f32x4*)(x + (size_t)m * D) + F.lane;
        f32x4 v[4]; float s = 0.f;
#pragma unroll
        for (int j = 0; j < 4; ++j) { v[j] = xr[64 * j]; s += (v[j].x * v[j].x + v[j].y * v[j].y) + (v[j].z * v[j].z + v[j].w * v[j].w); }
        s = wave_sum(s, F.lane);
        u32x2* o = (u32x2*)(Xb + (size_t)m * D) + F.lane;
#pragma unroll
        for (int j = 0; j < 4; ++j) { u32x2 w; w.x = cvt_pk_bf16(v[j].x, v[j].y); w.y = cvt_pk_bf16(v[j].z, v[j].w); o[64 * j] = w; }
        if (F.lane == 0) ssq[m] = s;
    }
}
__device__ __forceinline__ void resid_rows(const Ctx& F, bf16_t* Xb, const bf16_t* h, const float* post, float cs, float* ssq, float* outf) {
    f32x4 pv[4];
#pragma unroll
    for (int j = 0; j < 4; ++j) pv[j] = ((const f32x4*)post)[F.lane + 64 * j] * cs;
    for (int m0 = F.gw; m0 < M; m0 += 2 * F.NGW) {
        const int m1 = m0 + F.NGW; const bool two = m1 < M; const int mb = two ? m1 : m0;
        f32x4 hv[2][4], xv[2][4];
#pragma unroll
        for (int r = 0; r < 2; ++r) { const int m = r ? mb : m0;
            const u32x2* hr = (const u32x2*)(h + (size_t)m * D) + F.lane; const u32x2* xr = (const u32x2*)(Xb + (size_t)m * D) + F.lane;
#pragma unroll
            for (int j = 0; j < 4; ++j) { const u32x2 q = hr[64 * j]; hv[r][j] = (f32x4){bf_lo(q.x), bf_hi(q.x), bf_lo(q.y), bf_hi(q.y)};
                const u32x2 p = xr[64 * j]; xv[r][j] = (f32x4){bf_lo(p.x), bf_hi(p.x), bf_lo(p.y), bf_hi(p.y)}; } }
#pragma unroll
        for (int r = 0; r < 2; ++r) { const int m = r ? mb : m0; if (r && !two) break;
            float s = 0.f;
#pragma unroll
            for (int j = 0; j < 4; ++j) s += (hv[r][j].x * hv[r][j].x + hv[r][j].y * hv[r][j].y) + (hv[r][j].z * hv[r][j].z + hv[r][j].w * hv[r][j].w);
            const float r1 = 1.0f / sqrtf(wave_sum(s, F.lane) * (1.f / D) + EPS);
            if (outf) {
                f32x4* xo = (f32x4*)(outf + (size_t)m * D) + F.lane;
#pragma unroll
                for (int j = 0; j < 4; ++j) xo[64 * j] = xv[r][j] + hv[r][j] * r1 * pv[j];
            } else {
                float s2 = 0.f;
                u32x2* o = (u32x2*)(Xb + (size_t)m * D) + F.lane;
#pragma unroll
                for (int j = 0; j < 4; ++j) { const f32x4 xn = xv[r][j] + hv[r][j] * r1 * pv[j]; u32x2 w; w.x = cvt_pk_bf16(xn.x, xn.y); w.y = cvt_pk_bf16(xn.z, xn.w); o[64 * j] = w;
                    const f32x4 xr_ = {bf_lo(w.x), bf_hi(w.x), bf_lo(w.y), bf_hi(w.y)};
                    s2 += (xr_.x * xr_.x + xr_.y * xr_.y) + (xr_.z * xr_.z + xr_.w * xr_.w); }
                s2 = wave_sum(s2, F.lane);
                if (F.lane == 0) ssq[m] = s2;
            }
        }
    }
}
__device__ __forceinline__ void unpack8(const u32x4 q, float (&f)[8]) { f[0] = bf_lo(q.x); f[1] = bf_hi(q.x); f[2] = bf_lo(q.y); f[3] = bf_hi(q.y); f[4] = bf_lo(q.z); f[5] = bf_hi(q.z); f[6] = bf_lo(q.w); f[7] = bf_hi(q.w); }
__device__ __forceinline__ void mix_rows(const Ctx& F, bf16_t* ZBCA, const bf16_t* ZCV, const bf16_t* ZP, const float* convw, bf16_t* DDo) {
    const int half = F.gw & 1, c0 = half * 512 + F.lane * 8;
    const int npair = F.NGW >> 1, tpw = M / npair, t0 = (F.gw >> 1) * tpw;
    float w0[8], w1[8], w2[8];
#pragma unroll
    for (int j = 0; j < 8; ++j) { w0[j] = convw[c0 + j]; w1[j] = convw[D + c0 + j]; w2[j] = convw[2 * D + c0 + j]; }
    const int win = 2 << (c0 >> 8), wmax = half ? 16 : 4;
    const u32x4 zero = {0u, 0u, 0u, 0u};
    const int s0 = t0 & (SEQ - 1);
    const size_t off0 = (size_t)t0 * D + c0;
    float acc[8], cm1[8], cm2[8];
#pragma unroll
    for (int j = 0; j < 8; ++j) acc[j] = 0.f;
    for (int k = 1; k < wmax; ++k) {
        const bool ok = (k < win) && (s0 >= k);
        const u32x4 q = ok ? *(const u32x4*)(ZP + off0 - (size_t)k * D) : zero;
        float f[8]; unpack8(q, f);
#pragma unroll
        for (int j = 0; j < 8; ++j) acc[j] += f[j];
    }
    { const u32x4 q1 = s0 >= 1 ? *(const u32x4*)(ZCV + off0 - D) : zero, q2 = s0 >= 2 ? *(const u32x4*)(ZCV + off0 - 2 * D) : zero; unpack8(q1, cm1); unpack8(q2, cm2); }
    for (int i = 0; i < tpw; i += 4) {
        u32x4 qb[4], qc[4], qp[4], qo[4];
#pragma unroll
        for (int u = 0; u < 4; ++u) { const size_t off = off0 + (size_t)(i + u) * D; const int s = s0 + i + u;
            qb[u] = *(const u32x4*)(ZBCA + off); qc[u] = *(const u32x4*)(ZCV + off); qp[u] = *(const u32x4*)(ZP + off);
            qo[u] = (s >= win - 1) ? *(const u32x4*)(ZP + off - (size_t)(win - 1) * D) : zero; }
#pragma unroll
        for (int u = 0; u < 4; ++u) { const size_t off = off0 + (size_t)(i + u) * D; const int s = s0 + i + u;
            float fb[8], fc[8], fp[8], fo[8], ca[8], dd[8];
            unpack8(qb[u], fb); unpack8(qc[u], fc); unpack8(qp[u], fp); unpack8(qo[u], fo);
            const float inv = 1.0f / (float)((s + 1) < win ? (s + 1) : win);
#pragma unroll
            for (int j = 0; j < 8; ++j) { ca[j] = fb[j] * (w0[j] * cm2[j] + w1[j] * cm1[j] + w2[j] * fc[j]); cm2[j] = cm1[j]; cm1[j] = fc[j];
                const float st = acc[j] + fp[j]; dd[j] = st * inv - fp[j]; acc[j] = st - fo[j]; }
            u32x4 o1, o2;
            o1.x = cvt_pk_bf16(ca[0], ca[1]); o1.y = cvt_pk_bf16(ca[2], ca[3]); o1.z = cvt_pk_bf16(ca[4], ca[5]); o1.w = cvt_pk_bf16(ca[6], ca[7]);
            o2.x = cvt_pk_bf16(dd[0], dd[1]); o2.y = cvt_pk_bf16(dd[2], dd[3]); o2.z = cvt_pk_bf16(dd[4], dd[5]); o2.w = cvt_pk_bf16(dd[6], dd[7]);
            *(u32x4*)(ZBCA + off) = o1; *(u32x4*)(DDo + off) = o2; }
    }
}

__device__ __forceinline__ bool launder(Ctx& F, unsigned char*& ws, int& tidv) { int t; asm volatile("v_mbcnt_lo_u32_b32 %0, -1, 0\n\tv_mbcnt_hi_u32_b32 %0, -1, %0" : "=v"(t)); F.lane = t; tidv = F.wave * 64 + t;
    const unsigned long long w0 = (unsigned long long)ws; unsigned wl = __builtin_amdgcn_readfirstlane((unsigned)w0), wh = __builtin_amdgcn_readfirstlane((unsigned)(w0 >> 32)); asm volatile("" : "+s"(wl), "+s"(wh));
    const unsigned long long w = ((unsigned long long)wh << 32) | wl; ws = (unsigned char*)(__attribute__((address_space(1))) unsigned char*)w; return true; }
constexpr int PH_PER_LAYER = 12, N_PHASES = 1 + DEPTH * PH_PER_LAYER;

__global__ void __launch_bounds__(512, 2) mega_fwd(Args a) {
    extern __shared__ __attribute__((aligned(16))) unsigned char lds_raw[];
    Ctx F; F.lds = (LAS unsigned char*)lds_raw; F.lane = threadIdx.x & 63; F.wave = __builtin_amdgcn_readfirstlane(threadIdx.x >> 6);
    F.G = gridDim.x; F.gw = blockIdx.x * 8 + F.wave; F.NGW = F.G * 8;
    unsigned char* ws = a.ws; int tidv = threadIdx.x;
    const int lo = a.ph_lo, hi = a.ph_hi;
    volatile LAS unsigned* MISC = (volatile LAS unsigned*)(F.lds + MISC_OFF);
    if (threadIdx.x < 32) MISC[threadIdx.x] = 0u;
    __syncthreads();
    XcdBarrier bar; bar.bar = (unsigned*)(ws + WS_BAR); bar.x = 0; bar.st = nullptr;
    if (hi - lo > 1) bar = xcd_barrier_post((unsigned*)(ws + WS_BAR), MISC + 8);
    if (lo < 0) cg::this_grid().sync();
    int ph = 0;
#define IN_PH (lo <= ph && ph < hi && launder(F, ws, tidv))
#define SEAM() do { if (lo <= ph && ph + 1 < hi) { xcd_barrier(bar); } ++ph; } while (0)
#define XB ((bf16_t*)(ws + WS_XB))
#define SSQ ((float*)(ws + WS_SSQ))
    if (IN_PH) { prep_weights(F, a, ws, 0); cast_rows(F, a.in[0], XB, SSQ); }
    SEAM();
    for (int l = 0; l < DEPTH; ++l) {
        if (IN_PH) { pg8::Gemm g{XB, (const bf16_t*)(ws + W_GU1), M, NGU, D, D, 0}; pg8::StaticOrder S; S.init(M, NGU, F.G, blockIdx.x);
            pg8::EpiSwiglu E{(bf16_t*)(ws + WS_HH), SSQ}; pg8::gemm_phase(F.lds, g, S, E, tidv); }
        SEAM();
        if (IN_PH) { pg8::Gemm g{(const bf16_t*)(ws + WS_HH), (const bf16_t*)(ws + W_D1), M, D, FF, FF, 0}; pg8::StaticOrder S; S.init(M, D, F.G, blockIdx.x);
            pg8::EpiH E{(bf16_t*)(ws + WS_HFFN), nullptr}; pg8::gemm_phase(F.lds, g, S, E, tidv); }
        SEAM();
        if (IN_PH) resid_rows(F, XB, (const bf16_t*)(ws + WS_HFFN), a.in[2] + l * D, 0.5f, SSQ, nullptr);
        SEAM();
        if (IN_PH) { pg8::Gemm g{XB, (const bf16_t*)(ws + W_IN), M, NIN, D, D, 0}; pg8::StaticOrder S; S.init(M, NIN, F.G, blockIdx.x);
            pg8::EpiWin E{(bf16_t*)(ws + WS_ZB), (bf16_t*)(ws + WS_ZCV), (bf16_t*)(ws + WS_ZP), (bf16_t*)(ws + WS_ZG), a.in[8] + l * 2 * D, SSQ}; pg8::gemm_phase(F.lds, g, S, E, tidv); }
        SEAM();
        if (IN_PH) mix_rows(F, (bf16_t*)(ws + WS_ZB), (const bf16_t*)(ws + WS_ZCV), (const bf16_t*)(ws + WS_ZP), a.in[9] + l * 3 * D, (bf16_t*)(ws + WS_DD));
        SEAM();
        if (IN_PH) { pg8::Gemm g{(const bf16_t*)(ws + WS_DD), (const bf16_t*)(ws + W_PG), M, D, 256, D, 256}; pg8::StaticOrder S; S.init(M, D, F.G, blockIdx.x);
            pg8::EpiPoolGroup E{(bf16_t*)(ws + WS_YP0), a.in[12] + l * D, a.in[13] + l * D, nullptr}; pg8::gemm_phase(F.lds, g, S, E, tidv); }
        if (IN_PH) { pg8::Gemm g{(const bf16_t*)(ws + WS_CA), (const bf16_t*)(ws + W_CO), M, D, D, D, 0}; pg8::StaticOrder S; S.init(M, D, F.G, blockIdx.x);
            pg8::EpiGateA E{(const bf16_t*)(ws + WS_ZG), (bf16_t*)(ws + WS_M1), nullptr}; pg8::gemm_phase(F.lds, g, S, E, tidv); }
        SEAM();
        if (IN_PH) { pg8::Gemm g{(const bf16_t*)(ws + WS_YP0), (const bf16_t*)(ws + W_PO), M, D, D, D, 0}; pg8::StaticOrder S; S.init(M, D, F.G, blockIdx.x);
            pg8::EpiGateP E{(const bf16_t*)(ws + WS_ZG), (const bf16_t*)(ws + WS_M1), (bf16_t*)(ws + WS_MM), nullptr}; pg8::gemm_phase(F.lds, g, S, E, tidv); }
        SEAM();
        if (IN_PH) { pg8::Gemm g{(const bf16_t*)(ws + WS_MM), (const bf16_t*)(ws + W_WO), M, D, D, D, 0}; pg8::StaticOrder S; S.init(M, D, F.G, blockIdx.x);
            pg8::EpiH E{(bf16_t*)(ws + WS_HMIX), nullptr}; pg8::gemm_phase(F.lds, g, S, E, tidv); }
        SEAM();
        if (IN_PH) resid_rows(F, XB, (const bf16_t*)(ws + WS_HMIX), a.in[6] + l * D, 1.0f, SSQ, nullptr);
        SEAM();
        if (IN_PH) { pg8::Gemm g{XB, (const bf16_t*)(ws + W_GU2), M, NGU, D, D, 0}; pg8::StaticOrder S; S.init(M, NGU, F.G, blockIdx.x);
            pg8::EpiSwiglu E{(bf16_t*)(ws + WS_HH), SSQ}; pg8::gemm_phase(F.lds, g, S, E, tidv); }
        SEAM();
        if (IN_PH) { pg8::Gemm g{(const bf16_t*)(ws + WS_HH), (const bf16_t*)(ws + W_D2), M, D, FF, FF, 0}; pg8::StaticOrder S; S.init(M, D, F.G, blockIdx.x);
            pg8::EpiH E{(bf16_t*)(ws + WS_HFFN), nullptr}; pg8::gemm_phase(F.lds, g, S, E, tidv); }
        SEAM();
        if (IN_PH) { const bool more = (l + 1 < DEPTH);
            resid_rows(F, XB, (const bf16_t*)(ws + WS_HFFN), a.in[17] + l * D, 0.5f, SSQ, more ? nullptr : a.out);
            if (more) prep_weights(F, a, ws, l + 1); }
        SEAM();
    }
#undef IN_PH
#undef SEAM
}

extern "C" void kernel_launch(void* const* d_in, const int* in_sizes, int n_in, void* d_out, int out_size, void* d_ws, size_t ws_size, hipStream_t stream) {
    static int grid = 0;
    if (grid == 0) {
        if (n_in != 20 || in_sizes[0] != M * D || out_size != M * D || ws_size < WS_END) { fprintf(stderr, "kernel_launch: unexpected shapes (n_in %d, in0 %d, out %d, ws %zu < %zu)\n", n_in, n_in > 0 ? in_sizes[0] : -1, out_size, ws_size, (size_t)WS_END); grid = -1; return; }
        int dev = 0, cus = 0, per_cu = 0;
        (void)hipGetDevice(&dev); (void)hipDeviceGetAttribute(&cus, hipDeviceAttributeMultiprocessorCount, dev);
        if (hipFuncSetAttribute((const void*)mega_fwd, hipFuncAttributeMaxDynamicSharedMemorySize, LDS_BYTES) != hipSuccess) { fprintf(stderr, "kernel_launch: hipFuncSetAttribute failed\n"); grid = -1; return; }
        if (hipOccupancyMaxActiveBlocksPerMultiprocessor(&per_cu, (const void*)mega_fwd, 512, LDS_BYTES) != hipSuccess || per_cu < 1) { fprintf(stderr, "kernel_launch: occupancy query says %d\n", per_cu); per_cu = 1; (void)hipGetLastError(); }
        grid = cus * per_cu;
    }
    if (grid < 0) return;
    Args a{};
    for (int i = 0; i < 20; ++i) a.in[i] = (const float*)d_in[i];
    a.out = (float*)d_out; a.ws = (unsigned char*)d_ws;
#if MK_ONE_LAUNCH
    if (hipMemsetAsync((char*)d_ws, 0, CTL_ZERO_BYTES, stream) != hipSuccess) { fprintf(stderr, "kernel_launch: memset failed\n"); return; }
    a.ph_lo = 0; a.ph_hi = N_PHASES;
    void* args[] = {&a};
    hipError_t e = hipLaunchCooperativeKernel((const void*)mega_fwd, dim3(grid), dim3(512), args, LDS_BYTES, stream);
    if (e != hipSuccess) fprintf(stderr, "cooperative launch failed: %s (grid %d)\n", hipGetErrorString(e), grid);
#else
    for (int p = 0; p < N_PHASES; ++p) { a.ph_lo = p; a.ph_hi = p + 1; hipLaunchKernelGGL(mega_fwd, dim3(grid), dim3(512), LDS_BYTES, stream, a); }
#endif
}
```

```cpp
#include <hip/hip_runtime.h>
#include <hip/hip_cooperative_groups.h>
#include <cstdio>
#include <cstdint>
namespace cg = cooperative_groups;

#ifndef MK_ONE_LAUNCH
#define MK_ONE_LAUNCH 1
#endif

#define LAS __attribute__((address_space(3)))
typedef unsigned short bf16_t;
typedef short bf16x8 __attribute__((ext_vector_type(8)));
typedef float f32x4 __attribute__((ext_vector_type(4)));
typedef unsigned u32x4 __attribute__((ext_vector_type(4)));
typedef unsigned u32x2 __attribute__((ext_vector_type(2)));

constexpr int D = 1024, SEQ = 2048, BATCH = 16, M = BATCH * SEQ, FF = 2816, NGU = 2 * FF, NIN = 6144, DEPTH = 2;
constexpr float EPS = 1e-6f;
constexpr size_t MiB = 1u << 20;
constexpr size_t WS_W = 1 * MiB;
constexpr size_t W_GU1 = WS_W, W_D1 = W_GU1 + (size_t)NGU * D * 2, W_IN = W_D1 + (size_t)D * FF * 2, W_PG = W_IN + (size_t)NIN * D * 2,
                 W_CO = W_PG + (size_t)D * 256 * 2, W_PO = W_CO + (size_t)D * D * 2, W_WO = W_PO + (size_t)D * D * 2, W_GU2 = W_WO + (size_t)D * D * 2,
                 W_D2 = W_GU2 + (size_t)NGU * D * 2, W_END = W_D2 + (size_t)D * FF * 2;
static_assert(W_END <= 56 * MiB, "weights");
constexpr size_t WS_CNT = 32768;
constexpr size_t WS_XBUF = 256 * 1024;
constexpr size_t WS_XB = 56 * MiB;
constexpr size_t WS_R0 = 120 * MiB;
constexpr size_t WS_ZG = WS_R0;
constexpr size_t WS_ZB = WS_R0 + 128 * MiB;
constexpr size_t WS_ZCV = WS_ZB + 64 * MiB;
constexpr size_t WS_ZP = WS_ZCV + 64 * MiB;
constexpr size_t WS_DD = WS_ZP + 64 * MiB;
constexpr size_t WS_CA = WS_ZB;
constexpr size_t WS_YP0 = WS_ZCV;
constexpr size_t WS_M1 = WS_ZP;
constexpr size_t WS_MM = WS_DD;
constexpr size_t WS_HMIX = WS_R0;
constexpr size_t WS_HH = WS_R0;
constexpr size_t WS_HFFN = WS_ZCV;
constexpr size_t WS_SSQ = WS_DD + 64 * MiB;
constexpr size_t WS_END = WS_SSQ + 1 * MiB;
static_assert(WS_HH + (size_t)M * FF * 2 <= WS_HFFN, "H overlay");
constexpr int LDS_BYTES = 147456, MISC_OFF = 131072 + 320;
constexpr size_t WS_BAR = 16384, CTL_ZERO_BYTES = 131072;

typedef float f32x2 __attribute__((ext_vector_type(2)));
typedef __bf16 bf16x2 __attribute__((ext_vector_type(2)));
__device__ __forceinline__ unsigned cvt_pk_bf16(float lo, float hi) { const f32x2 v = {lo, hi}; const bf16x2 b = __builtin_convertvector(v, bf16x2); return __builtin_bit_cast(unsigned, b); }
__device__ __forceinline__ float bf_lo(unsigned u) { return __builtin_bit_cast(float, u << 16); }
__device__ __forceinline__ float bf_hi(unsigned u) { return __builtin_bit_cast(float, u & 0xffff0000u); }
__device__ __forceinline__ float sigmoid_f(float x) { return __builtin_amdgcn_rcpf(1.0f + __expf(-x)); }
__device__ __forceinline__ float wave_sum(float v, int lane) {
#pragma unroll
    for (int o = 1; o < 64; o <<= 1) v += __builtin_bit_cast(float, __builtin_amdgcn_ds_bpermute((lane ^ o) << 2, __builtin_bit_cast(int, v)));
    return v;
}
#define LDS_WAIT() asm volatile("s_waitcnt lgkmcnt(0)" ::: "memory")

namespace pg8 {
constexpr int BM = 256, BK = 64, HALF = 128, HTB = HALF * BK * 2, STAGE_BYTES = 8 * HTB, NXCD = 8, WGM = 8;
__host__ __device__ __forceinline__ int lds_byte(int r, int c) { const int st = (r >> 4) * 2 + (c >> 5), rr = r & 15, cc = c & 31, ob = rr * 64 + cc * 2; return st * 1024 + (ob ^ (((ob >> 9) & 1) << 5)); }
__host__ __device__ __forceinline__ void stage_rc(int b, int& R, int& C) { const int st = b / 1024, sb = b % 1024, swz = sb ^ (((sb >> 9) & 1) << 5); R = (st >> 1) * 16 + swz / 64; C = (st & 1) * 32 + (swz % 64) / 2; }
__host__ __device__ __forceinline__ int perm32(int rho) { const int n = rho >> 4, i = rho & 15; return 8 * (i >> 2) + 4 * n + (i & 3); }

struct Unit { int pm, pn; };
struct Gemm { const bf16_t* A; const bf16_t* Bt; int M, N, K, lda, a_pn_cols; };

struct StaticOrder {
    int nM, nN, nwg, G, c;
    __host__ __device__ void init(int M_, int N_, int G_, int c_) { nM = M_ / BM; nN = N_ / BM; nwg = nM * nN; G = G_; c = c_; }
    __host__ __device__ bool next(int i, Unit& u) const {
        const long L = (long)i * G + c; if (L >= nwg) return false;
        int wgid = (int)L; { const int q = nwg / NXCD, r = nwg % NXCD, xcd = wgid % NXCD, off = wgid / NXCD; wgid = (xcd < r ? xcd * (q + 1) : r * (q + 1) + (xcd - r) * q) + off; }
        const int nig = WGM * nN, gid = wgid / nig, fm = gid * WGM, gsz = (nM - fm) < WGM ? (nM - fm) : WGM;
        u.pm = fm + ((wgid % nig) % gsz); u.pn = (wgid % nig) / gsz; return true;
    }
};

typedef f32x4 Acc[2][2][4][2];
__device__ __forceinline__ const char* uni(const char* p) { const unsigned long long v = (unsigned long long)p; const unsigned lo = __builtin_amdgcn_readfirstlane((unsigned)v), hi = __builtin_amdgcn_readfirstlane((unsigned)(v >> 32)); return (const char*)(((unsigned long long)hi << 32) | lo); }

template <class Epi>
__device__ __forceinline__ void gemm_phase(LAS unsigned char* lds, const Gemm g, const StaticOrder& S, const Epi& E, const int tid) {
    const int wid = __builtin_amdgcn_readfirstlane(tid >> 6), lane = tid & 63, wr = wid >> 2, wc = wid & 3, fr = lane & 15, fq = lane >> 4;
    const int K = g.K, nt = K / BK;
    unsigned voffA[2], voffB[2];
#pragma unroll
    for (int i = 0; i < 2; ++i) { int R, C; stage_rc(tid * 16 + i * 8192, R, C); const int Rb = (R & ~31) + perm32(R & 31);
        voffA[i] = (unsigned)(R * g.lda + C) * 2u; voffB[i] = (unsigned)(Rb * K + C) * 2u; }
    const size_t kstep = (size_t)(BK * 2);
    const size_t hstepA = (size_t)HALF * g.lda * 2, tstepA = 2 * hstepA;
    const size_t hstepB = (size_t)HALF * K * 2, tstepB = 2 * hstepB;
    const size_t pnA = (size_t)g.a_pn_cols * 2;
    const unsigned ldsw = (unsigned)wid * 1024u;
    const int aoff = lds_byte(wr * 64 + fr, fq * 8), boff = lds_byte(wc * 32 + fr, fq * 8);
#define PG8_SA(b, h) (((b) * 2 + (h)) * HTB)
#define PG8_SB(b, h) ((4 + (b) * 2 + (h)) * HTB)
#define PG8_STAGE(bufoff, gbase, voff) do { _Pragma("unroll") for (int _i = 0; _i < 2; ++_i) \
        __builtin_amdgcn_global_load_lds((const unsigned*)((const char*)(gbase) + (voff)[_i]), (LAS unsigned*)(lds + (bufoff) + ldsw + _i * 8192), 16, 0, 0); } while (0)
#define PG8_LDA(dst, b, h) do { _Pragma("unroll") for (int m = 0; m < 4; ++m) _Pragma("unroll") for (int k = 0; k < 2; ++k) dst[m][k] = *(const LAS bf16x8*)(lds + PG8_SA(b, h) + aoff + m * 2048 + k * 1024); } while (0)
#define PG8_LDB(dst, b, h) do { _Pragma("unroll") for (int n = 0; n < 2; ++n) _Pragma("unroll") for (int k = 0; k < 2; ++k) dst[n][k] = *(const LAS bf16x8*)(lds + PG8_SB(b, h) + boff + n * 2048 + k * 1024); } while (0)
#define PG8_MMA(ai, bj, At, Bt) do { __builtin_amdgcn_s_setprio(1); _Pragma("unroll") for (int m = 0; m < 4; ++m) _Pragma("unroll") for (int n = 0; n < 2; ++n) _Pragma("unroll") for (int k = 0; k < 2; ++k) \
        acc[ai][bj][m][n] = __builtin_amdgcn_mfma_f32_16x16x32_bf16(Bt[n][k], At[m][k], acc[ai][bj][m][n], 0, 0, 0); __builtin_amdgcn_s_setprio(0); } while (0)
#define PG8_WAIT_V(n) asm volatile("s_waitcnt vmcnt(" #n ")" ::: "memory")
#define PG8_WAIT_L(n) asm volatile("s_waitcnt lgkmcnt(" #n ")" ::: "memory")
#define PG8_BAR __builtin_amdgcn_s_barrier()
#define PG8_SCHED __builtin_amdgcn_sched_barrier(0)
    Unit cur, nxt; int ui = 0;
    if (!S.next(0, cur)) return;
    LAS float* const rs_lds = (LAS float*)(lds + STAGE_BYTES + 1024); LAS float* const bias_lds = (LAS float*)(lds + STAGE_BYTES + 1024 + 2048);
    int rsbuf = 0, rspm = -1; bool rs_loaded = false;
#define PG8_RS_PREP(u) do { rs_loaded = false; if (Epi::ROWSCALE && (u).pm != rspm) { rs_loaded = true; rspm = (u).pm; rsbuf ^= 1; if (tid < 256) { const f32x4 q = ((const f32x4*)E.ssq)[rspm * BM + tid]; rs_lds[rsbuf * 256 + tid] = __builtin_amdgcn_rsqf(((q.x + q.y) + (q.z + q.w)) * (1.0f / 1024.0f) + 1e-6f); } } } while (0)
    if constexpr (Epi::NBIAS > 0) { for (int i = tid; i < Epi::NBIAS; i += 512) bias_lds[i] = E.bias_src(i); }
    PG8_RS_PREP(cur);
    Acc acc;
#pragma unroll
    for (int a = 0; a < 2; ++a)
#pragma unroll
        for (int b = 0; b < 2; ++b)
#pragma unroll
            for (int m = 0; m < 4; ++m)
#pragma unroll
                for (int n = 0; n < 2; ++n) acc[a][b][m][n] = (f32x4){0.f, 0.f, 0.f, 0.f};
    bf16x8 At[4][2], B0[2][2], B1[2][2];
    const char* cA = uni((const char*)g.A + (size_t)cur.pm * tstepA + (size_t)cur.pn * pnA); const char* cB = uni((const char*)g.Bt + (size_t)cur.pn * tstepB);
    PG8_STAGE(PG8_SB(0, 0), cB, voffB); PG8_STAGE(PG8_SB(0, 1), cB + hstepB, voffB); PG8_STAGE(PG8_SA(0, 0), cA, voffA); PG8_STAGE(PG8_SA(0, 1), cA + hstepA, voffA);
    if (wr == 1) PG8_BAR;
    PG8_WAIT_V(2); PG8_BAR;
    PG8_STAGE(PG8_SB(1, 0), cB + kstep, voffB); PG8_STAGE(PG8_SA(1, 0), cA + kstep, voffA); PG8_STAGE(PG8_SB(1, 1), cB + hstepB + kstep, voffB);
    PG8_WAIT_V(6); PG8_BAR;
    for (;;) {
        const bool has_next = S.next(ui + 1, nxt);
        const char* nA = uni(has_next ? (const char*)g.A + (size_t)nxt.pm * tstepA + (size_t)nxt.pn * pnA : cA); const char* nB = uni(has_next ? (const char*)g.Bt + (size_t)nxt.pn * tstepB : cB);
#pragma unroll 1
        for (int t = 0; t < nt; t += 2) {
            const bool last = (t == nt - 2);
            const char* a1 = cA + (size_t)(t + 1) * kstep;
            const char* a2 = last ? nA : cA + (size_t)(t + 2) * kstep; const char* b2 = last ? nB : cB + (size_t)(t + 2) * kstep;
            const char* a3 = a2 + kstep; const char* b3 = b2 + kstep;
            const bool relax = (Epi::NSTORES > 0) && (t == 0) && (ui > 0) && !rs_loaded;
            PG8_LDB(B0, 0, 0); PG8_LDB(B1, 0, 1); PG8_SCHED; PG8_LDA(At, 0, 0); PG8_STAGE(PG8_SA(1, 1), a1 + hstepA, voffA);
            if (relax) { if constexpr (Epi::NSTORES == 8) PG8_WAIT_V(16); else PG8_WAIT_V(24); } else PG8_WAIT_V(8);
            PG8_WAIT_L(0); PG8_BAR; PG8_MMA(0, 0, At, B0); PG8_MMA(0, 1, At, B1); PG8_BAR; PG8_SCHED;
            PG8_LDA(At, 0, 1); PG8_STAGE(PG8_SB(0, 0), b2, voffB); PG8_STAGE(PG8_SB(0, 1), b2 + hstepB, voffB); PG8_STAGE(PG8_SA(0, 0), a2, voffA);
            if (relax) { if constexpr (Epi::NSTORES == 8) PG8_WAIT_V(16); else PG8_WAIT_V(24); } else PG8_WAIT_V(8);
            PG8_WAIT_L(0); PG8_BAR; PG8_MMA(1, 0, At, B0); PG8_MMA(1, 1, At, B1); PG8_BAR; PG8_SCHED;
            PG8_LDB(B0, 1, 0); PG8_LDB(B1, 1, 1); PG8_SCHED; PG8_LDA(At, 1, 0); PG8_STAGE(PG8_SA(0, 1), a2 + hstepA, voffA);
            PG8_WAIT_V(8); PG8_WAIT_L(0); PG8_BAR; PG8_MMA(0, 0, At, B0); PG8_MMA(0, 1, At, B1); PG8_BAR; PG8_SCHED;
            PG8_LDA(At, 1, 1); PG8_STAGE(PG8_SB(1, 0), b3, voffB); PG8_STAGE(PG8_SB(1, 1), b3 + hstepB, voffB); PG8_STAGE(PG8_SA(1, 0), a3, voffA);
            PG8_WAIT_V(8); PG8_WAIT_L(0); PG8_BAR; PG8_MMA(1, 0, At, B0); PG8_MMA(1, 1, At, B1); PG8_BAR; PG8_SCHED;
        }
        if (wr == 0) PG8_BAR;
        E(acc, cur, wr, wc, fr, fq, rs_lds + rsbuf * 256, bias_lds);
        if (!has_next) break;
#pragma unroll
        for (int a = 0; a < 2; ++a)
#pragma unroll
            for (int b = 0; b < 2; ++b)
#pragma unroll
                for (int m = 0; m < 4; ++m)
#pragma unroll
                    for (int n = 0; n < 2; ++n) acc[a][b][m][n] = (f32x4){0.f, 0.f, 0.f, 0.f};
        cur = nxt; cA = nA; cB = nB; ++ui;
        PG8_RS_PREP(cur);
        if (wr == 1) PG8_BAR;
    }
    PG8_WAIT_V(0);
    PG8_BAR;
#undef PG8_RS_PREP
#undef PG8_SA
#undef PG8_SB
#undef PG8_STAGE
#undef PG8_LDA
#undef PG8_LDB
#undef PG8_MMA
#undef PG8_WAIT_V
#undef PG8_WAIT_L
#undef PG8_BAR
#undef PG8_SCHED
}

__device__ __forceinline__ u32x4 pack8(const f32x4 v0, const f32x4 v1) { u32x4 w; w.x = cvt_pk_bf16(v0[0], v0[1]); w.y = cvt_pk_bf16(v0[2], v0[3]); w.z = cvt_pk_bf16(v1[0], v1[1]); w.w = cvt_pk_bf16(v1[2], v1[3]); return w; }

__device__ __forceinline__ float row_scale(const float* ssq, int row) { return __builtin_amdgcn_rsqf(ssq[row] * (1.0f / D) + EPS); }
struct EpiSwiglu {
    static constexpr bool ROWSCALE = true; static constexpr int NBIAS = 0, NSTORES = 8;
    bf16_t* O; const float* ssq;
    __device__ __forceinline__ void operator()(const Acc& acc, const Unit& u, int wr, int wc, int fr, int fq, const LAS float* rsl, const LAS float* bl) const {
        const int row0 = u.pm * BM + wr * 64 + fr, col0 = u.pn * HALF + wc * 32 + 8 * fq;
        float rs[2][4];
#pragma unroll
        for (int ai = 0; ai < 2; ++ai)
#pragma unroll
            for (int m = 0; m < 4; ++m) rs[ai][m] = rsl[ai * HALF + wr * 64 + m * 16 + fr];
#pragma unroll
        for (int ai = 0; ai < 2; ++ai)
#pragma unroll
            for (int m = 0; m < 4; ++m) {
                f32x4 v[2];
#pragma unroll
                for (int n = 0; n < 2; ++n) { const f32x4 gt = acc[ai][0][m][n] * rs[ai][m], up = acc[ai][1][m][n] * rs[ai][m];
#pragma unroll
                    for (int j = 0; j < 4; ++j) v[n][j] = gt[j] * sigmoid_f(gt[j]) * up[j]; }
                *(u32x4*)(O + (size_t)(row0 + ai * HALF + m * 16) * FF + col0) = pack8(v[0], v[1]);
            }
    }
};
struct EpiH {
    static constexpr bool ROWSCALE = false; static constexpr int NBIAS = 0, NSTORES = 16;
    bf16_t* C; const float* ssq;
    __device__ __forceinline__ void operator()(const Acc& acc, const Unit& u, int wr, int wc, int fr, int fq, const LAS float* rsl, const LAS float* bl) const {
        const int row0 = u.pm * BM + wr * 64 + fr, col0 = u.pn * BM + wc * 32 + 8 * fq;
#pragma unroll
        for (int ai = 0; ai < 2; ++ai)
#pragma unroll
            for (int m = 0; m < 4; ++m) { bf16_t* rowp = C + (size_t)(row0 + ai * HALF + m * 16) * D + col0;
#pragma unroll
                for (int bj = 0; bj < 2; ++bj) *(u32x4*)(rowp + bj * HALF) = pack8(acc[ai][bj][m][0], acc[ai][bj][m][1]); }
    }
};
__device__ __forceinline__ void unpack8v(const u32x4 q, f32x4& a, f32x4& b) { a = (f32x4){bf_lo(q.x), bf_hi(q.x), bf_lo(q.y), bf_hi(q.y)}; b = (f32x4){bf_lo(q.z), bf_hi(q.z), bf_lo(q.w), bf_hi(q.w)}; }
template <bool FINAL> struct EpiResid {
    static constexpr bool ROWSCALE = false; static constexpr int NBIAS = 0, NSTORES = 0;
    bf16_t* Xb; const float* post; float cs; float* ssq4; float* outp; float* xbuf; unsigned* cnt; const float* ssq;
    __device__ __forceinline__ void operator()(const Acc& acc, const Unit& u, int wr, int wc, int fr, int fq, const LAS float* rsl, const LAS float* bl) const {
        LAS float* P = (LAS float*)bl; LAS float* S = P + 1024;
        float* const outf = FINAL ? outp : nullptr;
        const int lane = fr + 16 * fq, wave = wr * 4 + wc, tid = wave * 64 + lane;
#pragma unroll
        for (int ai = 0; ai < 2; ++ai)
#pragma unroll
            for (int m = 0; m < 4; ++m) { float q = 0.f;
#pragma unroll
                for (int bj = 0; bj < 2; ++bj)
#pragma unroll
                    for (int n = 0; n < 2; ++n) { const f32x4 x = acc[ai][bj][m][n]; q += (x[0] * x[0] + x[1] * x[1]) + (x[2] * x[2] + x[3] * x[3]); }
                q += __builtin_bit_cast(float, __builtin_amdgcn_ds_bpermute((lane ^ 16) << 2, __builtin_bit_cast(int, q)));
                q += __builtin_bit_cast(float, __builtin_amdgcn_ds_bpermute((lane ^ 32) << 2, __builtin_bit_cast(int, q)));
                if (fq == 0) P[(ai * HALF + wr * 64 + m * 16 + fr) * 4 + wc] = q; }
        asm volatile("s_waitcnt lgkmcnt(0)" ::: "memory"); __builtin_amdgcn_s_barrier(); asm volatile("" ::: "memory");
        float* slot = xbuf + ((size_t)u.pm * BM) * 4 + u.pn;
        if (tid < 256) { const float t4 = (P[tid * 4 + 0] + P[tid * 4 + 1]) + (P[tid * 4 + 2] + P[tid * 4 + 3]);
            __hip_atomic_store(slot + tid * 4, t4, __ATOMIC_RELAXED, __HIP_MEMORY_SCOPE_AGENT); }
        asm volatile("s_waitcnt vmcnt(0)" ::: "memory");
        unsigned* c = cnt + u.pm * 16;
        if (tid < 256 && lane == 0) __hip_atomic_fetch_add(c, 1u, __ATOMIC_RELAXED, __HIP_MEMORY_SCOPE_AGENT);
        if (wave == 0) { unsigned n = 0;
            while ((unsigned)__builtin_amdgcn_readfirstlane(__hip_atomic_load(c, __ATOMIC_RELAXED, __HIP_MEMORY_SCOPE_AGENT)) < 16u) { __builtin_amdgcn_s_sleep(1); if (++n > (1u << 22)) break; }
            __builtin_amdgcn_fence(__ATOMIC_ACQUIRE, "agent"); asm volatile("s_waitcnt vmcnt(0)" ::: "memory"); }
        asm volatile("s_waitcnt vmcnt(0) lgkmcnt(0)" ::: "memory"); __builtin_amdgcn_s_barrier(); asm volatile("" ::: "memory");
        if (tid < 256) { const float* sl = xbuf + ((size_t)u.pm * BM + tid) * 4; float t4 = 0.f;
#pragma unroll
            for (int k = 0; k < 4; ++k) t4 += __hip_atomic_load(sl + k, __ATOMIC_RELAXED, __HIP_MEMORY_SCOPE_AGENT);
            S[tid] = 1.0f / sqrtf(t4 * (1.0f / 1024.0f) + 1e-6f); }
        asm volatile("s_waitcnt vmcnt(0) lgkmcnt(0)" ::: "memory"); __builtin_amdgcn_s_barrier(); asm volatile("" ::: "memory");
        const int row0 = u.pm * BM + wr * 64 + fr, col0 = u.pn * BM + wc * 32 + 8 * fq;
        f32x4 pv[2][2];
#pragma unroll
        for (int bj = 0; bj < 2; ++bj)
#pragma unroll
            for (int n = 0; n < 2; ++n) pv[bj][n] = *(const f32x4*)(post + col0 + bj * HALF + 4 * n) * cs;
#pragma unroll
        for (int ai = 0; ai < 2; ++ai)
#pragma unroll
          for (int mh = 0; mh < 2; ++mh) {
            u32x4 xq[4][2];
#pragma unroll
            for (int m = 2 * mh; m < 2 * mh + 2; ++m)
#pragma unroll
                for (int bj = 0; bj < 2; ++bj) xq[m][bj] = *(const u32x4*)(Xb + (size_t)(row0 + ai * HALF + m * 16) * D + col0 + bj * HALF);
#pragma unroll
            for (int m = 2 * mh; m < 2 * mh + 2; ++m) { const int rl = ai * HALF + wr * 64 + m * 16 + fr; const float r1 = S[rl]; float q2 = 0.f;
#pragma unroll
                for (int bj = 0; bj < 2; ++bj) { f32x4 x0, x1; unpack8v(xq[m][bj], x0, x1);
                    x0 = x0 + acc[ai][bj][m][0] * r1 * pv[bj][0]; x1 = x1 + acc[ai][bj][m][1] * r1 * pv[bj][1];
                    if constexpr (FINAL) { float* o = outf + (size_t)(row0 + ai * HALF + m * 16) * D + col0 + bj * HALF; *(f32x4*)o = x0; *(f32x4*)(o + 4) = x1; }
                    else { const u32x4 w = pack8(x0, x1); *(u32x4*)(Xb + (size_t)(row0 + ai * HALF + m * 16) * D + col0 + bj * HALF) = w;
                        f32x4 y0, y1; unpack8v(w, y0, y1); q2 += ((y0[0] * y0[0] + y0[1] * y0[1]) + (y0[2] * y0[2] + y0[3] * y0[3])) + ((y1[0] * y1[0] + y1[1] * y1[1]) + (y1[2] * y1[2] + y1[3] * y1[3])); } }
                if constexpr (!FINAL) { q2 += __builtin_bit_cast(float, __builtin_amdgcn_ds_bpermute((lane ^ 16) << 2, __builtin_bit_cast(int, q2)));
                    q2 += __builtin_bit_cast(float, __builtin_amdgcn_ds_bpermute((lane ^ 32) << 2, __builtin_bit_cast(int, q2)));
                    if (fq == 0) P[rl * 4 + wc] = q2; } }
        }
        if constexpr (!FINAL) {
            asm volatile("s_waitcnt lgkmcnt(0)" ::: "memory"); __builtin_amdgcn_s_barrier(); asm volatile("" ::: "memory");
            if (tid < 256) ssq4[((size_t)u.pm * BM + tid) * 4 + u.pn] = (P[tid * 4 + 0] + P[tid * 4 + 1]) + (P[tid * 4 + 2] + P[tid * 4 + 3]);
        }
        asm volatile("s_waitcnt lgkmcnt(0)" ::: "memory"); __builtin_amdgcn_s_barrier(); asm volatile("" ::: "memory");
    }
};
struct EpiWin {
    static constexpr bool ROWSCALE = true; static constexpr int NBIAS = 2048, NSTORES = 8;
    bf16_t *ZB, *ZCV, *ZP, *ZG; const float* bgate; const float* ssq;
    __device__ __forceinline__ float bias_src(int i) const { return bgate[i]; }
    __device__ __forceinline__ void operator()(const Acc& acc, const Unit& u, int wr, int wc, int fr, int fq, const LAS float* rsl, const LAS float* bl) const {
        const int row0 = u.pm * BM + wr * 64 + fr, pn = u.pn, cw = wc * 32 + 8 * fq;
        float rs[2][4];
#pragma unroll
        for (int ai = 0; ai < 2; ++ai)
#pragma unroll
            for (int m = 0; m < 4; ++m) rs[ai][m] = rsl[ai * HALF + wr * 64 + m * 16 + fr];
        if (pn >= 4 && pn < 12) {
            const int col0 = (pn - 4) * HALF + cw;
#pragma unroll
            for (int ai = 0; ai < 2; ++ai)
#pragma unroll
                for (int m = 0; m < 4; ++m) { const float r2 = rs[ai][m] * rs[ai][m];
                    *(u32x4*)(ZCV + (size_t)(row0 + ai * HALF + m * 16) * D + col0) = pack8(acc[ai][0][m][0] * acc[ai][1][m][0] * r2, acc[ai][0][m][1] * acc[ai][1][m][1] * r2); }
        } else if (pn < 16) {
            bf16_t* base = pn < 4 ? ZB : ZP; const int col0 = (pn < 4 ? pn : pn - 12) * BM + cw;
#pragma unroll
            for (int ai = 0; ai < 2; ++ai)
#pragma unroll
                for (int m = 0; m < 4; ++m) { bf16_t* rowp = base + (size_t)(row0 + ai * HALF + m * 16) * D + col0;
#pragma unroll
                    for (int bj = 0; bj < 2; ++bj) *(u32x4*)(rowp + bj * HALF) = pack8(acc[ai][bj][m][0] * rs[ai][m], acc[ai][bj][m][1] * rs[ai][m]); }
        } else {
            const int col0 = (pn - 16) * BM + cw;
            f32x4 bv[2][2];
#pragma unroll
            for (int bj = 0; bj < 2; ++bj)
#pragma unroll
                for (int n = 0; n < 2; ++n) bv[bj][n] = *(const LAS f32x4*)(bl + col0 + bj * HALF + 4 * n);
#pragma unroll
            for (int ai = 0; ai < 2; ++ai)
#pragma unroll
                for (int m = 0; m < 4; ++m) { bf16_t* rowp = ZG + (size_t)(row0 + ai * HALF + m * 16) * 2048 + col0;
#pragma unroll
                    for (int bj = 0; bj < 2; ++bj) { f32x4 v[2];
#pragma unroll
                        for (int n = 0; n < 2; ++n) { const f32x4 a = acc[ai][bj][m][n] * rs[ai][m] + bv[bj][n];
#pragma unroll
                            for (int j = 0; j < 4; ++j) v[n][j] = sigmoid_f(a[j]); }
                        *(u32x4*)(rowp + bj * HALF) = pack8(v[0], v[1]); } }
        }
    }
};
struct EpiPoolGroup {
    static constexpr bool ROWSCALE = false; static constexpr int NBIAS = 2048, NSTORES = 16;
    bf16_t* O; const float* bias; const float* scale; const float* ssq;
    __device__ __forceinline__ float bias_src(int i) const { return i < 1024 ? bias[i] : scale[i - 1024]; }
    __device__ __forceinline__ void operator()(const Acc& acc, const Unit& u, int wr, int wc, int fr, int fq, const LAS float* rsl, const LAS float* bl) const {
        const int row0 = u.pm * BM + wr * 64 + fr, col0 = u.pn * BM + wc * 32 + 8 * fq;
        f32x4 bv[2][2], sv[2][2];
#pragma unroll
        for (int bj = 0; bj < 2; ++bj)
#pragma unroll
            for (int n = 0; n < 2; ++n) { bv[bj][n] = *(const LAS f32x4*)(bl + col0 + bj * HALF + 4 * n); sv[bj][n] = *(const LAS f32x4*)(bl + 1024 + col0 + bj * HALF + 4 * n); }
#pragma unroll
        for (int ai = 0; ai < 2; ++ai)
#pragma unroll
            for (int m = 0; m < 4; ++m) { bf16_t* rowp = O + (size_t)(row0 + ai * HALF + m * 16) * D + col0;
#pragma unroll
                for (int bj = 0; bj < 2; ++bj) *(u32x4*)(rowp + bj * HALF) = pack8((acc[ai][bj][m][0] + bv[bj][0]) * sv[bj][0], (acc[ai][bj][m][1] + bv[bj][1]) * sv[bj][1]); }
    }
};
struct EpiGateA {
    static constexpr bool ROWSCALE = false; static constexpr int NBIAS = 0, NSTORES = 16;
    const bf16_t* ZG; bf16_t* M1; const float* ssq;
    __device__ __forceinline__ void operator()(const Acc& acc, const Unit& u, int wr, int wc, int fr, int fq, const LAS float* rsl, const LAS float* bl) const {
        const int row0 = u.pm * BM + wr * 64 + fr, col0 = u.pn * BM + wc * 32 + 8 * fq;
#pragma unroll
        for (int ai = 0; ai < 2; ++ai) {
            u32x4 gq[4][2];
#pragma unroll
            for (int m = 0; m < 4; ++m)
#pragma unroll
                for (int bj = 0; bj < 2; ++bj) gq[m][bj] = *(const u32x4*)(ZG + (size_t)(row0 + ai * HALF + m * 16) * 2048 + col0 + bj * HALF);
#pragma unroll
            for (int m = 0; m < 4; ++m)
#pragma unroll
                for (int bj = 0; bj < 2; ++bj) { f32x4 g0, g1; unpack8v(gq[m][bj], g0, g1);
                    *(u32x4*)(M1 + (size_t)(row0 + ai * HALF + m * 16) * D + col0 + bj * HALF) = pack8(g0 * acc[ai][bj][m][0], g1 * acc[ai][bj][m][1]); }
        }
    }
};
struct EpiGateP {
    static constexpr bool ROWSCALE = false; static constexpr int NBIAS = 0, NSTORES = 16;
    const bf16_t* ZG; const bf16_t* M1; bf16_t* MM; const float* ssq;
    __device__ __forceinline__ void operator()(const Acc& acc, const Unit& u, int wr, int wc, int fr, int fq, const LAS float* rsl, const LAS float* bl) const {
        const int row0 = u.pm * BM + wr * 64 + fr, col0 = u.pn * BM + wc * 32 + 8 * fq;
#pragma unroll
        for (int ai = 0; ai < 2; ++ai) {
            u32x4 gq[4][2], mq[4][2];
#pragma unroll
            for (int m = 0; m < 4; ++m)
#pragma unroll
                for (int bj = 0; bj < 2; ++bj) { const size_t r = (size_t)(row0 + ai * HALF + m * 16);
                    gq[m][bj] = *(const u32x4*)(ZG + r * 2048 + D + col0 + bj * HALF); mq[m][bj] = *(const u32x4*)(M1 + r * D + col0 + bj * HALF); }
#pragma unroll
            for (int m = 0; m < 4; ++m)
#pragma unroll
                for (int bj = 0; bj < 2; ++bj) { f32x4 g0, g1, m0, m1; unpack8v(gq[m][bj], g0, g1); unpack8v(mq[m][bj], m0, m1);
                    *(u32x4*)(MM + (size_t)(row0 + ai * HALF + m * 16) * D + col0 + bj * HALF) = pack8(m0 + g0 * acc[ai][bj][m][0], m1 + g1 * acc[ai][bj][m][1]); }
        }
    }
};
}


#define XB_TMO      128
#define XB_XCNT(j)  (256  + 64 * (j))
#define XB_XSUB(j)  (1280 + 64 * (j))
#define XB_XGEN(j)  (2304 + 64 * (j))
#define XB_TOP      3328
#define XB_TOPGEN   3392
#define XCD_BAR_WORDS 3456
#define XB_SPIN_CAP (1u << 18)

__device__ __forceinline__ unsigned xb_ld(unsigned* p)              { return __hip_atomic_load(p, __ATOMIC_RELAXED, __HIP_MEMORY_SCOPE_AGENT); }
__device__ __forceinline__ unsigned xb_add(unsigned* p, unsigned v) { return __hip_atomic_fetch_add(p, v, __ATOMIC_RELAXED, __HIP_MEMORY_SCOPE_AGENT); }
__device__ __forceinline__ unsigned xb_xcc_id() { return (unsigned)__builtin_amdgcn_s_getreg((3 << 11) | 20) & 0xFu; }
#define XB_SPIN(cond, bar) do { unsigned _sp = 0; while (cond) { __builtin_amdgcn_s_sleep(1); \
    if ((++_sp & 255u) == 0u) { if (xb_ld(&(bar)[XB_TMO])) break; if (_sp > XB_SPIN_CAP) { atomicAdd(&(bar)[XB_TMO], 1u); break; } } } } while (0)

__device__ __forceinline__ bool xb_is_thread0(int wave) { int t; asm volatile("v_mbcnt_lo_u32_b32 %0, -1, 0\n\tv_mbcnt_hi_u32_b32 %0, -1, %0" : "=v"(t)); return t == 0 && wave == 0; }
struct XcdBarrier {
    unsigned* bar; unsigned x;
    volatile LAS unsigned* st;
};

__device__ __forceinline__ XcdBarrier xcd_barrier_post(unsigned* bar, volatile LAS unsigned* st) {
    XcdBarrier b; b.bar = bar; b.x = xb_xcc_id(); b.st = st;
    if (threadIdx.x == 0) (void)xb_add(&bar[XB_XCNT(b.x)], 1u);
    return b;
}
__device__ __forceinline__ void xcd_barrier_complete(unsigned* bar, unsigned x, unsigned& nloc, unsigned& nx) {
    const unsigned G = gridDim.x * gridDim.y * gridDim.z;
    unsigned sum, cnt, mine, sp = 0u;
    for (;;) {
        sum = 0u; cnt = 0u; mine = 0u;
#pragma unroll
        for (unsigned j = 0; j < 16; ++j) { const unsigned c = xb_ld(&bar[XB_XCNT(j)]); sum += c; cnt += (c > 0u) ? 1u : 0u; mine = (j == x) ? c : mine; }
        if (sum == G) break;
        __builtin_amdgcn_s_sleep(1);
        if ((++sp & 255u) == 0u) { if (xb_ld(&bar[XB_TMO])) break; if (sp > XB_SPIN_CAP) { atomicAdd(&bar[XB_TMO], 1u); break; } }
    }
    nloc = mine > 0u ? mine : 1u; nx = cnt > 0u ? cnt : 1u;
}

__device__ __forceinline__ void xcd_barrier(const XcdBarrier& b, int wave) {
    asm volatile("s_waitcnt vmcnt(0)" ::: "memory");
    __syncthreads();
    if (xb_is_thread0(wave)) {
        unsigned* bar = b.bar;
        __builtin_amdgcn_s_waitcnt(0);
        unsigned nloc = b.st[0], nx = b.st[1];
        if (nloc == 0u) { xcd_barrier_complete(bar, b.x, nloc, nx); b.st[0] = nloc; b.st[1] = nx; }
        const unsigned old = xb_add(&bar[XB_XSUB(b.x)], 1u);
        const unsigned gen = old / nloc;
        if (old + 1u == (gen + 1u) * nloc) {
            __builtin_amdgcn_fence(__ATOMIC_RELEASE, "agent");
            asm volatile("s_waitcnt vmcnt(0)" ::: "memory");
            const unsigned og = xb_add(&bar[XB_TOP], 1u);
            const unsigned tg = og / nx;
            if (og + 1u == (tg + 1u) * nx) xb_add(&bar[XB_TOPGEN], 1u);
            else XB_SPIN(xb_ld(&bar[XB_TOPGEN]) == tg, bar);
            __builtin_amdgcn_fence(__ATOMIC_ACQUIRE, "agent");
            xb_add(&bar[XB_XGEN(b.x)], 1u);
            asm volatile("s_waitcnt vmcnt(0)" ::: "memory");
        } else {
            XB_SPIN(xb_ld(&bar[XB_XGEN(b.x)]) == gen, bar);
            __builtin_amdgcn_fence(__ATOMIC_ACQUIRE, "agent");
            asm volatile("s_waitcnt vmcnt(0)" ::: "memory");
        }
    }
    __syncthreads();
}

struct Args { const float* in[20]; float* out; unsigned char* ws; int ph_lo, ph_hi; };
struct Ctx { LAS unsigned char* lds; int lane, wave, gw, NGW, G, bid; };

__device__ __forceinline__ void transpose_item(const float* W, int ldsrc, int K, int src_col0, bf16_t* WT, int dst_row0, int k0, const float* kscale, LAS float* scr, int lane) {
    {
        const int kr = lane >> 3, n4 = (lane & 7) * 4; f32x4 v[8];
#pragma unroll
        for (int i = 0; i < 8; ++i) v[i] = *(const f32x4*)(W + (size_t)(k0 + 8 * i + kr) * ldsrc + src_col0 + n4);
#pragma unroll
        for (int i = 0; i < 8; ++i) { const int kk = 8 * i + kr; const float sc = kscale ? kscale[k0 + kk] : 1.0f; LAS float* d = scr + kk * 33 + n4;
            d[0] = v[i].x * sc; d[1] = v[i].y * sc; d[2] = v[i].z * sc; d[3] = v[i].w * sc; }
    }
    LDS_WAIT(); asm volatile("" ::: "memory");
    const int c = lane & 7;
#pragma unroll
    for (int j = 0; j < 4; ++j) { const int n = (lane >> 3) + 8 * j; const LAS float* sp = scr + (8 * c) * 33 + n;
        u32x4 o; o.x = cvt_pk_bf16(sp[0 * 33], sp[1 * 33]); o.y = cvt_pk_bf16(sp[2 * 33], sp[3 * 33]); o.z = cvt_pk_bf16(sp[4 * 33], sp[5 * 33]); o.w = cvt_pk_bf16(sp[6 * 33], sp[7 * 33]);
        *(u32x4*)(WT + (size_t)(dst_row0 + n) * K + k0 + 8 * c) = o; }
    LDS_WAIT(); asm volatile("" ::: "memory");
}
__device__ __forceinline__ int map_gu(int n) { return ((n >> 7) & 1) * FF + (n >> 8) * 128 + (n & 127); }
__device__ __forceinline__ int map_in(int n) { if (n < 1024 || n >= 3072) return n; const int q = (n - 1024) >> 8, h = (n >> 7) & 1; return (h ? 2048 : 1024) + q * 128 + (n & 127); }

__device__ __forceinline__ void prep_weights(const Ctx& F, const Args& a, unsigned char* ws, int l) {
    LAS float* scr = (LAS float*)(F.lds + F.wave * 16384);
    constexpr int I_GU = (D / 64) * (NGU / 32), I_D = (FF / 64) * (D / 32), I_IN = (D / 64) * (NIN / 32), I_SQ = (D / 64) * (D / 32), I_PG = 4 * (256 / 64) * (256 / 32);
    constexpr int NITEMS = 2 * I_GU + 2 * I_D + I_IN + 3 * I_SQ + I_PG;
    for (int it = F.gw; it < NITEMS; it += F.NGW) {
        int r = it;
        if (r < 2 * I_GU) { const int w = r / I_GU; r -= w * I_GU; const int kb = r / (NGU / 32), nb = r % (NGU / 32);
            transpose_item(a.in[w ? 18 : 3] + (size_t)l * D * NGU, NGU, D, map_gu(32 * nb), (bf16_t*)(ws + (w ? W_GU2 : W_GU1)), 32 * nb, 64 * kb, a.in[w ? 16 : 1] + l * D, scr, F.lane); continue; }
        r -= 2 * I_GU;
        if (r < 2 * I_D) { const int w = r / I_D; r -= w * I_D; const int kb = r / (D / 32), nb = r % (D / 32);
            transpose_item(a.in[w ? 19 : 4] + (size_t)l * FF * D, D, FF, 32 * nb, (bf16_t*)(ws + (w ? W_D2 : W_D1)), 32 * nb, 64 * kb, nullptr, scr, F.lane); continue; }
        r -= 2 * I_D;
        if (r < I_IN) { const int kb = r / (NIN / 32), nb = r % (NIN / 32);
            transpose_item(a.in[7] + (size_t)l * D * NIN, NIN, D, map_in(32 * nb), (bf16_t*)(ws + W_IN), 32 * nb, 64 * kb, a.in[5] + l * D, scr, F.lane); continue; }
        r -= I_IN;
        if (r < 3 * I_SQ) { const int w = r / I_SQ; r -= w * I_SQ; const int kb = r / (D / 32), nb = r % (D / 32);
            transpose_item(a.in[w == 0 ? 10 : (w == 1 ? 14 : 15)] + (size_t)l * D * D, D, D, 32 * nb, (bf16_t*)(ws + (w == 0 ? W_CO : (w == 1 ? W_PO : W_WO))), 32 * nb, 64 * kb, nullptr, scr, F.lane); continue; }
        r -= 3 * I_SQ;
        { const int gi = r / 32; r -= gi * 32; const int kb = r / 8, nb = r % 8;
            transpose_item(a.in[11] + (size_t)l * 4 * 65536 + (size_t)gi * 65536, 256, 256, 32 * nb, (bf16_t*)(ws + W_PG), gi * 256 + 32 * nb, 64 * kb, nullptr, scr, F.lane); }
    }
}

__device__ __forceinline__ void cast_rows(const Ctx& F, const float* x, bf16_t* Xb, float* ssq) {
    for (int m = F.gw; m < M; m += F.NGW) {
        const f32x4* xr = (const f32x4*)(x + (size_t)m * D) + F.lane;
        f32x4 v[4]; float s = 0.f;
#pragma unroll
        for (int j = 0; j < 4; ++j) { v[j] = xr[64 * j]; s += (v[j].x * v[j].x + v[j].y * v[j].y) + (v[j].z * v[j].z + v[j].w * v[j].w); }
        s = wave_sum(s, F.lane);
        u32x2* o = (u32x2*)(Xb + (size_t)m * D) + F.lane;
#pragma unroll
        for (int j = 0; j < 4; ++j) { u32x2 w; w.x = cvt_pk_bf16(v[j].x, v[j].y); w.y = cvt_pk_bf16(v[j].z, v[j].w); o[64 * j] = w; }
        if (F.lane == 0) ((f32x4*)ssq)[m] = (f32x4){s, 0.f, 0.f, 0.f};
    }
}
__device__ __forceinline__ void resid_rows(const Ctx& F, bf16_t* Xb, const bf16_t* h, const float* post, float cs, float* ssq, float* outf) {
    f32x4 pv[4];
#pragma unroll
    for (int j = 0; j < 4; ++j) pv[j] = ((const f32x4*)post)[F.lane + 64 * j] * cs;
    for (int m0 = F.gw; m0 < M; m0 += 2 * F.NGW) {
        const int m1 = m0 + F.NGW; const bool two = m1 < M; const int mb = two ? m1 : m0;
        f32x4 hv[2][4], xv[2][4];
#pragma unroll
        for (int r = 0; r < 2; ++r) { const int m = r ? mb : m0;
            const u32x2* hr = (const u32x2*)(h + (size_t)m * D) + F.lane; const u32x2* xr = (const u32x2*)(Xb + (size_t)m * D) + F.lane;
#pragma unroll
            for (int j = 0; j < 4; ++j) { const u32x2 q = hr[64 * j]; hv[r][j] = (f32x4){bf_lo(q.x), bf_hi(q.x), bf_lo(q.y), bf_hi(q.y)};
                const u32x2 p = xr[64 * j]; xv[r][j] = (f32x4){bf_lo(p.x), bf_hi(p.x), bf_lo(p.y), bf_hi(p.y)}; } }
#pragma unroll
        for (int r = 0; r < 2; ++r) { const int m = r ? mb : m0; if (r && !two) break;
            float s = 0.f;
#pragma unroll
            for (int j = 0; j < 4; ++j) s += (hv[r][j].x * hv[r][j].x + hv[r][j].y * hv[r][j].y) + (hv[r][j].z * hv[r][j].z + hv[r][j].w * hv[r][j].w);
            const float r1 = 1.0f / sqrtf(wave_sum(s, F.lane) * (1.f / D) + EPS);
            if (outf) {
                f32x4* xo = (f32x4*)(outf + (size_t)m * D) + F.lane;
#pragma unroll
                for (int j = 0; j < 4; ++j) xo[64 * j] = xv[r][j] + hv[r][j] * r1 * pv[j];
            } else {
                float s2 = 0.f;
                u32x2* o = (u32x2*)(Xb + (size_t)m * D) + F.lane;
#pragma unroll
                for (int j = 0; j < 4; ++j) { const f32x4 xn = xv[r][j] + hv[r][j] * r1 * pv[j]; u32x2 w; w.x = cvt_pk_bf16(xn.x, xn.y); w.y = cvt_pk_bf16(xn.z, xn.w); o[64 * j] = w;
                    const f32x4 xr_ = {bf_lo(w.x), bf_hi(w.x), bf_lo(w.y), bf_hi(w.y)};
                    s2 += (xr_.x * xr_.x + xr_.y * xr_.y) + (xr_.z * xr_.z + xr_.w * xr_.w); }
                s2 = wave_sum(s2, F.lane);
                if (F.lane == 0) ssq[m] = s2;
            }
        }
    }
}
__device__ __forceinline__ void unpack8(const u32x4 q, float (&f)[8]) { f[0] = bf_lo(q.x); f[1] = bf_hi(q.x); f[2] = bf_lo(q.y); f[3] = bf_hi(q.y); f[4] = bf_lo(q.z); f[5] = bf_hi(q.z); f[6] = bf_lo(q.w); f[7] = bf_hi(q.w); }
__device__ __forceinline__ void mix_rows(const Ctx& F, bf16_t* ZBCA, const bf16_t* ZCV, const bf16_t* ZP, const float* convw, bf16_t* DDo) {
    const int half = F.gw & 1, c0 = half * 512 + F.lane * 8;
    const int npair = F.NGW >> 1, tpw = M / npair, t0 = (F.gw >> 1) * tpw;
    float w0[8], w1[8], w2[8];
#pragma unroll
    for (int j = 0; j < 8; ++j) { w0[j] = convw[c0 + j]; w1[j] = convw[D + c0 + j]; w2[j] = convw[2 * D + c0 + j]; }
    const int win = 2 << (c0 >> 8), wmax = half ? 16 : 4;
    const u32x4 zero = {0u, 0u, 0u, 0u};
    const int s0 = t0 & (SEQ - 1);
    const size_t off0 = (size_t)t0 * D + c0;
    float acc[8], cm1[8], cm2[8];
#pragma unroll
    for (int j = 0; j < 8; ++j) acc[j] = 0.f;
    for (int k = 1; k < wmax; ++k) {
        const bool ok = (k < win) && (s0 >= k);
        const u32x4 q = ok ? *(const u32x4*)(ZP + off0 - (size_t)k * D) : zero;
        float f[8]; unpack8(q, f);
#pragma unroll
        for (int j = 0; j < 8; ++j) acc[j] += f[j];
    }
    { const u32x4 q1 = s0 >= 1 ? *(const u32x4*)(ZCV + off0 - D) : zero, q2 = s0 >= 2 ? *(const u32x4*)(ZCV + off0 - 2 * D) : zero; unpack8(q1, cm1); unpack8(q2, cm2); }
    for (int i = 0; i < tpw; i += 4) {
        u32x4 qb[4], qc[4], qp[4], qo[4];
#pragma unroll
        for (int u = 0; u < 4; ++u) { const size_t off = off0 + (size_t)(i + u) * D; const int s = s0 + i + u;
            qb[u] = *(const u32x4*)(ZBCA + off); qc[u] = *(const u32x4*)(ZCV + off); qp[u] = *(const u32x4*)(ZP + off);
            qo[u] = (s >= win - 1) ? *(const u32x4*)(ZP + off - (size_t)(win - 1) * D) : zero; }
#pragma unroll
        for (int u = 0; u < 4; ++u) { const size_t off = off0 + (size_t)(i + u) * D; const int s = s0 + i + u;
            float fb[8], fc[8], fp[8], fo[8], ca[8], dd[8];
            unpack8(qb[u], fb); unpack8(qc[u], fc); unpack8(qp[u], fp); unpack8(qo[u], fo);
            const float inv = 1.0f / (float)((s + 1) < win ? (s + 1) : win);
#pragma unroll
            for (int j = 0; j < 8; ++j) { ca[j] = fb[j] * (w0[j] * cm2[j] + w1[j] * cm1[j] + w2[j] * fc[j]); cm2[j] = cm1[j]; cm1[j] = fc[j];
                const float st = acc[j] + fp[j]; dd[j] = st * inv - fp[j]; acc[j] = st - fo[j]; }
            u32x4 o1, o2;
            o1.x = cvt_pk_bf16(ca[0], ca[1]); o1.y = cvt_pk_bf16(ca[2], ca[3]); o1.z = cvt_pk_bf16(ca[4], ca[5]); o1.w = cvt_pk_bf16(ca[6], ca[7]);
            o2.x = cvt_pk_bf16(dd[0], dd[1]); o2.y = cvt_pk_bf16(dd[2], dd[3]); o2.z = cvt_pk_bf16(dd[4], dd[5]); o2.w = cvt_pk_bf16(dd[6], dd[7]);
            *(u32x4*)(ZBCA + off) = o1; *(u32x4*)(DDo + off) = o2; }
    }
}

__device__ __forceinline__ bool launder(Ctx& F, unsigned char*& ws, int& tidv) { int t; asm volatile("v_mbcnt_lo_u32_b32 %0, -1, 0\n\tv_mbcnt_hi_u32_b32 %0, -1, %0" : "=v"(t)); F.lane = t; tidv = F.wave * 64 + t; { int g = F.gw, b = blockIdx.x; asm volatile("" : "+s"(g), "+s"(b)); F.gw = g; F.bid = b; }
    const unsigned long long w0 = (unsigned long long)ws; unsigned wl = __builtin_amdgcn_readfirstlane((unsigned)w0), wh = __builtin_amdgcn_readfirstlane((unsigned)(w0 >> 32)); asm volatile("" : "+s"(wl), "+s"(wh));
    const unsigned long long w = ((unsigned long long)wh << 32) | wl; ws = (unsigned char*)(__attribute__((address_space(1))) unsigned char*)w; return true; }
constexpr int PH_PER_LAYER = 10, N_PHASES = 1 + DEPTH * PH_PER_LAYER;

__global__ void __launch_bounds__(512, 2) mega_fwd(Args a) {
    extern __shared__ __attribute__((aligned(16))) unsigned char lds_raw[];
    Ctx F; F.lds = (LAS unsigned char*)lds_raw; F.lane = threadIdx.x & 63; F.wave = __builtin_amdgcn_readfirstlane(threadIdx.x >> 6);
    F.G = gridDim.x; F.gw = blockIdx.x * 8 + F.wave; F.NGW = F.G * 8; F.bid = blockIdx.x;
    unsigned char* ws = a.ws; int tidv = threadIdx.x;
    const int lo = a.ph_lo, hi = a.ph_hi;
    volatile LAS unsigned* MISC = (volatile LAS unsigned*)(F.lds + MISC_OFF);
    if (threadIdx.x < 32) MISC[threadIdx.x] = 0u;
    __syncthreads();
    XcdBarrier bar; bar.bar = (unsigned*)(ws + WS_BAR); bar.x = 0; bar.st = nullptr;
    if (hi - lo > 1) bar = xcd_barrier_post((unsigned*)(ws + WS_BAR), MISC + 8);
    if (lo < 0) cg::this_grid().sync();
    int ph = 0;
#define IN_PH (lo <= ph && ph < hi && launder(F, ws, tidv))
#define SEAM() do { if (lo <= ph && ph + 1 < hi) { xcd_barrier(bar, F.wave); } ++ph; } while (0)
#define XB ((bf16_t*)(ws + WS_XB))
#define SSQ ((float*)(ws + WS_SSQ))
    if (IN_PH) { prep_weights(F, a, ws, 0); cast_rows(F, a.in[0], XB, SSQ); }
    SEAM();
    for (int l = 0; l < DEPTH; ++l) {
        const bool more = (l + 1 < DEPTH);
        if (IN_PH) { pg8::Gemm g{XB, (const bf16_t*)(ws + W_GU1), M, NGU, D, D, 0}; pg8::StaticOrder S; S.init(M, NGU, F.G, F.bid);
            pg8::EpiSwiglu E{(bf16_t*)(ws + WS_HH), SSQ}; pg8::gemm_phase(F.lds, g, S, E, tidv); }
        SEAM();
        if (IN_PH) { pg8::Gemm g{(const bf16_t*)(ws + WS_HH), (const bf16_t*)(ws + W_D1), M, D, FF, FF, 0}; pg8::StaticOrder S; S.init(M, D, F.G, F.bid);
            pg8::EpiResid<false> E{XB, a.in[2] + l * D, 0.5f, SSQ, nullptr, (float*)(ws + WS_XBUF), (unsigned*)(ws + WS_CNT) + (l * 3 + 0) * 128 * 16, nullptr}; pg8::gemm_phase(F.lds, g, S, E, tidv); }
        SEAM();
        if (IN_PH) { pg8::Gemm g{XB, (const bf16_t*)(ws + W_IN), M, NIN, D, D, 0}; pg8::StaticOrder S; S.init(M, NIN, F.G, F.bid);
            pg8::EpiWin E{(bf16_t*)(ws + WS_ZB), (bf16_t*)(ws + WS_ZCV), (bf16_t*)(ws + WS_ZP), (bf16_t*)(ws + WS_ZG), a.in[8] + l * 2 * D, SSQ}; pg8::gemm_phase(F.lds, g, S, E, tidv); }
        SEAM();
        if (IN_PH) mix_rows(F, (bf16_t*)(ws + WS_ZB), (const bf16_t*)(ws + WS_ZCV), (const bf16_t*)(ws + WS_ZP), a.in[9] + l * 3 * D, (bf16_t*)(ws + WS_DD));
        SEAM();
        if (IN_PH) { pg8::Gemm g{(const bf16_t*)(ws + WS_DD), (const bf16_t*)(ws + W_PG), M, D, 256, D, 256}; pg8::StaticOrder S; S.init(M, D, F.G, F.bid);
            pg8::EpiPoolGroup E{(bf16_t*)(ws + WS_YP0), a.in[12] + l * D, a.in[13] + l * D, nullptr}; pg8::gemm_phase(F.lds, g, S, E, tidv); }
        if (IN_PH) { pg8::Gemm g{(const bf16_t*)(ws + WS_CA), (const bf16_t*)(ws + W_CO), M, D, D, D, 0}; pg8::StaticOrder S; S.init(M, D, F.G, F.bid);
            pg8::EpiGateA E{(const bf16_t*)(ws + WS_ZG), (bf16_t*)(ws + WS_M1), nullptr}; pg8::gemm_phase(F.lds, g, S, E, tidv); }
        SEAM();
        if (IN_PH) { pg8::Gemm g{(const bf16_t*)(ws + WS_YP0), (const bf16_t*)(ws + W_PO), M, D, D, D, 0}; pg8::StaticOrder S; S.init(M, D, F.G, F.bid);
            pg8::EpiGateP E{(const bf16_t*)(ws + WS_ZG), (const bf16_t*)(ws + WS_M1), (bf16_t*)(ws + WS_MM), nullptr}; pg8::gemm_phase(F.lds, g, S, E, tidv); }
        SEAM();
        if (IN_PH) { pg8::Gemm g{(const bf16_t*)(ws + WS_MM), (const bf16_t*)(ws + W_WO), M, D, D, D, 0}; pg8::StaticOrder S; S.init(M, D, F.G, F.bid);
            pg8::EpiResid<false> E{XB, a.in[6] + l * D, 1.0f, SSQ, nullptr, (float*)(ws + WS_XBUF), (unsigned*)(ws + WS_CNT) + (l * 3 + 1) * 128 * 16, nullptr}; pg8::gemm_phase(F.lds, g, S, E, tidv); }
        SEAM();
        if (IN_PH) { pg8::Gemm g{XB, (const bf16_t*)(ws + W_GU2), M, NGU, D, D, 0}; pg8::StaticOrder S; S.init(M, NGU, F.G, F.bid);
            pg8::EpiSwiglu E{(bf16_t*)(ws + WS_HH), SSQ}; pg8::gemm_phase(F.lds, g, S, E, tidv); }
        SEAM();
        if (IN_PH) { pg8::Gemm g{(const bf16_t*)(ws + WS_HH), (const bf16_t*)(ws + W_D2), M, D, FF, FF, 0}; pg8::StaticOrder S; S.init(M, D, F.G, F.bid);
            if (more) { pg8::EpiResid<false> E{XB, a.in[17] + l * D, 0.5f, SSQ, nullptr, (float*)(ws + WS_XBUF), (unsigned*)(ws + WS_CNT) + (l * 3 + 2) * 128 * 16, nullptr}; pg8::gemm_phase(F.lds, g, S, E, tidv); }
            else { pg8::EpiResid<true> E{XB, a.in[17] + l * D, 0.5f, SSQ, a.out, (float*)(ws + WS_XBUF), (unsigned*)(ws + WS_CNT) + (l * 3 + 2) * 128 * 16, nullptr}; pg8::gemm_phase(F.lds, g, S, E, tidv); } }
        SEAM();
        if (IN_PH) { if (more) prep_weights(F, a, ws, l + 1); }
        SEAM();
    }
#undef IN_PH
#undef SEAM
}

extern "C" void kernel_launch(void* const* d_in, const int* in_sizes, int n_in, void* d_out, int out_size, void* d_ws, size_t ws_size, hipStream_t stream) {
    static int grid = 0;
    if (grid == 0) {
        if (n_in != 20 || in_sizes[0] != M * D || out_size != M * D || ws_size < WS_END) { fprintf(stderr, "kernel_launch: unexpected shapes (n_in %d, in0 %d, out %d, ws %zu < %zu)\n", n_in, n_in > 0 ? in_sizes[0] : -1, out_size, ws_size, (size_t)WS_END); grid = -1; return; }
        int dev = 0, cus = 0, per_cu = 0;
        (void)hipGetDevice(&dev); (void)hipDeviceGetAttribute(&cus, hipDeviceAttributeMultiprocessorCount, dev);
        if (hipFuncSetAttribute((const void*)mega_fwd, hipFuncAttributeMaxDynamicSharedMemorySize, LDS_BYTES) != hipSuccess) { fprintf(stderr, "kernel_launch: hipFuncSetAttribute failed\n"); grid = -1; return; }
        if (hipOccupancyMaxActiveBlocksPerMultiprocessor(&per_cu, (const void*)mega_fwd, 512, LDS_BYTES) != hipSuccess || per_cu < 1) { fprintf(stderr, "kernel_launch: occupancy query says %d\n", per_cu); per_cu = 1; (void)hipGetLastError(); }
        grid = cus * per_cu;
    }
    if (grid < 0) return;
    Args a{};
    for (int i = 0; i < 20; ++i) a.in[i] = (const float*)d_in[i];
    a.out = (float*)d_out; a.ws = (unsigned char*)d_ws;
#if MK_ONE_LAUNCH
    if (hipMemsetAsync((char*)d_ws, 0, CTL_ZERO_BYTES, stream) != hipSuccess) { fprintf(stderr, "kernel_launch: memset failed\n"); return; }
    a.ph_lo = 0; a.ph_hi = N_PHASES;
    void* args[] = {&a};
    hipError_t e = hipLaunchCooperativeKernel((const void*)mega_fwd, dim3(grid), dim3(512), args, LDS_BYTES, stream);
    if (e != hipSuccess) fprintf(stderr, "cooperative launch failed: %s (grid %d)\n", hipGetErrorString(e), grid);
#else
    for (int p = 0; p < N_PHASES; ++p) { a.ph_lo = p; a.ph_hi = p + 1; hipLaunchKernelGGL(mega_fwd, dim3(grid), dim3(512), LDS_BYTES, stream, a); }
#endif
}
```

```cpp
#include <hip/hip_runtime.h>
#include <hip/hip_cooperative_groups.h>
#include <cstdio>
#include <cstdint>
namespace cg = cooperative_groups;

#ifndef MK_ONE_LAUNCH
#define MK_ONE_LAUNCH 1
#endif

#define LAS __attribute__((address_space(3)))
typedef unsigned short bf16_t;
typedef short bf16x8 __attribute__((ext_vector_type(8)));
typedef float f32x4 __attribute__((ext_vector_type(4)));
typedef unsigned u32x4 __attribute__((ext_vector_type(4)));
typedef unsigned u32x2 __attribute__((ext_vector_type(2)));

constexpr int D = 1024, SEQ = 2048, BATCH = 16, M = BATCH * SEQ, FF = 2816, NGU = 2 * FF, NIN = 6144, DEPTH = 2;
constexpr float EPS = 1e-6f;
constexpr size_t MiB = 1u << 20;
constexpr size_t WS_W = 1 * MiB;
constexpr size_t W_GU1 = WS_W, W_D1 = W_GU1 + (size_t)NGU * D * 2, W_IN = W_D1 + (size_t)D * FF * 2, W_PG = W_IN + (size_t)NIN * D * 2,
                 W_CO = W_PG + (size_t)D * 256 * 2, W_PO = W_CO + (size_t)D * D * 2, W_WO = W_PO + (size_t)D * D * 2, W_GU2 = W_WO + (size_t)D * D * 2,
                 W_D2 = W_GU2 + (size_t)NGU * D * 2, W_END = W_D2 + (size_t)D * FF * 2;
static_assert(W_END <= 56 * MiB, "weights");
constexpr size_t WS_CNT = 32768;
constexpr size_t WS_XBUF = 256 * 1024;
constexpr size_t WS_XB = 56 * MiB;
constexpr size_t WS_R0 = 120 * MiB;
constexpr size_t WS_ZG = WS_R0;
constexpr size_t WS_ZB = WS_R0 + 128 * MiB;
constexpr size_t WS_ZCV = WS_ZB + 64 * MiB;
constexpr size_t WS_ZP = WS_ZCV + 64 * MiB;
constexpr size_t WS_DD = WS_ZP + 64 * MiB;
constexpr size_t WS_CA = WS_ZB;
constexpr size_t WS_YP0 = WS_ZCV;
constexpr size_t WS_M1 = WS_ZP;
constexpr size_t WS_MM = WS_DD;
constexpr size_t WS_HMIX = WS_R0;
constexpr size_t WS_HH = WS_R0;
constexpr size_t WS_HFFN = WS_ZCV;
constexpr size_t WS_SSQ = WS_DD + 64 * MiB;
constexpr size_t WS_END = WS_SSQ + 1 * MiB;
static_assert(WS_HH + (size_t)M * FF * 2 <= WS_HFFN, "H overlay");
constexpr int LDS_BYTES = 147456, MISC_OFF = 131072 + 320;
constexpr size_t WS_BAR = 16384, CTL_ZERO_BYTES = 131072;

typedef float f32x2 __attribute__((ext_vector_type(2)));
typedef __bf16 bf16x2 __attribute__((ext_vector_type(2)));
__device__ __forceinline__ unsigned cvt_pk_bf16(float lo, float hi) { const f32x2 v = {lo, hi}; const bf16x2 b = __builtin_convertvector(v, bf16x2); return __builtin_bit_cast(unsigned, b); }
__device__ __forceinline__ float bf_lo(unsigned u) { return __builtin_bit_cast(float, u << 16); }
__device__ __forceinline__ float bf_hi(unsigned u) { return __builtin_bit_cast(float, u & 0xffff0000u); }
__device__ __forceinline__ float sigmoid_f(float x) { return __builtin_amdgcn_rcpf(1.0f + __expf(-x)); }
__device__ __forceinline__ float wave_sum(float v, int lane) {
#pragma unroll
    for (int o = 1; o < 64; o <<= 1) v += __builtin_bit_cast(float, __builtin_amdgcn_ds_bpermute((lane ^ o) << 2, __builtin_bit_cast(int, v)));
    return v;
}
#define LDS_WAIT() asm volatile("s_waitcnt lgkmcnt(0)" ::: "memory")

namespace pg8 {
constexpr int BM = 256, BK = 64, HALF = 128, HTB = HALF * BK * 2, STAGE_BYTES = 8 * HTB, NXCD = 8, WGM = 8;
__host__ __device__ __forceinline__ int lds_byte(int r, int c) { const int st = (r >> 4) * 2 + (c >> 5), rr = r & 15, cc = c & 31, ob = rr * 64 + cc * 2; return st * 1024 + (ob ^ (((ob >> 9) & 1) << 5)); }
__host__ __device__ __forceinline__ void stage_rc(int b, int& R, int& C) { const int st = b / 1024, sb = b % 1024, swz = sb ^ (((sb >> 9) & 1) << 5); R = (st >> 1) * 16 + swz / 64; C = (st & 1) * 32 + (swz % 64) / 2; }
__host__ __device__ __forceinline__ int perm32(int rho) { const int n = rho >> 4, i = rho & 15; return 8 * (i >> 2) + 4 * n + (i & 3); }

struct Unit { int pm, pn; };
struct Gemm { const bf16_t* A; const bf16_t* Bt; int M, N, K, lda, a_pn_cols; };

struct StaticOrder {
    int nM, nN, nwg, G, c;
    __host__ __device__ void init(int M_, int N_, int G_, int c_) { nM = M_ / BM; nN = N_ / BM; nwg = nM * nN; G = G_; c = c_; }
    __host__ __device__ bool next(int i, Unit& u) const {
        const long L = (long)i * G + c; if (L >= nwg) return false;
        int wgid = (int)L; { const int q = nwg / NXCD, r = nwg % NXCD, xcd = wgid % NXCD, off = wgid / NXCD; wgid = (xcd < r ? xcd * (q + 1) : r * (q + 1) + (xcd - r) * q) + off; }
        const int nig = WGM * nN, gid = wgid / nig, fm = gid * WGM, gsz = (nM - fm) < WGM ? (nM - fm) : WGM;
        u.pm = fm + ((wgid % nig) % gsz); u.pn = (wgid % nig) / gsz; return true;
    }
};

typedef f32x4 Acc[2][2][4][2];
__device__ __forceinline__ const char* uni(const char* p) { const unsigned long long v = (unsigned long long)p; const unsigned lo = __builtin_amdgcn_readfirstlane((unsigned)v), hi = __builtin_amdgcn_readfirstlane((unsigned)(v >> 32)); return (const char*)(((unsigned long long)hi << 32) | lo); }

template <class Epi>
__device__ __forceinline__ void gemm_phase(LAS unsigned char* lds, const Gemm g, const StaticOrder& S, const Epi& E, const int tid) {
    const int wid = __builtin_amdgcn_readfirstlane(tid >> 6), lane = tid & 63, wr = wid >> 2, wc = wid & 3, fr = lane & 15, fq = lane >> 4;
    const int K = g.K, nt = K / BK;
    unsigned voffA[2], voffB[2];
#pragma unroll
    for (int i = 0; i < 2; ++i) { int R, C; stage_rc(tid * 16 + i * 8192, R, C); const int Rb = (R & ~31) + perm32(R & 31);
        voffA[i] = (unsigned)(R * g.lda + C) * 2u; voffB[i] = (unsigned)(Rb * K + C) * 2u; }
    const size_t kstep = (size_t)(BK * 2);
    const size_t hstepA = (size_t)HALF * g.lda * 2, tstepA = 2 * hstepA;
    const size_t hstepB = (size_t)HALF * K * 2, tstepB = 2 * hstepB;
    const size_t pnA = (size_t)g.a_pn_cols * 2;
    const unsigned ldsw = (unsigned)wid * 1024u;
    const int aoff = lds_byte(wr * 64 + fr, fq * 8), boff = lds_byte(wc * 32 + fr, fq * 8);
#define PG8_SA(b, h) (((b) * 2 + (h)) * HTB)
#define PG8_SB(b, h) ((4 + (b) * 2 + (h)) * HTB)
#define PG8_STAGE(bufoff, gbase, voff) do { _Pragma("unroll") for (int _i = 0; _i < 2; ++_i) \
        __builtin_amdgcn_global_load_lds((const unsigned*)((const char*)(gbase) + (voff)[_i]), (LAS unsigned*)(lds + (bufoff) + ldsw + _i * 8192), 16, 0, 0); } while (0)
#define PG8_LDA(dst, b, h) do { _Pragma("unroll") for (int m = 0; m < 4; ++m) _Pragma("unroll") for (int k = 0; k < 2; ++k) dst[m][k] = *(const LAS bf16x8*)(lds + PG8_SA(b, h) + aoff + m * 2048 + k * 1024); } while (0)
#define PG8_LDB(dst, b, h) do { _Pragma("unroll") for (int n = 0; n < 2; ++n) _Pragma("unroll") for (int k = 0; k < 2; ++k) dst[n][k] = *(const LAS bf16x8*)(lds + PG8_SB(b, h) + boff + n * 2048 + k * 1024); } while (0)
#define PG8_MMA(ai, bj, At, Bt) do { __builtin_amdgcn_s_setprio(1); _Pragma("unroll") for (int m = 0; m < 4; ++m) _Pragma("unroll") for (int n = 0; n < 2; ++n) _Pragma("unroll") for (int k = 0; k < 2; ++k) \
        acc[ai][bj][m][n] = __builtin_amdgcn_mfma_f32_16x16x32_bf16(Bt[n][k], At[m][k], acc[ai][bj][m][n], 0, 0, 0); __builtin_amdgcn_s_setprio(0); } while (0)
#define PG8_WAIT_V(n) asm volatile("s_waitcnt vmcnt(" #n ")" ::: "memory")
#define PG8_WAIT_L(n) asm volatile("s_waitcnt lgkmcnt(" #n ")" ::: "memory")
#define PG8_BAR __builtin_amdgcn_s_barrier()
#define PG8_SCHED __builtin_amdgcn_sched_barrier(0)
    Unit cur, nxt; int ui = 0;
    if (!S.next(0, cur)) return;
    LAS float* const rs_lds = (LAS float*)(lds + STAGE_BYTES + 1024); LAS float* const bias_lds = (LAS float*)(lds + STAGE_BYTES + 1024 + 2048);
    int rsbuf = 0, rspm = -1; bool rs_loaded = false;
#define PG8_RS_PREP(u) do { rs_loaded = false; if (Epi::ROWSCALE && (u).pm != rspm) { rs_loaded = true; rspm = (u).pm; rsbuf ^= 1; if (tid < 256) { const f32x4 q = ((const f32x4*)E.ssq)[rspm * BM + tid]; rs_lds[rsbuf * 256 + tid] = __builtin_amdgcn_rsqf(((q.x + q.y) + (q.z + q.w)) * (1.0f / 1024.0f) + 1e-6f); } } } while (0)
    if constexpr (Epi::NBIAS > 0) { for (int i = tid; i < Epi::NBIAS; i += 512) bias_lds[i] = E.bias_src(i); }
    PG8_RS_PREP(cur);
    Acc acc;
#pragma unroll
    for (int a = 0; a < 2; ++a)
#pragma unroll
        for (int b = 0; b < 2; ++b)
#pragma unroll
            for (int m = 0; m < 4; ++m)
#pragma unroll
                for (int n = 0; n < 2; ++n) acc[a][b][m][n] = (f32x4){0.f, 0.f, 0.f, 0.f};
    bf16x8 At[4][2], B0[2][2], B1[2][2];
    const char* cA = uni((const char*)g.A + (size_t)cur.pm * tstepA + (size_t)cur.pn * pnA); const char* cB = uni((const char*)g.Bt + (size_t)cur.pn * tstepB);
    PG8_STAGE(PG8_SB(0, 0), cB, voffB); PG8_STAGE(PG8_SB(0, 1), cB + hstepB, voffB); PG8_STAGE(PG8_SA(0, 0), cA, voffA); PG8_STAGE(PG8_SA(0, 1), cA + hstepA, voffA);
    if (wr == 1) PG8_BAR;
    PG8_WAIT_V(2); PG8_BAR;
    PG8_STAGE(PG8_SB(1, 0), cB + kstep, voffB); PG8_STAGE(PG8_SA(1, 0), cA + kstep, voffA); PG8_STAGE(PG8_SB(1, 1), cB + hstepB + kstep, voffB);
    PG8_WAIT_V(6); PG8_BAR;
    for (;;) {
        const bool has_next = S.next(ui + 1, nxt);
        const char* nA = uni(has_next ? (const char*)g.A + (size_t)nxt.pm * tstepA + (size_t)nxt.pn * pnA : cA); const char* nB = uni(has_next ? (const char*)g.Bt + (size_t)nxt.pn * tstepB : cB);
#pragma unroll 1
        for (int t = 0; t < nt; t += 2) {
            const bool last = (t == nt - 2);
            const char* a1 = cA + (size_t)(t + 1) * kstep;
            const char* a2 = last ? nA : cA + (size_t)(t + 2) * kstep; const char* b2 = last ? nB : cB + (size_t)(t + 2) * kstep;
            const char* a3 = a2 + kstep; const char* b3 = b2 + kstep;
            const bool relax = (Epi::NSTORES > 0) && (t == 0) && (ui > 0) && !rs_loaded;
            PG8_LDB(B0, 0, 0); PG8_LDB(B1, 0, 1); PG8_SCHED; PG8_LDA(At, 0, 0); PG8_STAGE(PG8_SA(1, 1), a1 + hstepA, voffA);
            if (relax) { if constexpr (Epi::NSTORES == 8) PG8_WAIT_V(16); else PG8_WAIT_V(24); } else PG8_WAIT_V(8);
            PG8_WAIT_L(0); PG8_BAR; PG8_MMA(0, 0, At, B0); PG8_MMA(0, 1, At, B1); PG8_BAR; PG8_SCHED;
            PG8_LDA(At, 0, 1); PG8_STAGE(PG8_SB(0, 0), b2, voffB); PG8_STAGE(PG8_SB(0, 1), b2 + hstepB, voffB); PG8_STAGE(PG8_SA(0, 0), a2, voffA);
            if (relax) { if constexpr (Epi::NSTORES == 8) PG8_WAIT_V(16); else PG8_WAIT_V(24); } else PG8_WAIT_V(8);
            PG8_WAIT_L(0); PG8_BAR; PG8_MMA(1, 0, At, B0); PG8_MMA(1, 1, At, B1); PG8_BAR; PG8_SCHED;
            PG8_LDB(B0, 1, 0); PG8_LDB(B1, 1, 1); PG8_SCHED; PG8_LDA(At, 1, 0); PG8_STAGE(PG8_SA(0, 1), a2 + hstepA, voffA);
            PG8_WAIT_V(8); PG8_WAIT_L(0); PG8_BAR; PG8_MMA(0, 0, At, B0); PG8_MMA(0, 1, At, B1); PG8_BAR; PG8_SCHED;
            PG8_LDA(At, 1, 1); PG8_STAGE(PG8_SB(1, 0), b3, voffB); PG8_STAGE(PG8_SB(1, 1), b3 + hstepB, voffB); PG8_STAGE(PG8_SA(1, 0), a3, voffA);
            PG8_WAIT_V(8); PG8_WAIT_L(0); PG8_BAR; PG8_MMA(1, 0, At, B0); PG8_MMA(1, 1, At, B1); PG8_BAR; PG8_SCHED;
        }
        if (wr == 0) PG8_BAR;
        E(acc, cur, wr, wc, fr, fq, rs_lds + rsbuf * 256, bias_lds);
        if (!has_next) break;
#pragma unroll
        for (int a = 0; a < 2; ++a)
#pragma unroll
            for (int b = 0; b < 2; ++b)
#pragma unroll
                for (int m = 0; m < 4; ++m)
#pragma unroll
                    for (int n = 0; n < 2; ++n) acc[a][b][m][n] = (f32x4){0.f, 0.f, 0.f, 0.f};
        cur = nxt; cA = nA; cB = nB; ++ui;
        PG8_RS_PREP(cur);
        if (wr == 1) PG8_BAR;
    }
    PG8_WAIT_V(0);
    PG8_BAR;
#undef PG8_RS_PREP
#undef PG8_SA
#undef PG8_SB
#undef PG8_STAGE
#undef PG8_LDA
#undef PG8_LDB
#undef PG8_MMA
#undef PG8_WAIT_V
#undef PG8_WAIT_L
#undef PG8_BAR
#undef PG8_SCHED
}

__device__ __forceinline__ u32x4 pack8(const f32x4 v0, const f32x4 v1) { u32x4 w; w.x = cvt_pk_bf16(v0[0], v0[1]); w.y = cvt_pk_bf16(v0[2], v0[3]); w.z = cvt_pk_bf16(v1[0], v1[1]); w.w = cvt_pk_bf16(v1[2], v1[3]); return w; }

__device__ __forceinline__ float row_scale(const float* ssq, int row) { return __builtin_amdgcn_rsqf(ssq[row] * (1.0f / D) + EPS); }
struct EpiSwiglu {
    static constexpr bool ROWSCALE = true; static constexpr int NBIAS = 0, NSTORES = 8;
    bf16_t* O; const float* ssq;
    __device__ __forceinline__ void operator()(const Acc& acc, const Unit& u, int wr, int wc, int fr, int fq, const LAS float* rsl, const LAS float* bl) const {
        const int row0 = u.pm * BM + wr * 64 + fr, col0 = u.pn * HALF + wc * 32 + 8 * fq;
        float rs[2][4];
#pragma unroll
        for (int ai = 0; ai < 2; ++ai)
#pragma unroll
            for (int m = 0; m < 4; ++m) rs[ai][m] = rsl[ai * HALF + wr * 64 + m * 16 + fr];
#pragma unroll
        for (int ai = 0; ai < 2; ++ai)
#pragma unroll
            for (int m = 0; m < 4; ++m) {
                f32x4 v[2];
#pragma unroll
                for (int n = 0; n < 2; ++n) { const f32x4 gt = acc[ai][0][m][n] * rs[ai][m], up = acc[ai][1][m][n] * rs[ai][m];
#pragma unroll
                    for (int j = 0; j < 4; ++j) v[n][j] = gt[j] * sigmoid_f(gt[j]) * up[j]; }
                *(u32x4*)(O + (size_t)(row0 + ai * HALF + m * 16) * FF + col0) = pack8(v[0], v[1]);
            }
    }
};
struct EpiH {
    static constexpr bool ROWSCALE = false; static constexpr int NBIAS = 0, NSTORES = 16;
    bf16_t* C; const float* ssq;
    __device__ __forceinline__ void operator()(const Acc& acc, const Unit& u, int wr, int wc, int fr, int fq, const LAS float* rsl, const LAS float* bl) const {
        const int row0 = u.pm * BM + wr * 64 + fr, col0 = u.pn * BM + wc * 32 + 8 * fq;
#pragma unroll
        for (int ai = 0; ai < 2; ++ai)
#pragma unroll
            for (int m = 0; m < 4; ++m) { bf16_t* rowp = C + (size_t)(row0 + ai * HALF + m * 16) * D + col0;
#pragma unroll
                for (int bj = 0; bj < 2; ++bj) *(u32x4*)(rowp + bj * HALF) = pack8(acc[ai][bj][m][0], acc[ai][bj][m][1]); }
    }
};
__device__ __forceinline__ void unpack8v(const u32x4 q, f32x4& a, f32x4& b) { a = (f32x4){bf_lo(q.x), bf_hi(q.x), bf_lo(q.y), bf_hi(q.y)}; b = (f32x4){bf_lo(q.z), bf_hi(q.z), bf_lo(q.w), bf_hi(q.w)}; }
template <bool FINAL> struct EpiResid {
    static constexpr bool ROWSCALE = false; static constexpr int NBIAS = 0, NSTORES = 0;
    bf16_t* Xb; const float* post; float cs; float* ssq4; float* outp; float* xbuf; unsigned* cnt; const float* ssq;
    __device__ __forceinline__ void operator()(const Acc& acc, const Unit& u, int wr, int wc, int fr, int fq, const LAS float* rsl, const LAS float* bl) const {
        LAS float* P = (LAS float*)bl; LAS float* S = P + 1024;
        float* const outf = FINAL ? outp : nullptr;
        const int lane = fr + 16 * fq, wave = wr * 4 + wc, tid = wave * 64 + lane;
#pragma unroll
        for (int ai = 0; ai < 2; ++ai)
#pragma unroll
            for (int m = 0; m < 4; ++m) { float q = 0.f;
#pragma unroll
                for (int bj = 0; bj < 2; ++bj)
#pragma unroll
                    for (int n = 0; n < 2; ++n) { const f32x4 x = acc[ai][bj][m][n]; q += (x[0] * x[0] + x[1] * x[1]) + (x[2] * x[2] + x[3] * x[3]); }
                q += __builtin_bit_cast(float, __builtin_amdgcn_ds_bpermute((lane ^ 16) << 2, __builtin_bit_cast(int, q)));
                q += __builtin_bit_cast(float, __builtin_amdgcn_ds_bpermute((lane ^ 32) << 2, __builtin_bit_cast(int, q)));
                if (fq == 0) P[(ai * HALF + wr * 64 + m * 16 + fr) * 4 + wc] = q; }
        asm volatile("s_waitcnt lgkmcnt(0)" ::: "memory"); __builtin_amdgcn_s_barrier(); asm volatile("" ::: "memory");
        const int row0 = u.pm * BM + wr * 64 + fr, col0 = u.pn * BM + wc * 32 + 8 * fq;
        f32x4 pv[2][2];
#pragma unroll
        for (int bj = 0; bj < 2; ++bj)
#pragma unroll
            for (int n = 0; n < 2; ++n) pv[bj][n] = *(const f32x4*)(post + col0 + bj * HALF + 4 * n) * cs;
        u32x4 xq0[2][2];
#pragma unroll
        for (int m = 0; m < 2; ++m)
#pragma unroll
            for (int bj = 0; bj < 2; ++bj) xq0[m][bj] = *(const u32x4*)(Xb + (size_t)(row0 + m * 16) * D + col0 + bj * HALF);
        float* slot = xbuf + ((size_t)u.pm * BM) * 4 + u.pn;
        if (tid < 256) { const float t4 = (P[tid * 4 + 0] + P[tid * 4 + 1]) + (P[tid * 4 + 2] + P[tid * 4 + 3]);
            __hip_atomic_store(slot + tid * 4, t4, __ATOMIC_RELAXED, __HIP_MEMORY_SCOPE_AGENT); }
        asm volatile("s_waitcnt vmcnt(0)" ::: "memory");
        unsigned* c = cnt + u.pm * 16;
        if (tid < 256 && lane == 0) __hip_atomic_fetch_add(c, 1u, __ATOMIC_RELAXED, __HIP_MEMORY_SCOPE_AGENT);
        if (wave == 0) { unsigned n = 0;
            while ((unsigned)__builtin_amdgcn_readfirstlane(__hip_atomic_load(c, __ATOMIC_RELAXED, __HIP_MEMORY_SCOPE_AGENT)) < 16u) { __builtin_amdgcn_s_sleep(1); if (++n > (1u << 22)) break; }
            __builtin_amdgcn_fence(__ATOMIC_ACQUIRE, "agent"); asm volatile("s_waitcnt vmcnt(0)" ::: "memory"); }
        asm volatile("s_waitcnt vmcnt(0) lgkmcnt(0)" ::: "memory"); __builtin_amdgcn_s_barrier(); asm volatile("" ::: "memory");
        if (tid < 256) { const float* sl = xbuf + ((size_t)u.pm * BM + tid) * 4; float t4 = 0.f;
#pragma unroll
            for (int k = 0; k < 4; ++k) t4 += __hip_atomic_load(sl + k, __ATOMIC_RELAXED, __HIP_MEMORY_SCOPE_AGENT);
            S[tid] = 1.0f / sqrtf(t4 * (1.0f / 1024.0f) + 1e-6f); }
        asm volatile("s_waitcnt vmcnt(0) lgkmcnt(0)" ::: "memory"); __builtin_amdgcn_s_barrier(); asm volatile("" ::: "memory");
#pragma unroll
        for (int ai = 0; ai < 2; ++ai)
#pragma unroll
          for (int mh = 0; mh < 2; ++mh) {
            u32x4 xq[4][2];
#pragma unroll
            for (int m = 2 * mh; m < 2 * mh + 2; ++m)
#pragma unroll
                for (int bj = 0; bj < 2; ++bj) xq[m][bj] = (ai == 0 && mh == 0) ? xq0[m][bj] : *(const u32x4*)(Xb + (size_t)(row0 + ai * HALF + m * 16) * D + col0 + bj * HALF);
#pragma unroll
            for (int m = 2 * mh; m < 2 * mh + 2; ++m) { const int rl = ai * HALF + wr * 64 + m * 16 + fr; const float r1 = S[rl]; float q2 = 0.f;
#pragma unroll
                for (int bj = 0; bj < 2; ++bj) { f32x4 x0, x1; unpack8v(xq[m][bj], x0, x1);
                    x0 = x0 + acc[ai][bj][m][0] * r1 * pv[bj][0]; x1 = x1 + acc[ai][bj][m][1] * r1 * pv[bj][1];
                    if constexpr (FINAL) { float* o = outf + (size_t)(row0 + ai * HALF + m * 16) * D + col0 + bj * HALF; *(f32x4*)o = x0; *(f32x4*)(o + 4) = x1; }
                    else { const u32x4 w = pack8(x0, x1); *(u32x4*)(Xb + (size_t)(row0 + ai * HALF + m * 16) * D + col0 + bj * HALF) = w;
                        f32x4 y0, y1; unpack8v(w, y0, y1); q2 += ((y0[0] * y0[0] + y0[1] * y0[1]) + (y0[2] * y0[2] + y0[3] * y0[3])) + ((y1[0] * y1[0] + y1[1] * y1[1]) + (y1[2] * y1[2] + y1[3] * y1[3])); } }
                if constexpr (!FINAL) { q2 += __builtin_bit_cast(float, __builtin_amdgcn_ds_bpermute((lane ^ 16) << 2, __builtin_bit_cast(int, q2)));
                    q2 += __builtin_bit_cast(float, __builtin_amdgcn_ds_bpermute((lane ^ 32) << 2, __builtin_bit_cast(int, q2)));
                    if (fq == 0) P[rl * 4 + wc] = q2; } }
        }
        if constexpr (!FINAL) {
            asm volatile("s_waitcnt lgkmcnt(0)" ::: "memory"); __builtin_amdgcn_s_barrier(); asm volatile("" ::: "memory");
            if (tid < 256) ssq4[((size_t)u.pm * BM + tid) * 4 + u.pn] = (P[tid * 4 + 0] + P[tid * 4 + 1]) + (P[tid * 4 + 2] + P[tid * 4 + 3]);
        }
        asm volatile("s_waitcnt lgkmcnt(0)" ::: "memory"); __builtin_amdgcn_s_barrier(); asm volatile("" ::: "memory");
    }
};
struct EpiWin {
    static constexpr bool ROWSCALE = true; static constexpr int NBIAS = 2048, NSTORES = 8;
    bf16_t *ZB, *ZCV, *ZP, *ZG; const float* bgate; const float* ssq;
    __device__ __forceinline__ float bias_src(int i) const { return bgate[i]; }
    __device__ __forceinline__ void operator()(const Acc& acc, const Unit& u, int wr, int wc, int fr, int fq, const LAS float* rsl, const LAS float* bl) const {
        const int row0 = u.pm * BM + wr * 64 + fr, pn = u.pn, cw = wc * 32 + 8 * fq;
        float rs[2][4];
#pragma unroll
        for (int ai = 0; ai < 2; ++ai)
#pragma unroll
            for (int m = 0; m < 4; ++m) rs[ai][m] = rsl[ai * HALF + wr * 64 + m * 16 + fr];
        if (pn >= 4 && pn < 12) {
            const int col0 = (pn - 4) * HALF + cw;
#pragma unroll
            for (int ai = 0; ai < 2; ++ai)
#pragma unroll
                for (int m = 0; m < 4; ++m) { const float r2 = rs[ai][m] * rs[ai][m];
                    *(u32x4*)(ZCV + (size_t)(row0 + ai * HALF + m * 16) * D + col0) = pack8(acc[ai][0][m][0] * acc[ai][1][m][0] * r2, acc[ai][0][m][1] * acc[ai][1][m][1] * r2); }
        } else if (pn < 16) {
            bf16_t* base = pn < 4 ? ZB : ZP; const int col0 = (pn < 4 ? pn : pn - 12) * BM + cw;
#pragma unroll
            for (int ai = 0; ai < 2; ++ai)
#pragma unroll
                for (int m = 0; m < 4; ++m) { bf16_t* rowp = base + (size_t)(row0 + ai * HALF + m * 16) * D + col0;
#pragma unroll
                    for (int bj = 0; bj < 2; ++bj) *(u32x4*)(rowp + bj * HALF) = pack8(acc[ai][bj][m][0] * rs[ai][m], acc[ai][bj][m][1] * rs[ai][m]); }
        } else {
            const int col0 = (pn - 16) * BM + cw;
            f32x4 bv[2][2];
#pragma unroll
            for (int bj = 0; bj < 2; ++bj)
#pragma unroll
                for (int n = 0; n < 2; ++n) bv[bj][n] = *(const LAS f32x4*)(bl + col0 + bj * HALF + 4 * n);
#pragma unroll
            for (int ai = 0; ai < 2; ++ai)
#pragma unroll
                for (int m = 0; m < 4; ++m) { bf16_t* rowp = ZG + (size_t)(row0 + ai * HALF + m * 16) * 2048 + col0;
#pragma unroll
                    for (int bj = 0; bj < 2; ++bj) { f32x4 v[2];
#pragma unroll
                        for (int n = 0; n < 2; ++n) { const f32x4 a = acc[ai][bj][m][n] * rs[ai][m] + bv[bj][n];
#pragma unroll
                            for (int j = 0; j < 4; ++j) v[n][j] = sigmoid_f(a[j]); }
                        *(u32x4*)(rowp + bj * HALF) = pack8(v[0], v[1]); } }
        }
    }
};
struct EpiPoolGroup {
    static constexpr bool ROWSCALE = false; static constexpr int NBIAS = 2048, NSTORES = 16;
    bf16_t* O; const float* bias; const float* scale; const float* ssq;
    __device__ __forceinline__ float bias_src(int i) const { return i < 1024 ? bias[i] : scale[i - 1024]; }
    __device__ __forceinline__ void operator()(const Acc& acc, const Unit& u, int wr, int wc, int fr, int fq, const LAS float* rsl, const LAS float* bl) const {
        const int row0 = u.pm * BM + wr * 64 + fr, col0 = u.pn * BM + wc * 32 + 8 * fq;
        f32x4 bv[2][2], sv[2][2];
#pragma unroll
        for (int bj = 0; bj < 2; ++bj)
#pragma unroll
            for (int n = 0; n < 2; ++n) { bv[bj][n] = *(const LAS f32x4*)(bl + col0 + bj * HALF + 4 * n); sv[bj][n] = *(const LAS f32x4*)(bl + 1024 + col0 + bj * HALF + 4 * n); }
#pragma unroll
        for (int ai = 0; ai < 2; ++ai)
#pragma unroll
            for (int m = 0; m < 4; ++m) { bf16_t* rowp = O + (size_t)(row0 + ai * HALF + m * 16) * D + col0;
#pragma unroll
                for (int bj = 0; bj < 2; ++bj) *(u32x4*)(rowp + bj * HALF) = pack8((acc[ai][bj][m][0] + bv[bj][0]) * sv[bj][0], (acc[ai][bj][m][1] + bv[bj][1]) * sv[bj][1]); }
    }
};
struct EpiGateA {
    static constexpr bool ROWSCALE = false; static constexpr int NBIAS = 0, NSTORES = 16;
    const bf16_t* ZG; bf16_t* M1; const float* ssq;
    __device__ __forceinline__ void operator()(const Acc& acc, const Unit& u, int wr, int wc, int fr, int fq, const LAS float* rsl, const LAS float* bl) const {
        const int row0 = u.pm * BM + wr * 64 + fr, col0 = u.pn * BM + wc * 32 + 8 * fq;
#pragma unroll
        for (int ai = 0; ai < 2; ++ai) {
            u32x4 gq[4][2];
#pragma unroll
            for (int m = 0; m < 4; ++m)
#pragma unroll
                for (int bj = 0; bj < 2; ++bj) gq[m][bj] = *(const u32x4*)(ZG + (size_t)(row0 + ai * HALF + m * 16) * 2048 + col0 + bj * HALF);
#pragma unroll
            for (int m = 0; m < 4; ++m)
#pragma unroll
                for (int bj = 0; bj < 2; ++bj) { f32x4 g0, g1; unpack8v(gq[m][bj], g0, g1);
                    *(u32x4*)(M1 + (size_t)(row0 + ai * HALF + m * 16) * D + col0 + bj * HALF) = pack8(g0 * acc[ai][bj][m][0], g1 * acc[ai][bj][m][1]); }
        }
    }
};
struct EpiGateP {
    static constexpr bool ROWSCALE = false; static constexpr int NBIAS = 0, NSTORES = 16;
    const bf16_t* ZG; const bf16_t* M1; bf16_t* MM; const float* ssq;
    __device__ __forceinline__ void operator()(const Acc& acc, const Unit& u, int wr, int wc, int fr, int fq, const LAS float* rsl, const LAS float* bl) const {
        const int row0 = u.pm * BM + wr * 64 + fr, col0 = u.pn * BM + wc * 32 + 8 * fq;
#pragma unroll
        for (int ai = 0; ai < 2; ++ai) {
            u32x4 gq[4][2], mq[4][2];
#pragma unroll
            for (int m = 0; m < 4; ++m)
#pragma unroll
                for (int bj = 0; bj < 2; ++bj) { const size_t r = (size_t)(row0 + ai * HALF + m * 16);
                    gq[m][bj] = *(const u32x4*)(ZG + r * 2048 + D + col0 + bj * HALF); mq[m][bj] = *(const u32x4*)(M1 + r * D + col0 + bj * HALF); }
#pragma unroll
            for (int m = 0; m < 4; ++m)
#pragma unroll
                for (int bj = 0; bj < 2; ++bj) { f32x4 g0, g1, m0, m1; unpack8v(gq[m][bj], g0, g1); unpack8v(mq[m][bj], m0, m1);
                    *(u32x4*)(MM + (size_t)(row0 + ai * HALF + m * 16) * D + col0 + bj * HALF) = pack8(m0 + g0 * acc[ai][bj][m][0], m1 + g1 * acc[ai][bj][m][1]); }
        }
    }
};
}


#define XB_TMO      128
#define XB_XCNT(j)  (256  + 64 * (j))
#define XB_XSUB(j)  (1280 + 64 * (j))
#define XB_XGEN(j)  (2304 + 64 * (j))
#define XB_TOP      3328
#define XB_TOPGEN   3392
#define XCD_BAR_WORDS 3456
#define XB_SPIN_CAP (1u << 18)

__device__ __forceinline__ unsigned xb_ld(unsigned* p)              { return __hip_atomic_load(p, __ATOMIC_RELAXED, __HIP_MEMORY_SCOPE_AGENT); }
__device__ __forceinline__ unsigned xb_add(unsigned* p, unsigned v) { return __hip_atomic_fetch_add(p, v, __ATOMIC_RELAXED, __HIP_MEMORY_SCOPE_AGENT); }
__device__ __forceinline__ unsigned xb_xcc_id() { return (unsigned)__builtin_amdgcn_s_getreg((3 << 11) | 20) & 0xFu; }
#define XB_SPIN(cond, bar) do { unsigned _sp = 0; while (cond) { __builtin_amdgcn_s_sleep(1); \
    if ((++_sp & 255u) == 0u) { if (xb_ld(&(bar)[XB_TMO])) break; if (_sp > XB_SPIN_CAP) { atomicAdd(&(bar)[XB_TMO], 1u); break; } } } } while (0)

__device__ __forceinline__ bool xb_is_thread0(int wave) { int t; asm volatile("v_mbcnt_lo_u32_b32 %0, -1, 0\n\tv_mbcnt_hi_u32_b32 %0, -1, %0" : "=v"(t)); return t == 0 && wave == 0; }
struct XcdBarrier {
    unsigned* bar; unsigned x;
    volatile LAS unsigned* st;
};

__device__ __forceinline__ XcdBarrier xcd_barrier_post(unsigned* bar, volatile LAS unsigned* st) {
    XcdBarrier b; b.bar = bar; b.x = xb_xcc_id(); b.st = st;
    if (threadIdx.x == 0) (void)xb_add(&bar[XB_XCNT(b.x)], 1u);
    return b;
}
__device__ __forceinline__ void xcd_barrier_complete(unsigned* bar, unsigned x, unsigned& nloc, unsigned& nx) {
    const unsigned G = gridDim.x * gridDim.y * gridDim.z;
    unsigned sum, cnt, mine, sp = 0u;
    for (;;) {
        sum = 0u; cnt = 0u; mine = 0u;
#pragma unroll
        for (unsigned j = 0; j < 16; ++j) { const unsigned c = xb_ld(&bar[XB_XCNT(j)]); sum += c; cnt += (c > 0u) ? 1u : 0u; mine = (j == x) ? c : mine; }
        if (sum == G) break;
        __builtin_amdgcn_s_sleep(1);
        if ((++sp & 255u) == 0u) { if (xb_ld(&bar[XB_TMO])) break; if (sp > XB_SPIN_CAP) { atomicAdd(&bar[XB_TMO], 1u); break; } }
    }
    nloc = mine > 0u ? mine : 1u; nx = cnt > 0u ? cnt : 1u;
}

__device__ __forceinline__ void xcd_barrier(const XcdBarrier& b, int wave) {
    asm volatile("s_waitcnt vmcnt(0)" ::: "memory");
    __syncthreads();
    if (xb_is_thread0(wave)) {
        unsigned* bar = b.bar;
        __builtin_amdgcn_s_waitcnt(0);
        unsigned nloc = b.st[0], nx = b.st[1];
        if (nloc == 0u) { xcd_barrier_complete(bar, b.x, nloc, nx); b.st[0] = nloc; b.st[1] = nx; }
        const unsigned old = xb_add(&bar[XB_XSUB(b.x)], 1u);
        const unsigned gen = old / nloc;
        if (old + 1u == (gen + 1u) * nloc) {
            __builtin_amdgcn_fence(__ATOMIC_RELEASE, "agent");
            asm volatile("s_waitcnt vmcnt(0)" ::: "memory");
            const unsigned og = xb_add(&bar[XB_TOP], 1u);
            const unsigned tg = og / nx;
            if (og + 1u == (tg + 1u) * nx) xb_add(&bar[XB_TOPGEN], 1u);
            else XB_SPIN(xb_ld(&bar[XB_TOPGEN]) == tg, bar);
            __builtin_amdgcn_fence(__ATOMIC_ACQUIRE, "agent");
            xb_add(&bar[XB_XGEN(b.x)], 1u);
            asm volatile("s_waitcnt vmcnt(0)" ::: "memory");
        } else {
            XB_SPIN(xb_ld(&bar[XB_XGEN(b.x)]) == gen, bar);
            __builtin_amdgcn_fence(__ATOMIC_ACQUIRE, "agent");
            asm volatile("s_waitcnt vmcnt(0)" ::: "memory");
        }
    }
    __syncthreads();
}

struct Args { const float* in[20]; float* out; unsigned char* ws; int ph_lo, ph_hi; };
struct Ctx { LAS unsigned char* lds; int lane, wave, gw, NGW, G, bid; };

__device__ __forceinline__ void transpose_item(const float* W, int ldsrc, int K, int src_col0, bf16_t* WT, int dst_row0, int k0, const float* kscale, LAS float* scr, int lane) {
    {
        const int kr = lane >> 3, n4 = (lane & 7) * 4; f32x4 v[8];
#pragma unroll
        for (int i = 0; i < 8; ++i) v[i] = *(const f32x4*)(W + (size_t)(k0 + 8 * i + kr) * ldsrc + src_col0 + n4);
#pragma unroll
        for (int i = 0; i < 8; ++i) { const int kk = 8 * i + kr; const float sc = kscale ? kscale[k0 + kk] : 1.0f; LAS float* d = scr + kk * 33 + n4;
            d[0] = v[i].x * sc; d[1] = v[i].y * sc; d[2] = v[i].z * sc; d[3] = v[i].w * sc; }
    }
    LDS_WAIT(); asm volatile("" ::: "memory");
    const int c = lane & 7;
#pragma unroll
    for (int j = 0; j < 4; ++j) { const int n = (lane >> 3) + 8 * j; const LAS float* sp = scr + (8 * c) * 33 + n;
        u32x4 o; o.x = cvt_pk_bf16(sp[0 * 33], sp[1 * 33]); o.y = cvt_pk_bf16(sp[2 * 33], sp[3 * 33]); o.z = cvt_pk_bf16(sp[4 * 33], sp[5 * 33]); o.w = cvt_pk_bf16(sp[6 * 33], sp[7 * 33]);
        *(u32x4*)(WT + (size_t)(dst_row0 + n) * K + k0 + 8 * c) = o; }
    LDS_WAIT(); asm volatile("" ::: "memory");
}
__device__ __forceinline__ int map_gu(int n) { return ((n >> 7) & 1) * FF + (n >> 8) * 128 + (n & 127); }
__device__ __forceinline__ int map_in(int n) { if (n < 1024 || n >= 3072) return n; const int q = (n - 1024) >> 8, h = (n >> 7) & 1; return (h ? 2048 : 1024) + q * 128 + (n & 127); }

__device__ __forceinline__ void prep_weights(const Ctx& F, const Args& a, unsigned char* ws, int l) {
    LAS float* scr = (LAS float*)(F.lds + F.wave * 16384);
    constexpr int I_GU = (D / 64) * (NGU / 32), I_D = (FF / 64) * (D / 32), I_IN = (D / 64) * (NIN / 32), I_SQ = (D / 64) * (D / 32), I_PG = 4 * (256 / 64) * (256 / 32);
    constexpr int NITEMS = 2 * I_GU + 2 * I_D + I_IN + 3 * I_SQ + I_PG;
    for (int it = F.gw; it < NITEMS; it += F.NGW) {
        int r = it;
        if (r < 2 * I_GU) { const int w = r / I_GU; r -= w * I_GU; const int kb = r / (NGU / 32), nb = r % (NGU / 32);
            transpose_item(a.in[w ? 18 : 3] + (size_t)l * D * NGU, NGU, D, map_gu(32 * nb), (bf16_t*)(ws + (w ? W_GU2 : W_GU1)), 32 * nb, 64 * kb, a.in[w ? 16 : 1] + l * D, scr, F.lane); continue; }
        r -= 2 * I_GU;
        if (r < 2 * I_D) { const int w = r / I_D; r -= w * I_D; const int kb = r / (D / 32), nb = r % (D / 32);
            transpose_item(a.in[w ? 19 : 4] + (size_t)l * FF * D, D, FF, 32 * nb, (bf16_t*)(ws + (w ? W_D2 : W_D1)), 32 * nb, 64 * kb, nullptr, scr, F.lane); continue; }
        r -= 2 * I_D;
        if (r < I_IN) { const int kb = r / (NIN / 32), nb = r % (NIN / 32);
            transpose_item(a.in[7] + (size_t)l * D * NIN, NIN, D, map_in(32 * nb), (bf16_t*)(ws + W_IN), 32 * nb, 64 * kb, a.in[5] + l * D, scr, F.lane); continue; }
        r -= I_IN;
        if (r < 3 * I_SQ) { const int w = r / I_SQ; r -= w * I_SQ; const int kb = r / (D / 32), nb = r % (D / 32);
            transpose_item(a.in[w == 0 ? 10 : (w == 1 ? 14 : 15)] + (size_t)l * D * D, D, D, 32 * nb, (bf16_t*)(ws + (w == 0 ? W_CO : (w == 1 ? W_PO : W_WO))), 32 * nb, 64 * kb, nullptr, scr, F.lane); continue; }
        r -= 3 * I_SQ;
        { const int gi = r / 32; r -= gi * 32; const int kb = r / 8, nb = r % 8;
            transpose_item(a.in[11] + (size_t)l * 4 * 65536 + (size_t)gi * 65536, 256, 256, 32 * nb, (bf16_t*)(ws + W_PG), gi * 256 + 32 * nb, 64 * kb, nullptr, scr, F.lane); }
    }
}

__device__ __forceinline__ void cast_rows(const Ctx& F, const float* x, bf16_t* Xb, float* ssq) {
    for (int m = F.gw; m < M; m += F.NGW) {
        const f32x4* xr = (const f32x4*)(x + (size_t)m * D) + F.lane;
        f32x4 v[4]; float s = 0.f;
#pragma unroll
        for (int j = 0; j < 4; ++j) { v[j] = xr[64 * j]; s += (v[j].x * v[j].x + v[j].y * v[j].y) + (v[j].z * v[j].z + v[j].w * v[j].w); }
        s = wave_sum(s, F.lane);
        u32x2* o = (u32x2*)(Xb + (size_t)m * D) + F.lane;
#pragma unroll
        for (int j = 0; j < 4; ++j) { u32x2 w; w.x = cvt_pk_bf16(v[j].x, v[j].y); w.y = cvt_pk_bf16(v[j].z, v[j].w); o[64 * j] = w; }
        if (F.lane == 0) ((f32x4*)ssq)[m] = (f32x4){s, 0.f, 0.f, 0.f};
    }
}
__device__ __forceinline__ void resid_rows(const Ctx& F, bf16_t* Xb, const bf16_t* h, const float* post, float cs, float* ssq, float* outf) {
    f32x4 pv[4];
#pragma unroll
    for (int j = 0; j < 4; ++j) pv[j] = ((const f32x4*)post)[F.lane + 64 * j] * cs;
    for (int m0 = F.gw; m0 < M; m0 += 2 * F.NGW) {
        const int m1 = m0 + F.NGW; const bool two = m1 < M; const int mb = two ? m1 : m0;
        f32x4 hv[2][4], xv[2][4];
#pragma unroll
        for (int r = 0; r < 2; ++r) { const int m = r ? mb : m0;
            const u32x2* hr = (const u32x2*)(h + (size_t)m * D) + F.lane; const u32x2* xr = (const u32x2*)(Xb + (size_t)m * D) + F.lane;
#pragma unroll
            for (int j = 0; j < 4; ++j) { const u32x2 q = hr[64 * j]; hv[r][j] = (f32x4){bf_lo(q.x), bf_hi(q.x), bf_lo(q.y), bf_hi(q.y)};
                const u32x2 p = xr[64 * j]; xv[r][j] = (f32x4){bf_lo(p.x), bf_hi(p.x), bf_lo(p.y), bf_hi(p.y)}; } }
#pragma unroll
        for (int r = 0; r < 2; ++r) { const int m = r ? mb : m0; if (r && !two) break;
            float s = 0.f;
#pragma unroll
            for (int j = 0; j < 4; ++j) s += (hv[r][j].x * hv[r][j].x + hv[r][j].y * hv[r][j].y) + (hv[r][j].z * hv[r][j].z + hv[r][j].w * hv[r][j].w);
            const float r1 = 1.0f / sqrtf(wave_sum(s, F.lane) * (1.f / D) + EPS);
            if (outf) {
                f32x4* xo = (f32x4*)(outf + (size_t)m * D) + F.lane;
#pragma unroll
                for (int j = 0; j < 4; ++j) xo[64 * j] = xv[r][j] + hv[r][j] * r1 * pv[j];
            } else {
                float s2 = 0.f;
                u32x2* o = (u32x2*)(Xb + (size_t)m * D) + F.lane;
#pragma unroll
                for (int j = 0; j < 4; ++j) { const f32x4 xn = xv[r][j] + hv[r][j] * r1 * pv[j]; u32x2 w; w.x = cvt_pk_bf16(xn.x, xn.y); w.y = cvt_pk_bf16(xn.z, xn.w); o[64 * j] = w;
                    const f32x4 xr_ = {bf_lo(w.x), bf_hi(w.x), bf_lo(w.y), bf_hi(w.y)};
                    s2 += (xr_.x * xr_.x + xr_.y * xr_.y) + (xr_.z * xr_.z + xr_.w * xr_.w); }
                s2 = wave_sum(s2, F.lane);
                if (F.lane == 0) ssq[m] = s2;
            }
        }
    }
}
__device__ __forceinline__ void unpack8(const u32x4 q, float (&f)[8]) { f[0] = bf_lo(q.x); f[1] = bf_hi(q.x); f[2] = bf_lo(q.y); f[3] = bf_hi(q.y); f[4] = bf_lo(q.z); f[5] = bf_hi(q.z); f[6] = bf_lo(q.w); f[7] = bf_hi(q.w); }
__device__ __forceinline__ void mix_rows(const Ctx& F, bf16_t* ZBCA, const bf16_t* ZCV, const bf16_t* ZP, const float* convw, bf16_t* DDo) {
    const int half = F.gw & 1, c0 = half * 512 + F.lane * 8;
    const int npair = F.NGW >> 1, tpw = M / npair, t0 = (F.gw >> 1) * tpw;
    float w0[8], w1[8], w2[8];
#pragma unroll
    for (int j = 0; j < 8; ++j) { w0[j] = convw[c0 + j]; w1[j] = convw[D + c0 + j]; w2[j] = convw[2 * D + c0 + j]; }
    const int win = 2 << (c0 >> 8), wmax = half ? 16 : 4;
    const u32x4 zero = {0u, 0u, 0u, 0u};
    const int s0 = t0 & (SEQ - 1);
    const size_t off0 = (size_t)t0 * D + c0;
    float acc[8], cm1[8], cm2[8];
#pragma unroll
    for (int j = 0; j < 8; ++j) acc[j] = 0.f;
    for (int k = 1; k < wmax; ++k) {
        const bool ok = (k < win) && (s0 >= k);
        const u32x4 q = ok ? *(const u32x4*)(ZP + off0 - (size_t)k * D) : zero;
        float f[8]; unpack8(q, f);
#pragma unroll
        for (int j = 0; j < 8; ++j) acc[j] += f[j];
    }
    { const u32x4 q1 = s0 >= 1 ? *(const u32x4*)(ZCV + off0 - D) : zero, q2 = s0 >= 2 ? *(const u32x4*)(ZCV + off0 - 2 * D) : zero; unpack8(q1, cm1); unpack8(q2, cm2); }
    for (int i = 0; i < tpw; i += 4) {
        u32x4 qb[4], qc[4], qp[4], qo[4];
#pragma unroll
        for (int u = 0; u < 4; ++u) { const size_t off = off0 + (size_t)(i + u) * D; const int s = s0 + i + u;
            qb[u] = *(const u32x4*)(ZBCA + off); qc[u] = *(const u32x4*)(ZCV + off); qp[u] = *(const u32x4*)(ZP + off);
            qo[u] = (s >= win - 1) ? *(const u32x4*)(ZP + off - (size_t)(win - 1) * D) : zero; }
#pragma unroll
        for (int u = 0; u < 4; ++u) { const size_t off = off0 + (size_t)(i + u) * D; const int s = s0 + i + u;
            float fb[8], fc[8], fp[8], fo[8], ca[8], dd[8];
            unpack8(qb[u], fb); unpack8(qc[u], fc); unpack8(qp[u], fp); unpack8(qo[u], fo);
            const float inv = 1.0f / (float)((s + 1) < win ? (s + 1) : win);
#pragma unroll
            for (int j = 0; j < 8; ++j) { ca[j] = fb[j] * (w0[j] * cm2[j] + w1[j] * cm1[j] + w2[j] * fc[j]); cm2[j] = cm1[j]; cm1[j] = fc[j];
                const float st = acc[j] + fp[j]; dd[j] = st * inv - fp[j]; acc[j] = st - fo[j]; }
            u32x4 o1, o2;
            o1.x = cvt_pk_bf16(ca[0], ca[1]); o1.y = cvt_pk_bf16(ca[2], ca[3]); o1.z = cvt_pk_bf16(ca[4], ca[5]); o1.w = cvt_pk_bf16(ca[6], ca[7]);
            o2.x = cvt_pk_bf16(dd[0], dd[1]); o2.y = cvt_pk_bf16(dd[2], dd[3]); o2.z = cvt_pk_bf16(dd[4], dd[5]); o2.w = cvt_pk_bf16(dd[6], dd[7]);
            *(u32x4*)(ZBCA + off) = o1; *(u32x4*)(DDo + off) = o2; }
    }
}

__device__ __forceinline__ bool launder(Ctx& F, unsigned char*& ws, int& tidv) { int t; asm volatile("v_mbcnt_lo_u32_b32 %0, -1, 0\n\tv_mbcnt_hi_u32_b32 %0, -1, %0" : "=v"(t)); F.lane = t; tidv = F.wave * 64 + t; { int g = F.gw, b = blockIdx.x; asm volatile("" : "+s"(g), "+s"(b)); F.gw = g; F.bid = b; }
    const unsigned long long w0 = (unsigned long long)ws; unsigned wl = __builtin_amdgcn_readfirstlane((unsigned)w0), wh = __builtin_amdgcn_readfirstlane((unsigned)(w0 >> 32)); asm volatile("" : "+s"(wl), "+s"(wh));
    const unsigned long long w = ((unsigned long long)wh << 32) | wl; ws = (unsigned char*)(__attribute__((address_space(1))) unsigned char*)w; return true; }
constexpr int PH_PER_LAYER = 10, N_PHASES = 1 + DEPTH * PH_PER_LAYER;

__global__ void __launch_bounds__(512, 2) mega_fwd(Args a) {
    extern __shared__ __attribute__((aligned(16))) unsigned char lds_raw[];
    Ctx F; F.lds = (LAS unsigned char*)lds_raw; F.lane = threadIdx.x & 63; F.wave = __builtin_amdgcn_readfirstlane(threadIdx.x >> 6);
    F.G = gridDim.x; F.gw = blockIdx.x * 8 + F.wave; F.NGW = F.G * 8; F.bid = blockIdx.x;
    unsigned char* ws = a.ws; int tidv = threadIdx.x;
    const int lo = a.ph_lo, hi = a.ph_hi;
    volatile LAS unsigned* MISC = (volatile LAS unsigned*)(F.lds + MISC_OFF);
    if (threadIdx.x < 32) MISC[threadIdx.x] = 0u;
    __syncthreads();
    XcdBarrier bar; bar.bar = (unsigned*)(ws + WS_BAR); bar.x = 0; bar.st = nullptr;
    if (hi - lo > 1) bar = xcd_barrier_post((unsigned*)(ws + WS_BAR), MISC + 8);
    if (lo < 0) cg::this_grid().sync();
    int ph = 0;
#define IN_PH (lo <= ph && ph < hi && launder(F, ws, tidv))
#define SEAM() do { if (lo <= ph && ph + 1 < hi) { xcd_barrier(bar, F.wave); } ++ph; } while (0)
#define XB ((bf16_t*)(ws + WS_XB))
#define SSQ ((float*)(ws + WS_SSQ))
    if (IN_PH) { prep_weights(F, a, ws, 0); cast_rows(F, a.in[0], XB, SSQ); }
    SEAM();
    for (int l = 0; l < DEPTH; ++l) {
        const bool more = (l + 1 < DEPTH);
        if (IN_PH) { pg8::Gemm g{XB, (const bf16_t*)(ws + W_GU1), M, NGU, D, D, 0}; pg8::StaticOrder S; S.init(M, NGU, F.G, F.bid);
            pg8::EpiSwiglu E{(bf16_t*)(ws + WS_HH), SSQ}; pg8::gemm_phase(F.lds, g, S, E, tidv); }
        SEAM();
        if (IN_PH) { pg8::Gemm g{(const bf16_t*)(ws + WS_HH), (const bf16_t*)(ws + W_D1), M, D, FF, FF, 0}; pg8::StaticOrder S; S.init(M, D, F.G, F.bid);
            pg8::EpiResid<false> E{XB, a.in[2] + l * D, 0.5f, SSQ, nullptr, (float*)(ws + WS_XBUF), (unsigned*)(ws + WS_CNT) + (l * 3 + 0) * 128 * 16, nullptr}; pg8::gemm_phase(F.lds, g, S, E, tidv); }
        SEAM();
        if (IN_PH) { pg8::Gemm g{XB, (const bf16_t*)(ws + W_IN), M, NIN, D, D, 0}; pg8::StaticOrder S; S.init(M, NIN, F.G, F.bid);
            pg8::EpiWin E{(bf16_t*)(ws + WS_ZB), (bf16_t*)(ws + WS_ZCV), (bf16_t*)(ws + WS_ZP), (bf16_t*)(ws + WS_ZG), a.in[8] + l * 2 * D, SSQ}; pg8::gemm_phase(F.lds, g, S, E, tidv); }
        SEAM();
        if (IN_PH) mix_rows(F, (bf16_t*)(ws + WS_ZB), (const bf16_t*)(ws + WS_ZCV), (const bf16_t*)(ws + WS_ZP), a.in[9] + l * 3 * D, (bf16_t*)(ws + WS_DD));
        SEAM();
        if (IN_PH) { pg8::Gemm g{(const bf16_t*)(ws + WS_DD), (const bf16_t*)(ws + W_PG), M, D, 256, D, 256}; pg8::StaticOrder S; S.init(M, D, F.G, F.bid);
            pg8::EpiPoolGroup E{(bf16_t*)(ws + WS_YP0), a.in[12] + l * D, a.in[13] + l * D, nullptr}; pg8::gemm_phase(F.lds, g, S, E, tidv); }
        if (IN_PH) { pg8::Gemm g{(const bf16_t*)(ws + WS_CA), (const bf16_t*)(ws + W_CO), M, D, D, D, 0}; pg8::StaticOrder S; S.init(M, D, F.G, F.bid);
            pg8::EpiGateA E{(const bf16_t*)(ws + WS_ZG), (bf16_t*)(ws + WS_M1), nullptr}; pg8::gemm_phase(F.lds, g, S, E, tidv); }
        SEAM();
        if (IN_PH) { pg8::Gemm g{(const bf16_t*)(ws + WS_YP0), (const bf16_t*)(ws + W_PO), M, D, D, D, 0}; pg8::StaticOrder S; S.init(M, D, F.G, F.bid);
            pg8::EpiGateP E{(const bf16_t*)(ws + WS_ZG), (const bf16_t*)(ws + WS_M1), (bf16_t*)(ws + WS_MM), nullptr}; pg8::gemm_phase(F.lds, g, S, E, tidv); }
        SEAM();
        if (IN_PH) { pg8::Gemm g{(const bf16_t*)(ws + WS_MM), (const bf16_t*)(ws + W_WO), M, D, D, D, 0}; pg8::StaticOrder S; S.init(M, D, F.G, F.bid);
            pg8::EpiResid<false> E{XB, a.in[6] + l * D, 1.0f, SSQ, nullptr, (float*)(ws + WS_XBUF), (unsigned*)(ws + WS_CNT) + (l * 3 + 1) * 128 * 16, nullptr}; pg8::gemm_phase(F.lds, g, S, E, tidv); }
        SEAM();
        if (IN_PH) { pg8::Gemm g{XB, (const bf16_t*)(ws + W_GU2), M, NGU, D, D, 0}; pg8::StaticOrder S; S.init(M, NGU, F.G, F.bid);
            pg8::EpiSwiglu E{(bf16_t*)(ws + WS_HH), SSQ}; pg8::gemm_phase(F.lds, g, S, E, tidv); }
        SEAM();
        if (IN_PH) { pg8::Gemm g{(const bf16_t*)(ws + WS_HH), (const bf16_t*)(ws + W_D2), M, D, FF, FF, 0}; pg8::StaticOrder S; S.init(M, D, F.G, F.bid);
            if (more) { pg8::EpiResid<false> E{XB, a.in[17] + l * D, 0.5f, SSQ, nullptr, (float*)(ws + WS_XBUF), (unsigned*)(ws + WS_CNT) + (l * 3 + 2) * 128 * 16, nullptr}; pg8::gemm_phase(F.lds, g, S, E, tidv); }
            else { pg8::EpiResid<true> E{XB, a.in[17] + l * D, 0.5f, SSQ, a.out, (float*)(ws + WS_XBUF), (unsigned*)(ws + WS_CNT) + (l * 3 + 2) * 128 * 16, nullptr}; pg8::gemm_phase(F.lds, g, S, E, tidv); } }
        SEAM();
        if (IN_PH) { if (more) prep_weights(F, a, ws, l + 1); }
        SEAM();
    }
#undef IN_PH
#undef SEAM
}

extern "C" void kernel_launch(void* const* d_in, const int* in_sizes, int n_in, void* d_out, int out_size, void* d_ws, size_t ws_size, hipStream_t stream) {
    static int grid = 0;
    if (grid == 0) {
        if (n_in != 20 || in_sizes[0] != M * D || out_size != M * D || ws_size < WS_END) { fprintf(stderr, "kernel_launch: unexpected shapes (n_in %d, in0 %d, out %d, ws %zu < %zu)\n", n_in, n_in > 0 ? in_sizes[0] : -1, out_size, ws_size, (size_t)WS_END); grid = -1; return; }
        int dev = 0, cus = 0, per_cu = 0;
        (void)hipGetDevice(&dev); (void)hipDeviceGetAttribute(&cus, hipDeviceAttributeMultiprocessorCount, dev);
        if (hipFuncSetAttribute((const void*)mega_fwd, hipFuncAttributeMaxDynamicSharedMemorySize, LDS_BYTES) != hipSuccess) { fprintf(stderr, "kernel_launch: hipFuncSetAttribute failed\n"); grid = -1; return; }
        if (hipOccupancyMaxActiveBlocksPerMultiprocessor(&per_cu, (const void*)mega_fwd, 512, LDS_BYTES) != hipSuccess || per_cu < 1) { fprintf(stderr, "kernel_launch: occupancy query says %d\n", per_cu); per_cu = 1; (void)hipGetLastError(); }
        grid = cus * per_cu;
    }
    if (grid < 0) return;
    Args a{};
    for (int i = 0; i < 20; ++i) a.in[i] = (const float*)d_in[i];
    a.out = (float*)d_out; a.ws = (unsigned char*)d_ws;
#if MK_ONE_LAUNCH
    if (hipMemsetAsync((char*)d_ws, 0, CTL_ZERO_BYTES, stream) != hipSuccess) { fprintf(stderr, "kernel_launch: memset failed\n"); return; }
    a.ph_lo = 0; a.ph_hi = N_PHASES;
    void* args[] = {&a};
    hipError_t e = hipLaunchCooperativeKernel((const void*)mega_fwd, dim3(grid), dim3(512), args, LDS_BYTES, stream);
    if (e != hipSuccess) fprintf(stderr, "cooperative launch failed: %s (grid %d)\n", hipGetErrorString(e), grid);
#else
    for (int p = 0; p < N_PHASES; ++p) { a.ph_lo = p; a.ph_hi = p + 1; hipLaunchKernelGGL(mega_fwd, dim3(grid), dim3(512), LDS_BYTES, stream, a); }
#endif
}
```

```cpp
#include <hip/hip_runtime.h>
#include <hip/hip_cooperative_groups.h>
#include <cstdio>
#include <cstdint>
namespace cg = cooperative_groups;

#ifndef MK_ONE_LAUNCH
#define MK_ONE_LAUNCH 1
#endif

#define LAS __attribute__((address_space(3)))
typedef unsigned short bf16_t;
typedef short bf16x8 __attribute__((ext_vector_type(8)));
typedef float f32x4 __attribute__((ext_vector_type(4)));
typedef unsigned u32x4 __attribute__((ext_vector_type(4)));
typedef unsigned u32x2 __attribute__((ext_vector_type(2)));

constexpr int D = 1024, SEQ = 2048, BATCH = 16, M = BATCH * SEQ, FF = 2816, NGU = 2 * FF, NIN = 6144, DEPTH = 2;
constexpr float EPS = 1e-6f;
constexpr size_t MiB = 1u << 20;
constexpr size_t WS_W = 1 * MiB;
constexpr size_t W_GU1 = WS_W, W_D1 = W_GU1 + (size_t)NGU * D * 2, W_IN = W_D1 + (size_t)D * FF * 2, W_PG = W_IN + (size_t)NIN * D * 2,
                 W_CO = W_PG + (size_t)D * 256 * 2, W_PO = W_CO + (size_t)D * D * 2, W_WO = W_PO + (size_t)D * D * 2, W_GU2 = W_WO + (size_t)D * D * 2,
                 W_D2 = W_GU2 + (size_t)NGU * D * 2, W_END = W_D2 + (size_t)D * FF * 2;
static_assert(W_END <= 56 * MiB, "weights");
constexpr size_t WS_CNT = 32768;
constexpr size_t WS_XBUF = 256 * 1024;
constexpr size_t WS_XB = 56 * MiB;
constexpr size_t WS_R0 = 120 * MiB;
constexpr size_t WS_ZG = WS_R0;
constexpr size_t WS_ZB = WS_R0 + 128 * MiB;
constexpr size_t WS_ZCV = WS_ZB + 64 * MiB;
constexpr size_t WS_ZP = WS_ZCV + 64 * MiB;
constexpr size_t WS_DD = WS_ZP + 64 * MiB;
constexpr size_t WS_CA = WS_ZB;
constexpr size_t WS_YP0 = WS_ZCV;
constexpr size_t WS_M1 = WS_ZP;
constexpr size_t WS_MM = WS_DD;
constexpr size_t WS_HMIX = WS_R0;
constexpr size_t WS_HH = WS_R0;
constexpr size_t WS_HFFN = WS_ZCV;
constexpr size_t WS_SSQ = WS_DD + 64 * MiB;
constexpr size_t WS_END = WS_SSQ + 1 * MiB;
static_assert(WS_HH + (size_t)M * FF * 2 <= WS_HFFN, "H overlay");
constexpr int LDS_BYTES = 147456, MISC_OFF = 131072 + 320;
constexpr size_t WS_BAR = 16384, CTL_ZERO_BYTES = 131072;

typedef float f32x2 __attribute__((ext_vector_type(2)));
typedef __bf16 bf16x2 __attribute__((ext_vector_type(2)));
__device__ __forceinline__ unsigned cvt_pk_bf16(float lo, float hi) { const f32x2 v = {lo, hi}; const bf16x2 b = __builtin_convertvector(v, bf16x2); return __builtin_bit_cast(unsigned, b); }
__device__ __forceinline__ float bf_lo(unsigned u) { return __builtin_bit_cast(float, u << 16); }
__device__ __forceinline__ float bf_hi(unsigned u) { return __builtin_bit_cast(float, u & 0xffff0000u); }
__device__ __forceinline__ float sigmoid_f(float x) { return __builtin_amdgcn_rcpf(1.0f + __expf(-x)); }
__device__ __forceinline__ float wave_sum(float v, int lane) {
#pragma unroll
    for (int o = 1; o < 64; o <<= 1) v += __builtin_bit_cast(float, __builtin_amdgcn_ds_bpermute((lane ^ o) << 2, __builtin_bit_cast(int, v)));
    return v;
}
#define LDS_WAIT() asm volatile("s_waitcnt lgkmcnt(0)" ::: "memory")

namespace pg8 {
constexpr int BM = 256, BK = 64, HALF = 128, HTB = HALF * BK * 2, STAGE_BYTES = 8 * HTB, NXCD = 8, WGM = 8;
__host__ __device__ __forceinline__ int lds_byte(int r, int c) { const int st = (r >> 4) * 2 + (c >> 5), rr = r & 15, cc = c & 31, ob = rr * 64 + cc * 2; return st * 1024 + (ob ^ (((ob >> 9) & 1) << 5)); }
__host__ __device__ __forceinline__ void stage_rc(int b, int& R, int& C) { const int st = b / 1024, sb = b % 1024, swz = sb ^ (((sb >> 9) & 1) << 5); R = (st >> 1) * 16 + swz / 64; C = (st & 1) * 32 + (swz % 64) / 2; }
__host__ __device__ __forceinline__ int perm32(int rho) { const int n = rho >> 4, i = rho & 15; return 8 * (i >> 2) + 4 * n + (i & 3); }

struct Unit { int pm, pn; };
struct Gemm { const bf16_t* A; const bf16_t* Bt; int M, N, K, lda, a_pn_cols; const bf16_t* A2; const bf16_t* Bt2; };

struct StaticOrder {
    int nM, nN, nwg, G, c;
    __host__ __device__ void init(int M_, int N_, int G_, int c_) { nM = M_ / BM; nN = N_ / BM; nwg = nM * nN; G = G_; c = c_; }
    __host__ __device__ bool next(int i, Unit& u) const {
        const long L = (long)i * G + c; if (L >= nwg) return false;
        int wgid = (int)L; { const int q = nwg / NXCD, r = nwg % NXCD, xcd = wgid % NXCD, off = wgid / NXCD; wgid = (xcd < r ? xcd * (q + 1) : r * (q + 1) + (xcd - r) * q) + off; }
        const int nig = WGM * nN, gid = wgid / nig, fm = gid * WGM, gsz = (nM - fm) < WGM ? (nM - fm) : WGM;
        u.pm = fm + ((wgid % nig) % gsz); u.pn = (wgid % nig) / gsz; return true;
    }
};

typedef f32x4 Acc[2][2][4][2];
__device__ __forceinline__ const char* uni(const char* p) { const unsigned long long v = (unsigned long long)p; const unsigned lo = __builtin_amdgcn_readfirstlane((unsigned)v), hi = __builtin_amdgcn_readfirstlane((unsigned)(v >> 32)); return (const char*)(((unsigned long long)hi << 32) | lo); }

template <class Epi>
__device__ __forceinline__ void gemm_phase(LAS unsigned char* lds, const Gemm g, const StaticOrder& S, const Epi& E, const int tid) {
    const int wid = __builtin_amdgcn_readfirstlane(tid >> 6), lane = tid & 63, wr = wid >> 2, wc = wid & 3, fr = lane & 15, fq = lane >> 4;
    const int K = g.K, nt = K / BK;
    unsigned voffA[2], voffB[2];
#pragma unroll
    for (int i = 0; i < 2; ++i) { int R, C; stage_rc(tid * 16 + i * 8192, R, C); const int Rb = (R & ~31) + perm32(R & 31);
        voffA[i] = (unsigned)(R * g.lda + C) * 2u; voffB[i] = (unsigned)(Rb * K + C) * 2u; }
    const size_t kstep = (size_t)(BK * 2);
    const size_t hstepA = (size_t)HALF * g.lda * 2, tstepA = 2 * hstepA;
    const size_t hstepB = (size_t)HALF * K * 2, tstepB = 2 * hstepB;
    const size_t pnA = (size_t)g.a_pn_cols * 2;
    const unsigned ldsw = (unsigned)wid * 1024u;
    const int aoff = lds_byte(wr * 64 + fr, fq * 8), boff = lds_byte(wc * 32 + fr, fq * 8);
#define PG8_SA(b, h) (((b) * 2 + (h)) * HTB)
#define PG8_SB(b, h) ((4 + (b) * 2 + (h)) * HTB)
#define PG8_STAGE(bufoff, gbase, voff) do { _Pragma("unroll") for (int _i = 0; _i < 2; ++_i) \
        __builtin_amdgcn_global_load_lds((const unsigned*)((const char*)(gbase) + (voff)[_i]), (LAS unsigned*)(lds + (bufoff) + ldsw + _i * 8192), 16, 0, 0); } while (0)
#define PG8_LDA(dst, b, h) do { _Pragma("unroll") for (int m = 0; m < 4; ++m) _Pragma("unroll") for (int k = 0; k < 2; ++k) dst[m][k] = *(const LAS bf16x8*)(lds + PG8_SA(b, h) + aoff + m * 2048 + k * 1024); } while (0)
#define PG8_LDB(dst, b, h) do { _Pragma("unroll") for (int n = 0; n < 2; ++n) _Pragma("unroll") for (int k = 0; k < 2; ++k) dst[n][k] = *(const LAS bf16x8*)(lds + PG8_SB(b, h) + boff + n * 2048 + k * 1024); } while (0)
#define PG8_MMA(ai, bj, At, Bt) do { __builtin_amdgcn_s_setprio(1); _Pragma("unroll") for (int m = 0; m < 4; ++m) _Pragma("unroll") for (int n = 0; n < 2; ++n) _Pragma("unroll") for (int k = 0; k < 2; ++k) \
        acc[ai][bj][m][n] = __builtin_amdgcn_mfma_f32_16x16x32_bf16(Bt[n][k], At[m][k], acc[ai][bj][m][n], 0, 0, 0); __builtin_amdgcn_s_setprio(0); } while (0)
#define PG8_WAIT_V(n) asm volatile("s_waitcnt vmcnt(" #n ")" ::: "memory")
#define PG8_WAIT_L(n) asm volatile("s_waitcnt lgkmcnt(" #n ")" ::: "memory")
#define PG8_BAR __builtin_amdgcn_s_barrier()
#define PG8_SCHED __builtin_amdgcn_sched_barrier(0)
    Unit cur, nxt; int ui = 0;
    if (!S.next(0, cur)) return;
    LAS float* const rs_lds = (LAS float*)(lds + STAGE_BYTES + 1024); LAS float* const bias_lds = (LAS float*)(lds + STAGE_BYTES + 1024 + 2048);
    int rsbuf = 0, rspm = -1; bool rs_loaded = false;
#define PG8_RS_PREP(u) do { rs_loaded = false; if (Epi::ROWSCALE && (u).pm != rspm) { rs_loaded = true; rspm = (u).pm; rsbuf ^= 1; if (tid < 256) { const f32x4 q = ((const f32x4*)E.ssq)[rspm * BM + tid]; rs_lds[rsbuf * 256 + tid] = __builtin_amdgcn_rsqf(((q.x + q.y) + (q.z + q.w)) * (1.0f / 1024.0f) + 1e-6f); } } } while (0)
    if constexpr (Epi::NBIAS > 0) { for (int i = tid; i < Epi::NBIAS; i += 512) bias_lds[i] = E.bias_src(i); }
    PG8_RS_PREP(cur);
    Acc acc;
#pragma unroll
    for (int a = 0; a < 2; ++a)
#pragma unroll
        for (int b = 0; b < 2; ++b)
#pragma unroll
            for (int m = 0; m < 4; ++m)
#pragma unroll
                for (int n = 0; n < 2; ++n) acc[a][b][m][n] = (f32x4){0.f, 0.f, 0.f, 0.f};
    bf16x8 At[4][2], B0[2][2], B1[2][2];
    const char* cA = uni((const char*)g.A + (size_t)cur.pm * tstepA + (size_t)cur.pn * pnA); const char* cB = uni((const char*)g.Bt + (size_t)cur.pn * tstepB);
    PG8_STAGE(PG8_SB(0, 0), cB, voffB); PG8_STAGE(PG8_SB(0, 1), cB + hstepB, voffB); PG8_STAGE(PG8_SA(0, 0), cA, voffA); PG8_STAGE(PG8_SA(0, 1), cA + hstepA, voffA);
    if (wr == 1) PG8_BAR;
    PG8_WAIT_V(2); PG8_BAR;
    PG8_STAGE(PG8_SB(1, 0), cB + kstep, voffB); PG8_STAGE(PG8_SA(1, 0), cA + kstep, voffA); PG8_STAGE(PG8_SB(1, 1), cB + hstepB + kstep, voffB);
    PG8_WAIT_V(6); PG8_BAR;
    for (;;) {
        bool has_next; const char* nAb = (const char*)g.A; const char* nBb = (const char*)g.Bt;
        if constexpr (Epi::DUAL) { if ((ui & 1) == 0) { has_next = true; nxt = cur; nAb = (const char*)g.A2; nBb = (const char*)g.Bt2; } else has_next = S.next((ui + 1) >> 1, nxt); }
        else has_next = S.next(ui + 1, nxt);
        const char* nA = uni(has_next ? nAb + (size_t)nxt.pm * tstepA + (size_t)nxt.pn * pnA : cA); const char* nB = uni(has_next ? nBb + (size_t)nxt.pn * tstepB : cB);
#pragma unroll 1
        for (int t = 0; t < nt; t += 2) {
            const bool last = (t == nt - 2);
            const char* a1 = cA + (size_t)(t + 1) * kstep;
            const char* a2 = last ? nA : cA + (size_t)(t + 2) * kstep; const char* b2 = last ? nB : cB + (size_t)(t + 2) * kstep;
            const char* a3 = a2 + kstep; const char* b3 = b2 + kstep;
            const bool relax = (Epi::NSTORES > 0) && (t == 0) && (ui > 0) && !rs_loaded;
            PG8_LDB(B0, 0, 0); PG8_LDB(B1, 0, 1); PG8_SCHED; PG8_LDA(At, 0, 0); PG8_STAGE(PG8_SA(1, 1), a1 + hstepA, voffA);
            if (relax) { if constexpr (Epi::NSTORES == 8) PG8_WAIT_V(16); else PG8_WAIT_V(24); } else PG8_WAIT_V(8);
            PG8_WAIT_L(0); PG8_BAR; PG8_MMA(0, 0, At, B0); PG8_MMA(0, 1, At, B1); PG8_BAR; PG8_SCHED;
            PG8_LDA(At, 0, 1); PG8_STAGE(PG8_SB(0, 0), b2, voffB); PG8_STAGE(PG8_SB(0, 1), b2 + hstepB, voffB); PG8_STAGE(PG8_SA(0, 0), a2, voffA);
            if (relax) { if constexpr (Epi::NSTORES == 8) PG8_WAIT_V(16); else PG8_WAIT_V(24); } else PG8_WAIT_V(8);
            PG8_WAIT_L(0); PG8_BAR; PG8_MMA(1, 0, At, B0); PG8_MMA(1, 1, At, B1); PG8_BAR; PG8_SCHED;
            PG8_LDB(B0, 1, 0); PG8_LDB(B1, 1, 1); PG8_SCHED; PG8_LDA(At, 1, 0); PG8_STAGE(PG8_SA(0, 1), a2 + hstepA, voffA);
            PG8_WAIT_V(8); PG8_WAIT_L(0); PG8_BAR; PG8_MMA(0, 0, At, B0); PG8_MMA(0, 1, At, B1); PG8_BAR; PG8_SCHED;
            PG8_LDA(At, 1, 1); PG8_STAGE(PG8_SB(1, 0), b3, voffB); PG8_STAGE(PG8_SB(1, 1), b3 + hstepB, voffB); PG8_STAGE(PG8_SA(1, 0), a3, voffA);
            PG8_WAIT_V(8); PG8_WAIT_L(0); PG8_BAR; PG8_MMA(1, 0, At, B0); PG8_MMA(1, 1, At, B1); PG8_BAR; PG8_SCHED;
        }
        if (wr == 0) PG8_BAR;
        bool midunit = false;
        if constexpr (Epi::DUAL) { midunit = ((ui & 1) == 0); if (midunit) E.mid(acc, cur, wr, wc, fr, fq); else E(acc, cur, wr, wc, fr, fq, rs_lds + rsbuf * 256, bias_lds); }
        else E(acc, cur, wr, wc, fr, fq, rs_lds + rsbuf * 256, bias_lds);
        if (!has_next) break;
        if (!midunit) {
#pragma unroll
        for (int a = 0; a < 2; ++a)
#pragma unroll
            for (int b = 0; b < 2; ++b)
#pragma unroll
                for (int m = 0; m < 4; ++m)
#pragma unroll
                    for (int n = 0; n < 2; ++n) acc[a][b][m][n] = (f32x4){0.f, 0.f, 0.f, 0.f};
        }
        cur = nxt; cA = nA; cB = nB; ++ui;
        PG8_RS_PREP(cur);
        if (wr == 1) PG8_BAR;
    }
    PG8_WAIT_V(0);
    PG8_BAR;
#undef PG8_RS_PREP
#undef PG8_SA
#undef PG8_SB
#undef PG8_STAGE
#undef PG8_LDA
#undef PG8_LDB
#undef PG8_MMA
#undef PG8_WAIT_V
#undef PG8_WAIT_L
#undef PG8_BAR
#undef PG8_SCHED
}

__device__ __forceinline__ u32x4 pack8(const f32x4 v0, const f32x4 v1) { u32x4 w; w.x = cvt_pk_bf16(v0[0], v0[1]); w.y = cvt_pk_bf16(v0[2], v0[3]); w.z = cvt_pk_bf16(v1[0], v1[1]); w.w = cvt_pk_bf16(v1[2], v1[3]); return w; }

__device__ __forceinline__ float row_scale(const float* ssq, int row) { return __builtin_amdgcn_rsqf(ssq[row] * (1.0f / D) + EPS); }
struct EpiSwiglu {
    static constexpr bool DUAL = false; static constexpr bool ROWSCALE = true; static constexpr int NBIAS = 0, NSTORES = 8;
    bf16_t* O; const float* ssq;
    __device__ __forceinline__ void operator()(const Acc& acc, const Unit& u, int wr, int wc, int fr, int fq, const LAS float* rsl, const LAS float* bl) const {
        const int row0 = u.pm * BM + wr * 64 + fr, col0 = u.pn * HALF + wc * 32 + 8 * fq;
        float rs[2][4];
#pragma unroll
        for (int ai = 0; ai < 2; ++ai)
#pragma unroll
            for (int m = 0; m < 4; ++m) rs[ai][m] = rsl[ai * HALF + wr * 64 + m * 16 + fr];
#pragma unroll
        for (int ai = 0; ai < 2; ++ai)
#pragma unroll
            for (int m = 0; m < 4; ++m) {
                f32x4 v[2];
#pragma unroll
                for (int n = 0; n < 2; ++n) { const f32x4 gt = acc[ai][0][m][n] * rs[ai][m], up = acc[ai][1][m][n] * rs[ai][m];
#pragma unroll
                    for (int j = 0; j < 4; ++j) v[n][j] = gt[j] * sigmoid_f(gt[j]) * up[j]; }
                *(u32x4*)(O + (size_t)(row0 + ai * HALF + m * 16) * FF + col0) = pack8(v[0], v[1]);
            }
    }
};
struct EpiH {
    static constexpr bool DUAL = false; static constexpr bool ROWSCALE = false; static constexpr int NBIAS = 0, NSTORES = 16;
    bf16_t* C; const float* ssq;
    __device__ __forceinline__ void operator()(const Acc& acc, const Unit& u, int wr, int wc, int fr, int fq, const LAS float* rsl, const LAS float* bl) const {
        const int row0 = u.pm * BM + wr * 64 + fr, col0 = u.pn * BM + wc * 32 + 8 * fq;
#pragma unroll
        for (int ai = 0; ai < 2; ++ai)
#pragma unroll
            for (int m = 0; m < 4; ++m) { bf16_t* rowp = C + (size_t)(row0 + ai * HALF + m * 16) * D + col0;
#pragma unroll
                for (int bj = 0; bj < 2; ++bj) *(u32x4*)(rowp + bj * HALF) = pack8(acc[ai][bj][m][0], acc[ai][bj][m][1]); }
    }
};
__device__ __forceinline__ void unpack8v(const u32x4 q, f32x4& a, f32x4& b) { a = (f32x4){bf_lo(q.x), bf_hi(q.x), bf_lo(q.y), bf_hi(q.y)}; b = (f32x4){bf_lo(q.z), bf_hi(q.z), bf_lo(q.w), bf_hi(q.w)}; }
template <bool FINAL> struct EpiResid {
    static constexpr bool DUAL = false; static constexpr bool ROWSCALE = false; static constexpr int NBIAS = 0, NSTORES = 0;
    bf16_t* Xb; const float* post; float cs; float* ssq4; float* outp; float* xbuf; unsigned* cnt; const float* ssq;
    __device__ __forceinline__ void operator()(const Acc& acc, const Unit& u, int wr, int wc, int fr, int fq, const LAS float* rsl, const LAS float* bl) const {
        LAS float* P = (LAS float*)bl; LAS float* S = P + 1024;
        float* const outf = FINAL ? outp : nullptr;
        const int lane = fr + 16 * fq, wave = wr * 4 + wc, tid = wave * 64 + lane;
#pragma unroll
        for (int ai = 0; ai < 2; ++ai)
#pragma unroll
            for (int m = 0; m < 4; ++m) { float q = 0.f;
#pragma unroll
                for (int bj = 0; bj < 2; ++bj)
#pragma unroll
                    for (int n = 0; n < 2; ++n) { const f32x4 x = acc[ai][bj][m][n]; q += (x[0] * x[0] + x[1] * x[1]) + (x[2] * x[2] + x[3] * x[3]); }
                q += __builtin_bit_cast(float, __builtin_amdgcn_ds_bpermute((lane ^ 16) << 2, __builtin_bit_cast(int, q)));
                q += __builtin_bit_cast(float, __builtin_amdgcn_ds_bpermute((lane ^ 32) << 2, __builtin_bit_cast(int, q)));
                if (fq == 0) P[(ai * HALF + wr * 64 + m * 16 + fr) * 4 + wc] = q; }
        asm volatile("s_waitcnt lgkmcnt(0)" ::: "memory"); __builtin_amdgcn_s_barrier(); asm volatile("" ::: "memory");
        const int row0 = u.pm * BM + wr * 64 + fr, col0 = u.pn * BM + wc * 32 + 8 * fq;
        f32x4 pv[2][2];
#pragma unroll
        for (int bj = 0; bj < 2; ++bj)
#pragma unroll
            for (int n = 0; n < 2; ++n) pv[bj][n] = *(const f32x4*)(post + col0 + bj * HALF + 4 * n) * cs;
        u32x4 xq0[2][2];
#pragma unroll
        for (int m = 0; m < 2; ++m)
#pragma unroll
            for (int bj = 0; bj < 2; ++bj) xq0[m][bj] = *(const u32x4*)(Xb + (size_t)(row0 + m * 16) * D + col0 + bj * HALF);
        float* slot = xbuf + ((size_t)u.pm * BM) * 4 + u.pn;
        if (tid < 256) { const float t4 = (P[tid * 4 + 0] + P[tid * 4 + 1]) + (P[tid * 4 + 2] + P[tid * 4 + 3]);
            __hip_atomic_store(slot + tid * 4, t4, __ATOMIC_RELAXED, __HIP_MEMORY_SCOPE_AGENT); }
        asm volatile("s_waitcnt vmcnt(0)" ::: "memory");
        unsigned* c = cnt + u.pm * 16;
        if (tid < 256 && lane == 0) __hip_atomic_fetch_add(c, 1u, __ATOMIC_RELAXED, __HIP_MEMORY_SCOPE_AGENT);
        if (wave == 0) { unsigned n = 0;
            while ((unsigned)__builtin_amdgcn_readfirstlane(__hip_atomic_load(c, __ATOMIC_RELAXED, __HIP_MEMORY_SCOPE_AGENT)) < 16u) { __builtin_amdgcn_s_sleep(1); if (++n > (1u << 22)) break; }
            __builtin_amdgcn_fence(__ATOMIC_ACQUIRE, "agent"); asm volatile("s_waitcnt vmcnt(0)" ::: "memory"); }
        asm volatile("s_waitcnt vmcnt(0) lgkmcnt(0)" ::: "memory"); __builtin_amdgcn_s_barrier(); asm volatile("" ::: "memory");
        if (tid < 256) { const float* sl = xbuf + ((size_t)u.pm * BM + tid) * 4; float t4 = 0.f;
#pragma unroll
            for (int k = 0; k < 4; ++k) t4 += __hip_atomic_load(sl + k, __ATOMIC_RELAXED, __HIP_MEMORY_SCOPE_AGENT);
            S[tid] = 1.0f / sqrtf(t4 * (1.0f / 1024.0f) + 1e-6f); }
        asm volatile("s_waitcnt vmcnt(0) lgkmcnt(0)" ::: "memory"); __builtin_amdgcn_s_barrier(); asm volatile("" ::: "memory");
#pragma unroll
        for (int ai = 0; ai < 2; ++ai)
#pragma unroll
          for (int mh = 0; mh < 2; ++mh) {
            u32x4 xq[4][2];
#pragma unroll
            for (int m = 2 * mh; m < 2 * mh + 2; ++m)
#pragma unroll
                for (int bj = 0; bj < 2; ++bj) xq[m][bj] = (ai == 0 && mh == 0) ? xq0[m][bj] : *(const u32x4*)(Xb + (size_t)(row0 + ai * HALF + m * 16) * D + col0 + bj * HALF);
#pragma unroll
            for (int m = 2 * mh; m < 2 * mh + 2; ++m) { const int rl = ai * HALF + wr * 64 + m * 16 + fr; const float r1 = S[rl]; float q2 = 0.f;
#pragma unroll
                for (int bj = 0; bj < 2; ++bj) { f32x4 x0, x1; unpack8v(xq[m][bj], x0, x1);
                    x0 = x0 + acc[ai][bj][m][0] * r1 * pv[bj][0]; x1 = x1 + acc[ai][bj][m][1] * r1 * pv[bj][1];
                    if constexpr (FINAL) { float* o = outf + (size_t)(row0 + ai * HALF + m * 16) * D + col0 + bj * HALF; *(f32x4*)o = x0; *(f32x4*)(o + 4) = x1; }
                    else { const u32x4 w = pack8(x0, x1); *(u32x4*)(Xb + (size_t)(row0 + ai * HALF + m * 16) * D + col0 + bj * HALF) = w;
                        f32x4 y0, y1; unpack8v(w, y0, y1); q2 += ((y0[0] * y0[0] + y0[1] * y0[1]) + (y0[2] * y0[2] + y0[3] * y0[3])) + ((y1[0] * y1[0] + y1[1] * y1[1]) + (y1[2] * y1[2] + y1[3] * y1[3])); } }
                if constexpr (!FINAL) { q2 += __builtin_bit_cast(float, __builtin_amdgcn_ds_bpermute((lane ^ 16) << 2, __builtin_bit_cast(int, q2)));
                    q2 += __builtin_bit_cast(float, __builtin_amdgcn_ds_bpermute((lane ^ 32) << 2, __builtin_bit_cast(int, q2)));
                    if (fq == 0) P[rl * 4 + wc] = q2; } }
        }
        if constexpr (!FINAL) {
            asm volatile("s_waitcnt lgkmcnt(0)" ::: "memory"); __builtin_amdgcn_s_barrier(); asm volatile("" ::: "memory");
            if (tid < 256) ssq4[((size_t)u.pm * BM + tid) * 4 + u.pn] = (P[tid * 4 + 0] + P[tid * 4 + 1]) + (P[tid * 4 + 2] + P[tid * 4 + 3]);
        }
        asm volatile("s_waitcnt lgkmcnt(0)" ::: "memory"); __builtin_amdgcn_s_barrier(); asm volatile("" ::: "memory");
    }
};
struct EpiWin {
    static constexpr bool DUAL = false; static constexpr bool ROWSCALE = true; static constexpr int NBIAS = 2048, NSTORES = 8;
    bf16_t *ZB, *ZCV, *ZP, *ZG; const float* bgate; const float* ssq;
    __device__ __forceinline__ float bias_src(int i) const { return bgate[i]; }
    __device__ __forceinline__ void operator()(const Acc& acc, const Unit& u, int wr, int wc, int fr, int fq, const LAS float* rsl, const LAS float* bl) const {
        const int row0 = u.pm * BM + wr * 64 + fr, pn = u.pn, cw = wc * 32 + 8 * fq;
        float rs[2][4];
#pragma unroll
        for (int ai = 0; ai < 2; ++ai)
#pragma unroll
            for (int m = 0; m < 4; ++m) rs[ai][m] = rsl[ai * HALF + wr * 64 + m * 16 + fr];
        if (pn >= 4 && pn < 12) {
            const int col0 = (pn - 4) * HALF + cw;
#pragma unroll
            for (int ai = 0; ai < 2; ++ai)
#pragma unroll
                for (int m = 0; m < 4; ++m) { const float r2 = rs[ai][m] * rs[ai][m];
                    *(u32x4*)(ZCV + (size_t)(row0 + ai * HALF + m * 16) * D + col0) = pack8(acc[ai][0][m][0] * acc[ai][1][m][0] * r2, acc[ai][0][m][1] * acc[ai][1][m][1] * r2); }
        } else if (pn < 16) {
            bf16_t* base = pn < 4 ? ZB : ZP; const int col0 = (pn < 4 ? pn : pn - 12) * BM + cw;
#pragma unroll
            for (int ai = 0; ai < 2; ++ai)
#pragma unroll
                for (int m = 0; m < 4; ++m) { bf16_t* rowp = base + (size_t)(row0 + ai * HALF + m * 16) * D + col0;
#pragma unroll
                    for (int bj = 0; bj < 2; ++bj) *(u32x4*)(rowp + bj * HALF) = pack8(acc[ai][bj][m][0] * rs[ai][m], acc[ai][bj][m][1] * rs[ai][m]); }
        } else {
            const int col0 = (pn - 16) * BM + cw;
            f32x4 bv[2][2];
#pragma unroll
            for (int bj = 0; bj < 2; ++bj)
#pragma unroll
                for (int n = 0; n < 2; ++n) bv[bj][n] = *(const LAS f32x4*)(bl + col0 + bj * HALF + 4 * n);
#pragma unroll
            for (int ai = 0; ai < 2; ++ai)
#pragma unroll
                for (int m = 0; m < 4; ++m) { bf16_t* rowp = ZG + (size_t)(row0 + ai * HALF + m * 16) * 2048 + col0;
#pragma unroll
                    for (int bj = 0; bj < 2; ++bj) { f32x4 v[2];
#pragma unroll
                        for (int n = 0; n < 2; ++n) { const f32x4 a = acc[ai][bj][m][n] * rs[ai][m] + bv[bj][n];
#pragma unroll
                            for (int j = 0; j < 4; ++j) v[n][j] = sigmoid_f(a[j]); }
                        *(u32x4*)(rowp + bj * HALF) = pack8(v[0], v[1]); } }
        }
    }
};
struct EpiPoolGroup {
    static constexpr bool DUAL = false; static constexpr bool ROWSCALE = false; static constexpr int NBIAS = 2048, NSTORES = 16;
    bf16_t* O; const float* bias; const float* scale; const float* ssq;
    __device__ __forceinline__ float bias_src(int i) const { return i < 1024 ? bias[i] : scale[i - 1024]; }
    __device__ __forceinline__ void operator()(const Acc& acc, const Unit& u, int wr, int wc, int fr, int fq, const LAS float* rsl, const LAS float* bl) const {
        const int row0 = u.pm * BM + wr * 64 + fr, col0 = u.pn * BM + wc * 32 + 8 * fq;
        f32x4 bv[2][2], sv[2][2];
#pragma unroll
        for (int bj = 0; bj < 2; ++bj)
#pragma unroll
            for (int n = 0; n < 2; ++n) { bv[bj][n] = *(const LAS f32x4*)(bl + col0 + bj * HALF + 4 * n); sv[bj][n] = *(const LAS f32x4*)(bl + 1024 + col0 + bj * HALF + 4 * n); }
#pragma unroll
        for (int ai = 0; ai < 2; ++ai)
#pragma unroll
            for (int m = 0; m < 4; ++m) { bf16_t* rowp = O + (size_t)(row0 + ai * HALF + m * 16) * D + col0;
#pragma unroll
                for (int bj = 0; bj < 2; ++bj) *(u32x4*)(rowp + bj * HALF) = pack8((acc[ai][bj][m][0] + bv[bj][0]) * sv[bj][0], (acc[ai][bj][m][1] + bv[bj][1]) * sv[bj][1]); }
    }
};
struct EpiGateA {
    static constexpr bool DUAL = false; static constexpr bool ROWSCALE = false; static constexpr int NBIAS = 0, NSTORES = 16;
    const bf16_t* ZG; bf16_t* M1; const float* ssq;
    __device__ __forceinline__ void operator()(const Acc& acc, const Unit& u, int wr, int wc, int fr, int fq, const LAS float* rsl, const LAS float* bl) const {
        const int row0 = u.pm * BM + wr * 64 + fr, col0 = u.pn * BM + wc * 32 + 8 * fq;
#pragma unroll
        for (int ai = 0; ai < 2; ++ai) {
            u32x4 gq[4][2];
#pragma unroll
            for (int m = 0; m < 4; ++m)
#pragma unroll
                for (int bj = 0; bj < 2; ++bj) gq[m][bj] = *(const u32x4*)(ZG + (size_t)(row0 + ai * HALF + m * 16) * 2048 + col0 + bj * HALF);
#pragma unroll
            for (int m = 0; m < 4; ++m)
#pragma unroll
                for (int bj = 0; bj < 2; ++bj) { f32x4 g0, g1; unpack8v(gq[m][bj], g0, g1);
                    *(u32x4*)(M1 + (size_t)(row0 + ai * HALF + m * 16) * D + col0 + bj * HALF) = pack8(g0 * acc[ai][bj][m][0], g1 * acc[ai][bj][m][1]); }
        }
    }
};
struct EpiGateP {
    static constexpr bool DUAL = false; static constexpr bool ROWSCALE = false; static constexpr int NBIAS = 0, NSTORES = 16;
    const bf16_t* ZG; const bf16_t* M1; bf16_t* MM; const float* ssq;
    __device__ __forceinline__ void operator()(const Acc& acc, const Unit& u, int wr, int wc, int fr, int fq, const LAS float* rsl, const LAS float* bl) const {
        const int row0 = u.pm * BM + wr * 64 + fr, col0 = u.pn * BM + wc * 32 + 8 * fq;
#pragma unroll
        for (int ai = 0; ai < 2; ++ai) {
            u32x4 gq[4][2], mq[4][2];
#pragma unroll
            for (int m = 0; m < 4; ++m)
#pragma unroll
                for (int bj = 0; bj < 2; ++bj) { const size_t r = (size_t)(row0 + ai * HALF + m * 16);
                    gq[m][bj] = *(const u32x4*)(ZG + r * 2048 + D + col0 + bj * HALF); mq[m][bj] = *(const u32x4*)(M1 + r * D + col0 + bj * HALF); }
#pragma unroll
            for (int m = 0; m < 4; ++m)
#pragma unroll
                for (int bj = 0; bj < 2; ++bj) { f32x4 g0, g1, m0, m1; unpack8v(gq[m][bj], g0, g1); unpack8v(mq[m][bj], m0, m1);
                    *(u32x4*)(MM + (size_t)(row0 + ai * HALF + m * 16) * D + col0 + bj * HALF) = pack8(m0 + g0 * acc[ai][bj][m][0], m1 + g1 * acc[ai][bj][m][1]); }
        }
    }
};
struct EpiDual {
    static constexpr bool DUAL = true; static constexpr bool ROWSCALE = false; static constexpr int NBIAS = 0, NSTORES = 16;
    const bf16_t* ZG; bf16_t* MM; const float* ssq;
    __device__ __forceinline__ void mid(Acc& acc, const Unit& u, int wr, int wc, int fr, int fq) const {
        const int row0 = u.pm * BM + wr * 64 + fr, col0 = u.pn * BM + wc * 32 + 8 * fq;
#pragma unroll
        for (int ai = 0; ai < 2; ++ai) {
            u32x4 ga[4][2], gp[4][2];
#pragma unroll
            for (int m = 0; m < 4; ++m)
#pragma unroll
                for (int bj = 0; bj < 2; ++bj) { const bf16_t* p = ZG + (size_t)(row0 + ai * HALF + m * 16) * 2048 + col0 + bj * HALF; ga[m][bj] = *(const u32x4*)p; gp[m][bj] = *(const u32x4*)(p + D); }
#pragma unroll
            for (int m = 0; m < 4; ++m)
#pragma unroll
                for (int bj = 0; bj < 2; ++bj) { f32x4 a0, a1, p0, p1; unpack8v(ga[m][bj], a0, a1); unpack8v(gp[m][bj], p0, p1);
#pragma unroll
                    for (int j = 0; j < 4; ++j) { acc[ai][bj][m][0][j] *= a0[j] * __builtin_amdgcn_rcpf(fmaxf(p0[j], 1e-30f)); acc[ai][bj][m][1][j] *= a1[j] * __builtin_amdgcn_rcpf(fmaxf(p1[j], 1e-30f)); } }
        }
    }
    __device__ __forceinline__ void operator()(const Acc& acc, const Unit& u, int wr, int wc, int fr, int fq, const LAS float* rsl, const LAS float* bl) const {
        const int row0 = u.pm * BM + wr * 64 + fr, col0 = u.pn * BM + wc * 32 + 8 * fq;
#pragma unroll
        for (int ai = 0; ai < 2; ++ai) {
            u32x4 gp[4][2];
#pragma unroll
            for (int m = 0; m < 4; ++m)
#pragma unroll
                for (int bj = 0; bj < 2; ++bj) gp[m][bj] = *(const u32x4*)(ZG + (size_t)(row0 + ai * HALF + m * 16) * 2048 + D + col0 + bj * HALF);
#pragma unroll
            for (int m = 0; m < 4; ++m)
#pragma unroll
                for (int bj = 0; bj < 2; ++bj) { f32x4 p0, p1; unpack8v(gp[m][bj], p0, p1);
#pragma unroll
                    for (int j = 0; j < 4; ++j) { p0[j] = fmaxf(p0[j], 1e-30f); p1[j] = fmaxf(p1[j], 1e-30f); }
                    *(u32x4*)(MM + (size_t)(row0 + ai * HALF + m * 16) * D + col0 + bj * HALF) = pack8(p0 * acc[ai][bj][m][0], p1 * acc[ai][bj][m][1]); }
        }
    }
};
}


#define XB_TMO      128
#define XB_XCNT(j)  (256  + 64 * (j))
#define XB_XSUB(j)  (1280 + 64 * (j))
#define XB_XGEN(j)  (2304 + 64 * (j))
#define XB_TOP      3328
#define XB_TOPGEN   3392
#define XCD_BAR_WORDS 3456
#define XB_SPIN_CAP (1u << 18)

__device__ __forceinline__ unsigned xb_ld(unsigned* p)              { return __hip_atomic_load(p, __ATOMIC_RELAXED, __HIP_MEMORY_SCOPE_AGENT); }
__device__ __forceinline__ unsigned xb_add(unsigned* p, unsigned v) { return __hip_atomic_fetch_add(p, v, __ATOMIC_RELAXED, __HIP_MEMORY_SCOPE_AGENT); }
__device__ __forceinline__ unsigned xb_xcc_id() { return (unsigned)__builtin_amdgcn_s_getreg((3 << 11) | 20) & 0xFu; }
#define XB_SPIN(cond, bar) do { unsigned _sp = 0; while (cond) { __builtin_amdgcn_s_sleep(1); \
    if ((++_sp & 255u) == 0u) { if (xb_ld(&(bar)[XB_TMO])) break; if (_sp > XB_SPIN_CAP) { atomicAdd(&(bar)[XB_TMO], 1u); break; } } } } while (0)

__device__ __forceinline__ bool xb_is_thread0(int wave) { int t; asm volatile("v_mbcnt_lo_u32_b32 %0, -1, 0\n\tv_mbcnt_hi_u32_b32 %0, -1, %0" : "=v"(t)); return t == 0 && wave == 0; }
struct XcdBarrier {
    unsigned* bar; unsigned x;
    volatile LAS unsigned* st;
};

__device__ __forceinline__ XcdBarrier xcd_barrier_post(unsigned* bar, volatile LAS unsigned* st) {
    XcdBarrier b; b.bar = bar; b.x = xb_xcc_id(); b.st = st;
    if (threadIdx.x == 0) (void)xb_add(&bar[XB_XCNT(b.x)], 1u);
    return b;
}
__device__ __forceinline__ void xcd_barrier_complete(unsigned* bar, unsigned x, unsigned& nloc, unsigned& nx) {
    const unsigned G = gridDim.x * gridDim.y * gridDim.z;
    unsigned sum, cnt, mine, sp = 0u;
    for (;;) {
        sum = 0u; cnt = 0u; mine = 0u;
#pragma unroll
        for (unsigned j = 0; j < 16; ++j) { const unsigned c = xb_ld(&bar[XB_XCNT(j)]); sum += c; cnt += (c > 0u) ? 1u : 0u; mine = (j == x) ? c : mine; }
        if (sum == G) break;
        __builtin_amdgcn_s_sleep(1);
        if ((++sp & 255u) == 0u) { if (xb_ld(&bar[XB_TMO])) break; if (sp > XB_SPIN_CAP) { atomicAdd(&bar[XB_TMO], 1u); break; } }
    }
    nloc = mine > 0u ? mine : 1u; nx = cnt > 0u ? cnt : 1u;
}

__device__ __forceinline__ void xcd_barrier(const XcdBarrier& b, int wave) {
    asm volatile("s_waitcnt vmcnt(0)" ::: "memory");
    __syncthreads();
    if (xb_is_thread0(wave)) {
        unsigned* bar = b.bar;
        __builtin_amdgcn_s_waitcnt(0);
        unsigned nloc = b.st[0], nx = b.st[1];
        if (nloc == 0u) { xcd_barrier_complete(bar, b.x, nloc, nx); b.st[0] = nloc; b.st[1] = nx; }
        const unsigned old = xb_add(&bar[XB_XSUB(b.x)], 1u);
        const unsigned gen = old / nloc;
        if (old + 1u == (gen + 1u) * nloc) {
            __builtin_amdgcn_fence(__ATOMIC_RELEASE, "agent");
            asm volatile("s_waitcnt vmcnt(0)" ::: "memory");
            const unsigned og = xb_add(&bar[XB_TOP], 1u);
            const unsigned tg = og / nx;
            if (og + 1u == (tg + 1u) * nx) xb_add(&bar[XB_TOPGEN], 1u);
            else XB_SPIN(xb_ld(&bar[XB_TOPGEN]) == tg, bar);
            __builtin_amdgcn_fence(__ATOMIC_ACQUIRE, "agent");
            xb_add(&bar[XB_XGEN(b.x)], 1u);
            asm volatile("s_waitcnt vmcnt(0)" ::: "memory");
        } else {
            XB_SPIN(xb_ld(&bar[XB_XGEN(b.x)]) == gen, bar);
            __builtin_amdgcn_fence(__ATOMIC_ACQUIRE, "agent");
            asm volatile("s_waitcnt vmcnt(0)" ::: "memory");
        }
    }
    __syncthreads();
}

struct Args { const float* in[20]; float* out; unsigned char* ws; int ph_lo, ph_hi; };
struct Ctx { LAS unsigned char* lds; int lane, wave, gw, NGW, G, bid; };

__device__ __forceinline__ void transpose_item(const float* W, int ldsrc, int K, int src_col0, bf16_t* WT, int dst_row0, int k0, const float* kscale, LAS float* scr, int lane) {
    {
        const int kr = lane >> 3, n4 = (lane & 7) * 4; f32x4 v[8];
#pragma unroll
        for (int i = 0; i < 8; ++i) v[i] = *(const f32x4*)(W + (size_t)(k0 + 8 * i + kr) * ldsrc + src_col0 + n4);
#pragma unroll
        for (int i = 0; i < 8; ++i) { const int kk = 8 * i + kr; const float sc = kscale ? kscale[k0 + kk] : 1.0f; LAS float* d = scr + kk * 33 + n4;
            d[0] = v[i].x * sc; d[1] = v[i].y * sc; d[2] = v[i].z * sc; d[3] = v[i].w * sc; }
    }
    LDS_WAIT(); asm volatile("" ::: "memory");
    const int c = lane & 7;
#pragma unroll
    for (int j = 0; j < 4; ++j) { const int n = (lane >> 3) + 8 * j; const LAS float* sp = scr + (8 * c) * 33 + n;
        u32x4 o; o.x = cvt_pk_bf16(sp[0 * 33], sp[1 * 33]); o.y = cvt_pk_bf16(sp[2 * 33], sp[3 * 33]); o.z = cvt_pk_bf16(sp[4 * 33], sp[5 * 33]); o.w = cvt_pk_bf16(sp[6 * 33], sp[7 * 33]);
        *(u32x4*)(WT + (size_t)(dst_row0 + n) * K + k0 + 8 * c) = o; }
    LDS_WAIT(); asm volatile("" ::: "memory");
}
__device__ __forceinline__ int map_gu(int n) { return ((n >> 7) & 1) * FF + (n >> 8) * 128 + (n & 127); }
__device__ __forceinline__ int map_in(int n) { if (n < 1024 || n >= 3072) return n; const int q = (n - 1024) >> 8, h = (n >> 7) & 1; return (h ? 2048 : 1024) + q * 128 + (n & 127); }

__device__ __forceinline__ void prep_weights(const Ctx& F, const Args& a, unsigned char* ws, int l) {
    LAS float* scr = (LAS float*)(F.lds + F.wave * 16384);
    constexpr int I_GU = (D / 64) * (NGU / 32), I_D = (FF / 64) * (D / 32), I_IN = (D / 64) * (NIN / 32), I_SQ = (D / 64) * (D / 32), I_PG = 4 * (256 / 64) * (256 / 32);
    constexpr int NITEMS = 2 * I_GU + 2 * I_D + I_IN + 3 * I_SQ + I_PG;
    for (int it = F.gw; it < NITEMS; it += F.NGW) {
        int r = it;
        if (r < 2 * I_GU) { const int w = r / I_GU; r -= w * I_GU; const int kb = r / (NGU / 32), nb = r % (NGU / 32);
            transpose_item(a.in[w ? 18 : 3] + (size_t)l * D * NGU, NGU, D, map_gu(32 * nb), (bf16_t*)(ws + (w ? W_GU2 : W_GU1)), 32 * nb, 64 * kb, a.in[w ? 16 : 1] + l * D, scr, F.lane); continue; }
        r -= 2 * I_GU;
        if (r < 2 * I_D) { const int w = r / I_D; r -= w * I_D; const int kb = r / (D / 32), nb = r % (D / 32);
            transpose_item(a.in[w ? 19 : 4] + (size_t)l * FF * D, D, FF, 32 * nb, (bf16_t*)(ws + (w ? W_D2 : W_D1)), 32 * nb, 64 * kb, nullptr, scr, F.lane); continue; }
        r -= 2 * I_D;
        if (r < I_IN) { const int kb = r / (NIN / 32), nb = r % (NIN / 32);
            transpose_item(a.in[7] + (size_t)l * D * NIN, NIN, D, map_in(32 * nb), (bf16_t*)(ws + W_IN), 32 * nb, 64 * kb, a.in[5] + l * D, scr, F.lane); continue; }
        r -= I_IN;
        if (r < 3 * I_SQ) { const int w = r / I_SQ; r -= w * I_SQ; const int kb = r / (D / 32), nb = r % (D / 32);
            transpose_item(a.in[w == 0 ? 10 : (w == 1 ? 14 : 15)] + (size_t)l * D * D, D, D, 32 * nb, (bf16_t*)(ws + (w == 0 ? W_CO : (w == 1 ? W_PO : W_WO))), 32 * nb, 64 * kb, nullptr, scr, F.lane); continue; }
        r -= 3 * I_SQ;
        { const int gi = r / 32; r -= gi * 32; const int kb = r / 8, nb = r % 8;
            transpose_item(a.in[11] + (size_t)l * 4 * 65536 + (size_t)gi * 65536, 256, 256, 32 * nb, (bf16_t*)(ws + W_PG), gi * 256 + 32 * nb, 64 * kb, nullptr, scr, F.lane); }
    }
}

__device__ __forceinline__ void cast_rows(const Ctx& F, const float* x, bf16_t* Xb, float* ssq) {
    for (int m = F.gw; m < M; m += F.NGW) {
        const f32x4* xr = (const f32x4*)(x + (size_t)m * D) + F.lane;
        f32x4 v[4]; float s = 0.f;
#pragma unroll
        for (int j = 0; j < 4; ++j) { v[j] = xr[64 * j]; s += (v[j].x * v[j].x + v[j].y * v[j].y) + (v[j].z * v[j].z + v[j].w * v[j].w); }
        s = wave_sum(s, F.lane);
        u32x2* o = (u32x2*)(Xb + (size_t)m * D) + F.lane;
#pragma unroll
        for (int j = 0; j < 4; ++j) { u32x2 w; w.x = cvt_pk_bf16(v[j].x, v[j].y); w.y = cvt_pk_bf16(v[j].z, v[j].w); o[64 * j] = w; }
        if (F.lane == 0) ((f32x4*)ssq)[m] = (f32x4){s, 0.f, 0.f, 0.f};
    }
}
__device__ __forceinline__ void resid_rows(const Ctx& F, bf16_t* Xb, const bf16_t* h, const float* post, float cs, float* ssq, float* outf) {
    f32x4 pv[4];
#pragma unroll
    for (int j = 0; j < 4; ++j) pv[j] = ((const f32x4*)post)[F.lane + 64 * j] * cs;
    for (int m0 = F.gw; m0 < M; m0 += 2 * F.NGW) {
        const int m1 = m0 + F.NGW; const bool two = m1 < M; const int mb = two ? m1 : m0;
        f32x4 hv[2][4], xv[2][4];
#pragma unroll
        for (int r = 0; r < 2; ++r) { const int m = r ? mb : m0;
            const u32x2* hr = (const u32x2*)(h + (size_t)m * D) + F.lane; const u32x2* xr = (const u32x2*)(Xb + (size_t)m * D) + F.lane;
#pragma unroll
            for (int j = 0; j < 4; ++j) { const u32x2 q = hr[64 * j]; hv[r][j] = (f32x4){bf_lo(q.x), bf_hi(q.x), bf_lo(q.y), bf_hi(q.y)};
                const u32x2 p = xr[64 * j]; xv[r][j] = (f32x4){bf_lo(p.x), bf_hi(p.x), bf_lo(p.y), bf_hi(p.y)}; } }
#pragma unroll
        for (int r = 0; r < 2; ++r) { const int m = r ? mb : m0; if (r && !two) break;
            float s = 0.f;
#pragma unroll
            for (int j = 0; j < 4; ++j) s += (hv[r][j].x * hv[r][j].x + hv[r][j].y * hv[r][j].y) + (hv[r][j].z * hv[r][j].z + hv[r][j].w * hv[r][j].w);
            const float r1 = 1.0f / sqrtf(wave_sum(s, F.lane) * (1.f / D) + EPS);
            if (outf) {
                f32x4* xo = (f32x4*)(outf + (size_t)m * D) + F.lane;
#pragma unroll
                for (int j = 0; j < 4; ++j) xo[64 * j] = xv[r][j] + hv[r][j] * r1 * pv[j];
            } else {
                float s2 = 0.f;
                u32x2* o = (u32x2*)(Xb + (size_t)m * D) + F.lane;
#pragma unroll
                for (int j = 0; j < 4; ++j) { const f32x4 xn = xv[r][j] + hv[r][j] * r1 * pv[j]; u32x2 w; w.x = cvt_pk_bf16(xn.x, xn.y); w.y = cvt_pk_bf16(xn.z, xn.w); o[64 * j] = w;
                    const f32x4 xr_ = {bf_lo(w.x), bf_hi(w.x), bf_lo(w.y), bf_hi(w.y)};
                    s2 += (xr_.x * xr_.x + xr_.y * xr_.y) + (xr_.z * xr_.z + xr_.w * xr_.w); }
                s2 = wave_sum(s2, F.lane);
                if (F.lane == 0) ssq[m] = s2;
            }
        }
    }
}
__device__ __forceinline__ void unpack8(const u32x4 q, float (&f)[8]) { f[0] = bf_lo(q.x); f[1] = bf_hi(q.x); f[2] = bf_lo(q.y); f[3] = bf_hi(q.y); f[4] = bf_lo(q.z); f[5] = bf_hi(q.z); f[6] = bf_lo(q.w); f[7] = bf_hi(q.w); }
__device__ __forceinline__ void mix_rows(const Ctx& F, bf16_t* ZBCA, const bf16_t* ZCV, const bf16_t* ZP, const float* convw, bf16_t* DDo) {
    const int half = F.gw & 1, c0 = half * 512 + F.lane * 8;
    const int npair = F.NGW >> 1, tpw = M / npair, t0 = (F.gw >> 1) * tpw;
    float w0[8], w1[8], w2[8];
#pragma unroll
    for (int j = 0; j < 8; ++j) { w0[j] = convw[c0 + j]; w1[j] = convw[D + c0 + j]; w2[j] = convw[2 * D + c0 + j]; }
    const int win = 2 << (c0 >> 8), wmax = half ? 16 : 4;
    const u32x4 zero = {0u, 0u, 0u, 0u};
    const int s0 = t0 & (SEQ - 1);
    const size_t off0 = (size_t)t0 * D + c0;
    float acc[8], cm1[8], cm2[8];
#pragma unroll
    for (int j = 0; j < 8; ++j) acc[j] = 0.f;
    for (int k = 1; k < wmax; ++k) {
        const bool ok = (k < win) && (s0 >= k);
        const u32x4 q = ok ? *(const u32x4*)(ZP + off0 - (size_t)k * D) : zero;
        float f[8]; unpack8(q, f);
#pragma unroll
        for (int j = 0; j < 8; ++j) acc[j] += f[j];
    }
    { const u32x4 q1 = s0 >= 1 ? *(const u32x4*)(ZCV + off0 - D) : zero, q2 = s0 >= 2 ? *(const u32x4*)(ZCV + off0 - 2 * D) : zero; unpack8(q1, cm1); unpack8(q2, cm2); }
    for (int i = 0; i < tpw; i += 4) {
        u32x4 qb[4], qc[4], qp[4], qo[4];
#pragma unroll
        for (int u = 0; u < 4; ++u) { const size_t off = off0 + (size_t)(i + u) * D; const int s = s0 + i + u;
            qb[u] = *(const u32x4*)(ZBCA + off); qc[u] = *(const u32x4*)(ZCV + off); qp[u] = *(const u32x4*)(ZP + off);
            qo[u] = (s >= win - 1) ? *(const u32x4*)(ZP + off - (size_t)(win - 1) * D) : zero; }
#pragma unroll
        for (int u = 0; u < 4; ++u) { const size_t off = off0 + (size_t)(i + u) * D; const int s = s0 + i + u;
            float fb[8], fc[8], fp[8], fo[8], ca[8], dd[8];
            unpack8(qb[u], fb); unpack8(qc[u], fc); unpack8(qp[u], fp); unpack8(qo[u], fo);
            const float inv = 1.0f / (float)((s + 1) < win ? (s + 1) : win);
#pragma unroll
            for (int j = 0; j < 8; ++j) { ca[j] = fb[j] * (w0[j] * cm2[j] + w1[j] * cm1[j] + w2[j] * fc[j]); cm2[j] = cm1[j]; cm1[j] = fc[j];
                const float st = acc[j] + fp[j]; dd[j] = st * inv - fp[j]; acc[j] = st - fo[j]; }
            u32x4 o1, o2;
            o1.x = cvt_pk_bf16(ca[0], ca[1]); o1.y = cvt_pk_bf16(ca[2], ca[3]); o1.z = cvt_pk_bf16(ca[4], ca[5]); o1.w = cvt_pk_bf16(ca[6], ca[7]);
            o2.x = cvt_pk_bf16(dd[0], dd[1]); o2.y = cvt_pk_bf16(dd[2], dd[3]); o2.z = cvt_pk_bf16(dd[4], dd[5]); o2.w = cvt_pk_bf16(dd[6], dd[7]);
            *(u32x4*)(ZBCA + off) = o1; *(u32x4*)(DDo + off) = o2; }
    }
}

__device__ __forceinline__ bool launder(Ctx& F, unsigned char*& ws, int& tidv) { int t; asm volatile("v_mbcnt_lo_u32_b32 %0, -1, 0\n\tv_mbcnt_hi_u32_b32 %0, -1, %0" : "=v"(t)); F.lane = t; tidv = F.wave * 64 + t; { int g = F.gw, b = blockIdx.x; asm volatile("" : "+s"(g), "+s"(b)); F.gw = g; F.bid = b; }
    const unsigned long long w0 = (unsigned long long)ws; unsigned wl = __builtin_amdgcn_readfirstlane((unsigned)w0), wh = __builtin_amdgcn_readfirstlane((unsigned)(w0 >> 32)); asm volatile("" : "+s"(wl), "+s"(wh));
    const unsigned long long w = ((unsigned long long)wh << 32) | wl; ws = (unsigned char*)(__attribute__((address_space(1))) unsigned char*)w; return true; }
constexpr int PH_PER_LAYER = 10, N_PHASES = 1 + DEPTH * PH_PER_LAYER;

__global__ void __launch_bounds__(512, 2) mega_fwd(Args a) {
    extern __shared__ __attribute__((aligned(16))) unsigned char lds_raw[];
    Ctx F; F.lds = (LAS unsigned char*)lds_raw; F.lane = threadIdx.x & 63; F.wave = __builtin_amdgcn_readfirstlane(threadIdx.x >> 6);
    F.G = gridDim.x; F.gw = blockIdx.x * 8 + F.wave; F.NGW = F.G * 8; F.bid = blockIdx.x;
    unsigned char* ws = a.ws; int tidv = threadIdx.x;
    const int lo = a.ph_lo, hi = a.ph_hi;
    volatile LAS unsigned* MISC = (volatile LAS unsigned*)(F.lds + MISC_OFF);
    if (threadIdx.x < 32) MISC[threadIdx.x] = 0u;
    __syncthreads();
    XcdBarrier bar; bar.bar = (unsigned*)(ws + WS_BAR); bar.x = 0; bar.st = nullptr;
    if (hi - lo > 1) bar = xcd_barrier_post((unsigned*)(ws + WS_BAR), MISC + 8);
    if (lo < 0) cg::this_grid().sync();
    int ph = 0;
#define IN_PH (lo <= ph && ph < hi && launder(F, ws, tidv))
#define SEAM() do { if (lo <= ph && ph + 1 < hi) { xcd_barrier(bar, F.wave); } ++ph; } while (0)
#define XB ((bf16_t*)(ws + WS_XB))
#define SSQ ((float*)(ws + WS_SSQ))
    if (IN_PH) { prep_weights(F, a, ws, 0); cast_rows(F, a.in[0], XB, SSQ); }
    SEAM();
    for (int l = 0; l < DEPTH; ++l) {
        const bool more = (l + 1 < DEPTH);
        if (IN_PH) { pg8::Gemm g{XB, (const bf16_t*)(ws + W_GU1), M, NGU, D, D, 0, nullptr, nullptr}; pg8::StaticOrder S; S.init(M, NGU, F.G, F.bid);
            pg8::EpiSwiglu E{(bf16_t*)(ws + WS_HH), SSQ}; pg8::gemm_phase(F.lds, g, S, E, tidv); }
        SEAM();
        if (IN_PH) { pg8::Gemm g{(const bf16_t*)(ws + WS_HH), (const bf16_t*)(ws + W_D1), M, D, FF, FF, 0, nullptr, nullptr}; pg8::StaticOrder S; S.init(M, D, F.G, F.bid);
            pg8::EpiResid<false> E{XB, a.in[2] + l * D, 0.5f, SSQ, nullptr, (float*)(ws + WS_XBUF), (unsigned*)(ws + WS_CNT) + (l * 3 + 0) * 128 * 16, nullptr}; pg8::gemm_phase(F.lds, g, S, E, tidv); }
        SEAM();
        if (IN_PH) { pg8::Gemm g{XB, (const bf16_t*)(ws + W_IN), M, NIN, D, D, 0, nullptr, nullptr}; pg8::StaticOrder S; S.init(M, NIN, F.G, F.bid);
            pg8::EpiWin E{(bf16_t*)(ws + WS_ZB), (bf16_t*)(ws + WS_ZCV), (bf16_t*)(ws + WS_ZP), (bf16_t*)(ws + WS_ZG), a.in[8] + l * 2 * D, SSQ}; pg8::gemm_phase(F.lds, g, S, E, tidv); }
        SEAM();
        if (IN_PH) mix_rows(F, (bf16_t*)(ws + WS_ZB), (const bf16_t*)(ws + WS_ZCV), (const bf16_t*)(ws + WS_ZP), a.in[9] + l * 3 * D, (bf16_t*)(ws + WS_DD));
        SEAM();
        if (IN_PH) { pg8::Gemm g{(const bf16_t*)(ws + WS_DD), (const bf16_t*)(ws + W_PG), M, D, 256, D, 256, nullptr, nullptr}; pg8::StaticOrder S; S.init(M, D, F.G, F.bid);
            pg8::EpiPoolGroup E{(bf16_t*)(ws + WS_YP0), a.in[12] + l * D, a.in[13] + l * D, nullptr}; pg8::gemm_phase(F.lds, g, S, E, tidv); }
        SEAM();
        if (IN_PH) { pg8::Gemm g{(const bf16_t*)(ws + WS_CA), (const bf16_t*)(ws + W_CO), M, D, D, D, 0, (const bf16_t*)(ws + WS_YP0), (const bf16_t*)(ws + W_PO)}; pg8::StaticOrder S; S.init(M, D, F.G, F.bid);
            pg8::EpiDual E{(const bf16_t*)(ws + WS_ZG), (bf16_t*)(ws + WS_MM), nullptr}; pg8::gemm_phase(F.lds, g, S, E, tidv); }
        SEAM();
        if (IN_PH) { pg8::Gemm g{(const bf16_t*)(ws + WS_MM), (const bf16_t*)(ws + W_WO), M, D, D, D, 0, nullptr, nullptr}; pg8::StaticOrder S; S.init(M, D, F.G, F.bid);
            pg8::EpiResid<false> E{XB, a.in[6] + l * D, 1.0f, SSQ, nullptr, (float*)(ws + WS_XBUF), (unsigned*)(ws + WS_CNT) + (l * 3 + 1) * 128 * 16, nullptr}; pg8::gemm_phase(F.lds, g, S, E, tidv); }
        SEAM();
        if (IN_PH) { pg8::Gemm g{XB, (const bf16_t*)(ws + W_GU2), M, NGU, D, D, 0, nullptr, nullptr}; pg8::StaticOrder S; S.init(M, NGU, F.G, F.bid);
            pg8::EpiSwiglu E{(bf16_t*)(ws + WS_HH), SSQ}; pg8::gemm_phase(F.lds, g, S, E, tidv); }
        SEAM();
        if (IN_PH) { pg8::Gemm g{(const bf16_t*)(ws + WS_HH), (const bf16_t*)(ws + W_D2), M, D, FF, FF, 0, nullptr, nullptr}; pg8::StaticOrder S; S.init(M, D, F.G, F.bid);
            if (more) { pg8::EpiResid<false> E{XB, a.in[17] + l * D, 0.5f, SSQ, nullptr, (float*)(ws + WS_XBUF), (unsigned*)(ws + WS_CNT) + (l * 3 + 2) * 128 * 16, nullptr}; pg8::gemm_phase(F.lds, g, S, E, tidv); }
            else { pg8::EpiResid<true> E{XB, a.in[17] + l * D, 0.5f, SSQ, a.out, (float*)(ws + WS_XBUF), (unsigned*)(ws + WS_CNT) + (l * 3 + 2) * 128 * 16, nullptr}; pg8::gemm_phase(F.lds, g, S, E, tidv); } }
        SEAM();
        if (IN_PH) { if (more) prep_weights(F, a, ws, l + 1); }
        SEAM();
    }
#undef IN_PH
#undef SEAM
}

extern "C" void kernel_launch(void* const* d_in, const int* in_sizes, int n_in, void* d_out, int out_size, void* d_ws, size_t ws_size, hipStream_t stream) {
    static int grid = 0;
    if (grid == 0) {
        if (n_in != 20 || in_sizes[0] != M * D || out_size != M * D || ws_size < WS_END) { fprintf(stderr, "kernel_launch: unexpected shapes (n_in %d, in0 %d, out %d, ws %zu < %zu)\n", n_in, n_in > 0 ? in_sizes[0] : -1, out_size, ws_size, (size_t)WS_END); grid = -1; return; }
        int dev = 0, cus = 0, per_cu = 0;
        (void)hipGetDevice(&dev); (void)hipDeviceGetAttribute(&cus, hipDeviceAttributeMultiprocessorCount, dev);
        if (hipFuncSetAttribute((const void*)mega_fwd, hipFuncAttributeMaxDynamicSharedMemorySize, LDS_BYTES) != hipSuccess) { fprintf(stderr, "kernel_launch: hipFuncSetAttribute failed\n"); grid = -1; return; }
        if (hipOccupancyMaxActiveBlocksPerMultiprocessor(&per_cu, (const void*)mega_fwd, 512, LDS_BYTES) != hipSuccess || per_cu < 1) { fprintf(stderr, "kernel_launch: occupancy query says %d\n", per_cu); per_cu = 1; (void)hipGetLastError(); }
        grid = cus * per_cu;
    }
    if (grid < 0) return;
    Args a{};
    for (int i = 0; i < 20; ++i) a.in[i] = (const float*)d_in[i];
    a.out = (float*)d_out; a.ws = (unsigned char*)d_ws;
#if MK_ONE_LAUNCH
    if (hipMemsetAsync((char*)d_ws, 0, CTL_ZERO_BYTES, stream) != hipSuccess) { fprintf(stderr, "kernel_launch: memset failed\n"); return; }
    a.ph_lo = 0; a.ph_hi = N_PHASES;
    void* args[] = {&a};
    hipError_t e = hipLaunchCooperativeKernel((const void*)mega_fwd, dim3(grid), dim3(512), args, LDS_BYTES, stream);
    if (e != hipSuccess) fprintf(stderr, "cooperative launch failed: %s (grid %d)\n", hipGetErrorString(e), grid);
#else
    for (int p = 0; p < N_PHASES; ++p) { a.ph_lo = p; a.ph_hi = p + 1; hipLaunchKernelGGL(mega_fwd, dim3(grid), dim3(512), LDS_BYTES, stream, a); }
#endif
}
```
